# Optimizing an MI355X kernel written in HIP

```python
import math, functools
import jax, jax.numpy as jnp
from jax import lax
import numpy as np

D_MODEL = 1024
BATCH = 8
SEQ = 4096
DEPTH = 4

CTX_LEN = 256
GRID_W = 64
D_FF = 2816
N_MOD = 9
NORM_EPS = 1e-6

RG_W = 256
RG_HEADS = 4
RG_BLK = RG_W // RG_HEADS
RG_CONV = 4
RG_C = 8.0

GLA_HEADS = 4
GLA_DK = 48
GLA_DV = 96
GLA_QK = GLA_HEADS * GLA_DK
GLA_W = GLA_HEADS * GLA_DV
GLA_RANK = 16
GLA_TAU = 16.0
GLA_CHUNK = 64

RW_HEADS = 6
RW_N = 64
RW_W = RW_HEADS * RW_N
RW_DECAY_LORA = 64
RW_AAA_LORA = 64
RW_GATE_LORA = 128
RW_GN_EPS = 64e-5

MIX_W = RG_W + GLA_W + RW_W

RG_SIZES = (RG_W, RG_W)
GLA_SIZES = (GLA_QK, GLA_QK, GLA_W, GLA_W, GLA_RANK, GLA_RANK)
RW_SIZES = (RW_W, RW_W, RW_W, RW_DECAY_LORA, RW_DECAY_LORA,
            RW_AAA_LORA, RW_AAA_LORA, RW_GATE_LORA)
RW_P = sum(RW_SIZES)
IN_SIZES = RG_SIZES + GLA_SIZES + (RW_P,)
P_IN = sum(IN_SIZES)

kernel_name = "hymba_style_rglru_gla_rwkv7_diffusion_trunk"


def split_cols(z, sizes):
    return jnp.split(z, [int(s) for s in np.cumsum(sizes)[:-1]], axis=-1)


def rms_norm(x, g, eps=NORM_EPS):
    xf = x.astype(jnp.float32)
    y = xf * lax.rsqrt(jnp.mean(xf * xf, axis=-1, keepdims=True) + eps)
    return (y * g.astype(jnp.float32)).astype(x.dtype)


def modulate(h, shift, scale):
    return h * (1 + scale) + shift


def adaln(cvec, w, b):
    m = jax.nn.silu(cvec) @ w + b
    return m.reshape(cvec.shape[:-1] + (N_MOD, D_MODEL))


def swiglu(h, w1, w3, w2):
    return (jax.nn.silu(h @ w1) * (h @ w3)) @ w2


def ffn_sublayer(h, shift, scale, gate, g_pre, g_post, w1, w3, w2):
    y = swiglu(modulate(rms_norm(h, g_pre), shift, scale), w1, w3, w2)
    return h + 0.5 * gate * rms_norm(y, g_post)


def grid_quad_shift(x, rows):
    B, T, C = x.shape
    g = x.reshape(B, rows, GRID_W, C // 4, 4)
    left = jnp.pad(g[:, :, :-1, :, 0], ((0, 0), (0, 0), (1, 0), (0, 0)))
    right = jnp.pad(g[:, :, 1:, :, 1], ((0, 0), (0, 0), (0, 1), (0, 0)))
    up = jnp.pad(g[:, :-1, :, :, 2], ((0, 0), (1, 0), (0, 0), (0, 0)))
    down = jnp.pad(g[:, 1:, :, :, 3], ((0, 0), (0, 1), (0, 0), (0, 0)))
    return jnp.stack([left, right, up, down], axis=-1).reshape(B, T, C)


def seq_bi_shift(x):
    B, T, C = x.shape
    g = x.reshape(B, T, C // 2, 2)
    prev = jnp.pad(g[:, :-1, :, 0], ((0, 0), (1, 0), (0, 0)))
    nxt = jnp.pad(g[:, 1:, :, 1], ((0, 0), (0, 1), (0, 0)))
    return jnp.stack([prev, nxt], axis=-1).reshape(B, T, C)


def depthwise_conv_centred(x, w, b):
    C = x.shape[-1]
    lo = RG_CONV // 2
    y = lax.conv_general_dilated(x, w[:, None, :].astype(x.dtype), window_strides=(1,),
                                 padding=[(lo, RG_CONV - 1 - lo)],
                                 dimension_numbers=('NWC', 'WIO', 'NWC'),
                                 feature_group_count=C)
    return y + b


def linear_scan(a, b, h0):
    b = b.at[:, 0].add(a[:, 0] * h0)
    def combine(l, r):
        return l[0] * r[0], r[0] * l[1] + r[1]
    _, h = lax.associative_scan(combine, (a, b), axis=1)
    return h


def rglru_direction(xc, ga_w, ga_b, gx_w, gx_b, lam, h0):
    B, T, _ = xc.shape
    xh = xc.reshape(B, T, RG_HEADS, RG_BLK)
    r = jax.nn.sigmoid(jnp.einsum('bthi,hij->bthj', xh, ga_w).reshape(B, T, RG_W) + ga_b)
    i = jax.nn.sigmoid(jnp.einsum('bthi,hij->bthj', xh, gx_w).reshape(B, T, RG_W) + gx_b)
    log_a = -RG_C * r * jax.nn.softplus(-lam)
    a = jnp.exp(log_a)
    mult = jnp.sqrt(-jnp.expm1(2.0 * log_a))
    return linear_scan(a, mult * (i * xc), h0)


def rglru_mixer(xb, gb, conv_w, conv_b, ga_w, ga_b, gx_w, gx_b, lam, h0_f, h0_b):
    xc = depthwise_conv_centred(xb, conv_w, conv_b)
    hf = rglru_direction(xc, ga_w[0], ga_b[0], gx_w[0], gx_b[0], lam[0], h0_f)
    hb = rglru_direction(jnp.flip(xc, 1), ga_w[1], ga_b[1], gx_w[1], gx_b[1], lam[1], h0_b)
    y = (hf + jnp.flip(hb, 1)) * jax.nn.gelu(gb)
    return y, (hf[:, -1], hb[:, -1])


def gla_chunked(q, k, v, log_a, S0):
    B, T, H, _ = q.shape
    DV = v.shape[-1]
    n = T // GLA_CHUNK
    def to_chunks(t):
        return t.reshape(B, n, GLA_CHUNK, H, t.shape[-1]).transpose(1, 0, 3, 2, 4)
    qc, kc, vc, gc = (to_chunks(t) for t in (q, k, v, log_a))
    causal = jnp.tril(jnp.ones((GLA_CHUNK, GLA_CHUNK), dtype=bool))

    def step(S, inp):
        qi, ki, vi, gi = inp
        bcum = jnp.cumsum(gi, axis=2)
        o_inter = jnp.einsum('bhcd,bhde->bhce', qi * jnp.exp(bcum), S)
        diff = bcum[:, :, :, None, :] - bcum[:, :, None, :, :]
        decay = jnp.exp(jnp.where(causal[:, :, None], diff, -jnp.inf))
        A = jnp.einsum('bhid,bhjd,bhijd->bhij', qi, ki, decay)
        o = o_inter + jnp.einsum('bhij,bhje->bhie', A, vi)
        b_last = bcum[:, :, -1:, :]
        S_new = (jnp.exp(b_last[:, :, 0, :])[..., None] * S
                 + jnp.einsum('bhcd,bhce->bhde', ki * jnp.exp(b_last - bcum), vi))
        return S_new, o

    S_fin, o = lax.scan(step, S0, (qc, kc, vc, gc))
    o = o.transpose(1, 0, 3, 2, 4).reshape(B, T, H, DV)
    return o, S_fin


def gla_mixer(q, k, v, og, al_f, al_b, alpha_w2, alpha_b, norm_w, S0_f, S0_b):
    B, T, _ = q.shape
    q = q.reshape(B, T, GLA_HEADS, GLA_DK) * (GLA_DK ** -0.5)
    k = k.reshape(B, T, GLA_HEADS, GLA_DK)
    v = v.reshape(B, T, GLA_HEADS, GLA_DV)
    def log_alpha(lr, w2, b):
        return (jax.nn.log_sigmoid(lr @ w2 + b) / GLA_TAU).reshape(B, T, GLA_HEADS, GLA_DK)
    o_f, S_f = gla_chunked(q, k, v, log_alpha(al_f, alpha_w2[0], alpha_b[0]), S0_f)
    flip = lambda t: jnp.flip(t, 1)
    o_b, S_b = gla_chunked(flip(q), flip(k), flip(v),
                           flip(log_alpha(al_b, alpha_w2[1], alpha_b[1])), S0_b)
    o = rms_norm(o_f + flip(o_b), norm_w)
    y = o.reshape(B, T, GLA_W) * jax.nn.silu(og)
    return y, (S_f, S_b)


def rwkv7_scan(r, w, k, v, a, b, S0):
    def step(S, inp):
        rt, wt, kt, vt, at, bt = inp
        sa = jnp.einsum('bhvk,bhk->bhv', S, at)
        S = S * wt[:, :, None, :] + sa[..., None] * bt[:, :, None, :] + vt[..., None] * kt[:, :, None, :]
        return S, jnp.einsum('bhvk,bhk->bhv', S, rt)
    xs = tuple(jnp.moveaxis(t, 1, 0) for t in (r, w, k, v, a, b))
    S_fin, y = lax.scan(step, S0, xs)
    return jnp.moveaxis(y, 0, 1), S_fin


def rwkv7_mixer(feats, shift_fn, mu, w0, w2, a0, a2, g2, k_k, k_a, r_k, ln_w, ln_b, S0_f, S0_b):
    feats = feats + mu * (shift_fn(feats) - feats)
    r, k, v, wl_f, wl_b, al_f, al_b, gl = split_cols(feats, RW_SIZES)
    B, T, _ = r.shape
    heads = lambda t: t.reshape(B, T, RW_HEADS, RW_N)
    kk = heads(k * k_k)
    kk = kk / jnp.maximum(jnp.linalg.norm(kk, axis=-1, keepdims=True), 1e-12)

    def direction(wl, al, d, S0, reverse):
        log_w = -jax.nn.softplus(-(w0[d] + jnp.tanh(wl) @ w2[d])) - 0.5
        decay = jnp.exp(-jnp.exp(log_w))
        a = jax.nn.sigmoid(a0[d] + al @ a2[d])
        kd = k * (1 + (a - 1) * k_a)
        ins = [heads(r), heads(decay), heads(kd), heads(v), -kk, kk * heads(a)]
        if reverse:
            ins = [jnp.flip(t, 1) for t in ins]
        y, S = rwkv7_scan(*ins, S0)
        if reverse:
            y = jnp.flip(y, 1)
        bonus = jnp.sum(heads(r) * heads(kd) * r_k, axis=-1, keepdims=True) * heads(v)
        return y, bonus, S

    y_f, bonus_f, S_f = direction(wl_f, al_f, 0, S0_f, False)
    y_b, bonus_b, S_b = direction(wl_b, al_b, 1, S0_b, True)
    y = y_f + y_b
    mean = jnp.mean(y, axis=-1, keepdims=True)
    var = jnp.mean(jnp.square(y - mean), axis=-1, keepdims=True)
    y = ((y - mean) * lax.rsqrt(var + RW_GN_EPS)).reshape(B, T, RW_W) * ln_w + ln_b
    y = y + (bonus_f + bonus_b).reshape(B, T, RW_W)
    g = jax.nn.sigmoid(gl) @ g2
    return y * g, (S_f, S_b)


def token_mixer(z, shift_fn, states, mp):
    z = z.astype(jnp.float32)
    xb, gb, q, k, v, og, al_f, al_b, rw = split_cols(z, IN_SIZES)
    y_rg, st_rg = rglru_mixer(xb, gb, mp['rg_conv_w'], mp['rg_conv_b'], mp['rg_gate_a_w'],
                              mp['rg_gate_a_b'], mp['rg_gate_x_w'], mp['rg_gate_x_b'],
                              mp['rg_lambda'], states[0], states[1])
    y_gla, st_gla = gla_mixer(q, k, v, og, al_f, al_b, mp['gla_alpha_w2'], mp['gla_alpha_b'],
                              mp['gla_norm'], states[2], states[3])
    y_rw, st_rw = rwkv7_mixer(rw, shift_fn, mp['rw_mu'], mp['rw_w0'], mp['rw_w2'], mp['rw_a0'],
                              mp['rw_a2'], mp['rw_g2'], mp['rw_k_k'], mp['rw_k_a'], mp['rw_r_k'],
                              mp['rw_ln_w'], mp['rw_ln_b'], states[4], states[5])
    y = jnp.concatenate([y_rg, y_gla, y_rw], axis=-1)
    return y, st_rg + st_gla + st_rw


def setup_inputs(seed: int = 0) -> dict:
    key = jax.random.key(seed)
    ks = iter(jax.random.split(key, 48))
    nrm = lambda shape, s: s * jax.random.normal(next(ks), shape, jnp.float32)
    uni = lambda shape, lo, hi: jax.random.uniform(next(ks), shape, jnp.float32, lo, hi)
    logit = lambda p: jnp.log(p) - jnp.log1p(-p)
    L, D = DEPTH, D_MODEL
    return {
        "x": nrm((BATCH, SEQ, D), 1.0),
        "c": nrm((BATCH, D), 1.0),
        "ctx": nrm((BATCH, CTX_LEN, D), 1.0),
        "c_ctx": nrm((D,), 1.0),
        "w_mod": nrm((L, D, N_MOD * D), 0.5 * D ** -0.5),
        "b_mod": nrm((L, N_MOD * D), 0.02),
        "norm_pre": 1.0 + nrm((L, 3, D), 0.02),
        "norm_post": 1.0 + nrm((L, 3, D), 0.02),
        "ffn_w1": nrm((L, 2, D, D_FF), D ** -0.5),
        "ffn_w3": nrm((L, 2, D, D_FF), D ** -0.5),
        "ffn_w2": nrm((L, 2, D_FF, D), D_FF ** -0.5),
        "w_in": nrm((L, D, P_IN), D ** -0.5),
        "w_out": nrm((L, MIX_W, D), MIX_W ** -0.5),
        "rg_conv_w": nrm((L, RG_CONV, RG_W), RG_CONV ** -0.5),
        "rg_conv_b": nrm((L, RG_W), 0.02),
        "rg_gate_a_w": nrm((L, 2, RG_HEADS, RG_BLK, RG_BLK), RG_BLK ** -0.5),
        "rg_gate_a_b": nrm((L, 2, RG_W), 0.02),
        "rg_gate_x_w": nrm((L, 2, RG_HEADS, RG_BLK, RG_BLK), RG_BLK ** -0.5),
        "rg_gate_x_b": nrm((L, 2, RG_W), 0.02),
        "rg_lambda": logit(uni((L, 2, RG_W), 0.9, 0.999)),
        "gla_alpha_w2": nrm((L, 2, GLA_RANK, GLA_QK), GLA_RANK ** -0.5),
        "gla_alpha_b": nrm((L, 2, GLA_QK), 0.1),
        "gla_norm": 1.0 + nrm((L, GLA_DV), 0.02),
        "rw_mu": uni((L, RW_P), 0.0, 1.0),
        "rw_w0": uni((L, 2, RW_W), -6.0, -1.0),
        "rw_w2": nrm((L, 2, RW_DECAY_LORA, RW_W), 0.5 * RW_DECAY_LORA ** -0.5),
        "rw_a0": nrm((L, 2, RW_W), 0.1),
        "rw_a2": nrm((L, 2, RW_AAA_LORA, RW_W), 0.5 * RW_AAA_LORA ** -0.5),
        "rw_g2": nrm((L, RW_GATE_LORA, RW_W), RW_GATE_LORA ** -0.5),
        "rw_k_k": 0.85 + nrm((L, RW_W), 0.02),
        "rw_k_a": 1.0 + nrm((L, RW_W), 0.02),
        "rw_r_k": nrm((L, RW_HEADS, RW_N), 0.1),
        "rw_ln_w": 1.0 + nrm((L, RW_W), 0.02),
        "rw_ln_b": nrm((L, RW_W), 0.02),
    }


def reference(x, c, ctx, c_ctx, w_mod, b_mod, norm_pre, norm_post, ffn_w1, ffn_w3, ffn_w2,
              w_in, w_out, rg_conv_w, rg_conv_b, rg_gate_a_w, rg_gate_a_b, rg_gate_x_w,
              rg_gate_x_b, rg_lambda, gla_alpha_w2, gla_alpha_b, gla_norm, rw_mu, rw_w0, rw_w2,
              rw_a0, rw_a2, rw_g2, rw_k_k, rw_k_a, rw_r_k, rw_ln_w, rw_ln_b):
    f32 = jnp.float32
    B = x.shape[0]
    rows = x.shape[1] // GRID_W
    lat_shift = functools.partial(grid_quad_shift, rows=rows)
    zero_states = ((jnp.zeros((B, RG_W), f32),) * 2
                   + (jnp.zeros((B, GLA_HEADS, GLA_DK, GLA_DV), f32),) * 2
                   + (jnp.zeros((B, RW_HEADS, RW_N, RW_N), f32),) * 2)
    h, hc = x, ctx
    for l in range(DEPTH):
        last = l == DEPTH - 1
        m_lat = jnp.moveaxis(adaln(c, w_mod[l], b_mod[l]), 1, 0)[:, :, None, :]
        m_ctx = adaln(c_ctx, w_mod[l], b_mod[l])
        mp = {
            'rg_conv_w': rg_conv_w[l], 'rg_conv_b': rg_conv_b[l],
            'rg_gate_a_w': rg_gate_a_w[l], 'rg_gate_a_b': rg_gate_a_b[l],
            'rg_gate_x_w': rg_gate_x_w[l], 'rg_gate_x_b': rg_gate_x_b[l],
            'rg_lambda': rg_lambda[l],
            'gla_alpha_w2': gla_alpha_w2[l], 'gla_alpha_b': gla_alpha_b[l], 'gla_norm': gla_norm[l],
            'rw_mu': rw_mu[l], 'rw_w0': rw_w0[l], 'rw_w2': rw_w2[l], 'rw_a0': rw_a0[l],
            'rw_a2': rw_a2[l], 'rw_g2': rw_g2[l], 'rw_k_k': rw_k_k[l], 'rw_k_a': rw_k_a[l],
            'rw_r_k': rw_r_k[l], 'rw_ln_w': rw_ln_w[l], 'rw_ln_b': rw_ln_b[l],
        }
        h = ffn_sublayer(h, m_lat[0], m_lat[1], m_lat[2], norm_pre[l, 0], norm_post[l, 0],
                         ffn_w1[l, 0], ffn_w3[l, 0], ffn_w2[l, 0])
        hc = ffn_sublayer(hc, m_ctx[0], m_ctx[1], m_ctx[2], norm_pre[l, 0], norm_post[l, 0],
                          ffn_w1[l, 0], ffn_w3[l, 0], ffn_w2[l, 0])
        zc = modulate(rms_norm(hc, norm_pre[l, 1]), m_ctx[3], m_ctx[4]) @ w_in[l]
        yc, ctx_states = token_mixer(zc, seq_bi_shift, zero_states, mp)
        z = modulate(rms_norm(h, norm_pre[l, 1]), m_lat[3], m_lat[4]) @ w_in[l]
        y, _ = token_mixer(z, lat_shift, ctx_states, mp)
        h = h + m_lat[5] * rms_norm(y.astype(h.dtype) @ w_out[l], norm_post[l, 1])
        h = ffn_sublayer(h, m_lat[6], m_lat[7], m_lat[8], norm_pre[l, 2], norm_post[l, 2],
                         ffn_w1[l, 1], ffn_w3[l, 1], ffn_w2[l, 1])
        if not last:
            hc = hc + m_ctx[5] * rms_norm(yc.astype(hc.dtype) @ w_out[l], norm_post[l, 1])
            hc = ffn_sublayer(hc, m_ctx[6], m_ctx[7], m_ctx[8], norm_pre[l, 2], norm_post[l, 2],
                              ffn_w1[l, 1], ffn_w3[l, 1], ffn_w2[l, 1])
    return h
```

```cpp
#include <hip/hip_runtime.h>
#include <hip/hip_cooperative_groups.h>
#include <cstdio>
namespace cg = cooperative_groups;

typedef unsigned short u16;
using bf16x8 = __attribute__((ext_vector_type(8))) short;
using f32x4 = __attribute__((ext_vector_type(4))) float;

#define DEV __device__ __forceinline__

constexpr int NLAT = 32768, NCTXR = 2048, NT = 34816;
constexpr int DM = 1024, DFF = 2816, PIN = 3232, PINP = 3328;
constexpr int Z1W = 1696, Z2W = 1536;
constexpr int NTHREADS = 512;
constexpr size_t SMEM_BYTES = 131072;

constexpr size_t OFF_MOD = 0;
constexpr size_t SZ_MOD = 4ull * 9 * 9216 * 4;
constexpr size_t OFF_HC = OFF_MOD + SZ_MOD;
constexpr size_t SZ_HC = 2048ull * 1024 * 4;
constexpr size_t OFF_INVN = OFF_HC + SZ_HC;
constexpr size_t SZ_INVN = (size_t)NT * 8 * 4;
constexpr size_t OFF_WB = OFF_INVN + SZ_INVN;
constexpr size_t SZ_WB = 5632ull * 1024 * 2 + 1024ull * 2816 * 2;
constexpr size_t OFF_XN = OFF_WB + SZ_WB;
constexpr size_t SZ_XN = (size_t)NT * 1024 * 2;
constexpr size_t OFF_Y = OFF_XN + SZ_XN;
constexpr size_t SZ_Y = SZ_XN;
constexpr size_t OFF_AR = OFF_Y + SZ_Y;
constexpr size_t SZ_384 = (size_t)NT * 384 * 2;
constexpr size_t SZ_256 = (size_t)NT * 256 * 2;
constexpr size_t SZ_192 = (size_t)NT * 192 * 2;
constexpr size_t AR_Z1 = 0;
constexpr size_t AR_Z2 = AR_Z1 + (size_t)NT * Z1W * 2;
constexpr size_t AR_RWP = AR_Z2 + (size_t)NT * Z2W * 2;
constexpr size_t AR_LA = AR_RWP + 7 * SZ_384;
constexpr size_t SZ_AR = AR_LA + 2 * SZ_192;
constexpr size_t WS_TOTAL = OFF_AR + SZ_AR;
constexpr size_t WB_W13T = 0;
constexpr size_t WB_W2T = 5632ull * 1024 * 2;
constexpr size_t WB_WINT = 0;
constexpr size_t WB_WOUTT = WB_WINT + 3328ull * 1024 * 2;
constexpr size_t WB_RWW2T = WB_WOUTT + 1024ull * 1024 * 2;
constexpr size_t WB_RWA2T = WB_RWW2T + 2ull * 384 * 64 * 2;
constexpr size_t WB_RWG2T = WB_RWA2T + 2ull * 384 * 64 * 2;
constexpr size_t WB_RGGT = WB_RWG2T + 384ull * 128 * 2;
constexpr size_t WB_GLAT = WB_RGGT + 16ull * 64 * 64 * 2;

struct Params {
  const float *x, *c, *ctx, *c_ctx, *w_mod, *b_mod, *norm_pre, *norm_post, *ffn_w1, *ffn_w3, *ffn_w2, *w_in, *w_out,
      *rg_conv_w, *rg_conv_b, *rg_gate_a_w, *rg_gate_a_b, *rg_gate_x_w, *rg_gate_x_b, *rg_lambda,
      *gla_alpha_w2, *gla_alpha_b, *gla_norm, *rw_mu, *rw_w0, *rw_w2, *rw_a0, *rw_a2, *rw_g2, *rw_k_k, *rw_k_a,
      *rw_r_k, *rw_ln_w, *rw_ln_b;
  float* out;
  char* ws;
};

extern __shared__ __attribute__((aligned(16))) char g_smem[];

DEV const float* kparg(int off) {
  const char __attribute__((address_space(4)))* kp =
      (const char __attribute__((address_space(4)))*)__builtin_amdgcn_kernarg_segment_ptr();
  return *(const float* volatile const __attribute__((address_space(4)))*)(kp + off);
}
#define KP(name) kparg((int)__builtin_offsetof(Params, name))
#define KWS ((char*)kparg((int)__builtin_offsetof(Params, ws)))
#define KOUT ((float*)kparg((int)__builtin_offsetof(Params, out)))
struct PTag {};

DEV int my_tid() {
  int t = threadIdx.x;
  asm volatile("" : "+v"(t));
  return t;
}
DEV int my_bid() {
  int b = blockIdx.x;
  asm volatile("" : "+s"(b));
  return b;
}
DEV float bf2f(u16 u) { return __uint_as_float(((unsigned)u) << 16); }
DEV u16 f2bf(float f) {
  unsigned u = __float_as_uint(f);
  u += 0x7fffu + ((u >> 16) & 1u);
  return (u16)(u >> 16);
}
DEV unsigned pack2(float a, float b) { return (unsigned)f2bf(a) | ((unsigned)f2bf(b) << 16); }
DEV float lo2f(unsigned u) { return __uint_as_float(u << 16); }
DEV float hi2f(unsigned u) { return __uint_as_float(u & 0xffff0000u); }
DEV float wave_sum(float v) {
#pragma unroll
  for (int o = 32; o > 0; o >>= 1) v += __shfl_xor(v, o, 64);
  return v;
}
DEV float sigmoidf_(float x) { return 1.f / (1.f + __expf(-x)); }
DEV float siluf_(float x) { return x / (1.f + __expf(-x)); }
DEV float log_sigmoidf_(float x) { return fminf(x, 0.f) - log1pf(__expf(-fabsf(x))); }
template <int CTRL>
DEV float dpp_f(float x) {
  return __int_as_float(__builtin_amdgcn_update_dpp(0, __float_as_int(x), CTRL, 0xf, 0xf, true));
}
DEV float quad_sum(float x) {
  x += dpp_f<0xB1>(x);
  x += dpp_f<0x4E>(x);
  return x;
}
DEV float oct_sum(float x) {
  x = quad_sum(x);
  x += dpp_f<0x141>(x);
  return x;
}
DEV int seq_row(int b, int dir, int s) {
  if (s < 256) {
    int t = dir ? 255 - s : s;
    return NLAT + b * 256 + t;
  }
  int t = s - 256;
  t = dir ? 4095 - t : t;
  return b * 4096 + t;
}

DEV void phase_adaln(PTag p) {
  const int ltid = my_tid();
  const int lbid = my_bid();
  (void)ltid; (void)lbid;
  float* sc = (float*)g_smem;
  float* red = sc + 9 * 1024;
  float* mod = (float*)(KWS + OFF_MOD);
  const int tid = ltid;
  for (int i = tid; i < 9 * 1024; i += NTHREADS) {
    int m = i >> 10, k = i & 1023;
    float v = (m < 8) ? KP(c)[m * 1024 + k] : KP(c_ctx)[k];
    sc[i] = siluf_(v);
  }
  __syncthreads();
  for (int job = lbid; job < 256; job += gridDim.x) {
    int l = job >> 6, j0 = (job & 63) * 144;
    const float* W = KP(w_mod) + (size_t)l * 1024 * 9216;
    int cgp = tid % 36, ig = tid / 36;
    if (tid < 504) {
      float acc[9][4];
#pragma unroll
      for (int m = 0; m < 9; ++m)
#pragma unroll
        for (int q = 0; q < 4; ++q) acc[m][q] = 0.f;
#pragma unroll 4
      for (int i = ig; i < 1024; i += 14) {
        float4 w4 = *(const float4*)(W + (size_t)i * 9216 + j0 + cgp * 4);
#pragma unroll
        for (int m = 0; m < 9; ++m) {
          float s = sc[m * 1024 + i];
          acc[m][0] += s * w4.x;
          acc[m][1] += s * w4.y;
          acc[m][2] += s * w4.z;
          acc[m][3] += s * w4.w;
        }
      }
#pragma unroll
      for (int m = 0; m < 9; ++m)
#pragma unroll
        for (int q = 0; q < 4; ++q) red[(ig * 9 + m) * 144 + cgp * 4 + q] = acc[m][q];
    }
    __syncthreads();
    for (int o = tid; o < 9 * 144; o += NTHREADS) {
      int m = o / 144, cc = o % 144;
      float s = KP(b_mod)[l * 9216 + j0 + cc];
#pragma unroll
      for (int g = 0; g < 14; ++g) s += red[(g * 9 + m) * 144 + cc];
      mod[(size_t)(l * 9 + m) * 9216 + j0 + cc] = s;
    }
    __syncthreads();
  }
}

DEV void conv_job(const float* srcA, const float* srcB, int interleave, int ld, int Kvalid, int Nvalid, u16* dst,
                  int Kdst, int Ndst, int& tb) {
  const int ltid = my_tid();
  const int lbid = my_bid();
  (void)ltid; (void)lbid;
  float* tile = (float*)g_smem;
  const int tid = ltid;
  int tk = (Kdst + 63) / 64, nt = (Ndst / 64) * tk;
  int G = gridDim.x;
  int start = (((int)lbid - (tb % G)) % G + G) % G;
  for (int t = start; t < nt; t += G) {
    int nn0 = (t / tk) * 64, k0 = (t % tk) * 64;
    int nl = tid & 63, nn = nn0 + nl;
    const float* src;
    int col;
    bool nv;
    if (interleave) {
      int g = nn >> 5, w = nn & 31;
      col = g * 16 + (w & 15);
      src = (w < 16) ? srcA : srcB;
      nv = true;
    } else {
      col = nn;
      src = srcA;
      nv = nn < Nvalid;
    }
#pragma unroll
    for (int pass = 0; pass < 8; ++pass) {
      int kk = pass * 8 + (tid >> 6);
      int k = k0 + kk;
      float v = (nv && k < Kvalid) ? src[(size_t)k * ld + col] : 0.f;
      tile[nl * 65 + kk] = v;
    }
    __syncthreads();
    {
      int nl2 = tid >> 3, kc = tid & 7;
      int k = k0 + kc * 8;
      if (k < Kdst) {
        const float* tp = tile + nl2 * 65 + kc * 8;
        uint4 o;
        o.x = pack2(tp[0], tp[1]);
        o.y = pack2(tp[2], tp[3]);
        o.z = pack2(tp[4], tp[5]);
        o.w = pack2(tp[6], tp[7]);
        *(uint4*)(dst + (size_t)(nn0 + nl2) * Kdst + k) = o;
      }
    }
    __syncthreads();
  }
  tb += nt;
}

DEV void conv_ffn(PTag p, int l, int f) {
  int tb = 0;
  u16* wb = (u16*)(KWS + OFF_WB);
  size_t o13 = ((size_t)(l * 2 + f)) * 1024 * 2816;
  conv_job(KP(ffn_w1) + o13, KP(ffn_w3) + o13, 1, 2816, 1024, 5632, (u16*)((char*)wb + WB_W13T), 1024, 5632, tb);
  conv_job(KP(ffn_w2) + o13, nullptr, 0, 1024, 2816, 1024, (u16*)((char*)wb + WB_W2T), 2816, 1024, tb);
}
DEV void conv_mixer(PTag p, int l) {
  int tb = 0;
  char* wb = KWS + OFF_WB;
  conv_job(KP(w_in) + (size_t)l * 1024 * PIN, nullptr, 0, PIN, 1024, PIN, (u16*)(wb + WB_WINT), 1024, PINP, tb);
  conv_job(KP(w_out) + (size_t)l * 1024 * 1024, nullptr, 0, 1024, 1024, 1024, (u16*)(wb + WB_WOUTT), 1024, 1024, tb);
  for (int d = 0; d < 2; ++d) {
    conv_job(KP(rw_w2) + (size_t)(l * 2 + d) * 64 * 384, nullptr, 0, 384, 64, 384, (u16*)(wb + WB_RWW2T) + d * 384 * 64, 64,
             384, tb);
    conv_job(KP(rw_a2) + (size_t)(l * 2 + d) * 64 * 384, nullptr, 0, 384, 64, 384, (u16*)(wb + WB_RWA2T) + d * 384 * 64, 64,
             384, tb);
    conv_job(KP(gla_alpha_w2) + (size_t)(l * 2 + d) * 16 * 192, nullptr, 0, 192, 16, 192, (u16*)(wb + WB_GLAT) + d * 192 * 32,
             32, 192, tb);
    for (int h = 0; h < 4; ++h) {
      conv_job(KP(rg_gate_a_w) + (size_t)((l * 2 + d) * 4 + h) * 4096, nullptr, 0, 64, 64, 64,
               (u16*)(wb + WB_RGGT) + ((d * 2 + 0) * 4 + h) * 4096, 64, 64, tb);
      conv_job(KP(rg_gate_x_w) + (size_t)((l * 2 + d) * 4 + h) * 4096, nullptr, 0, 64, 64, 64,
               (u16*)(wb + WB_RGGT) + ((d * 2 + 1) * 4 + h) * 4096, 64, 64, tb);
    }
  }
  conv_job(KP(rw_g2) + (size_t)l * 128 * 384, nullptr, 0, 384, 128, 384, (u16*)(wb + WB_RWG2T), 128, 384, tb);
}

DEV void phase_rows(PTag p, int init, int has_y, const float* gpost, const float* mod_gate, float coef,
                    int has_next, const float* gpre, const float* mod_shift, const float* mod_scale, int Mrows) {
  const int ltid = my_tid();
  const int lbid = my_bid();
  (void)ltid; (void)lbid;
  const int lane = ltid & 63;
  const int gw = lbid * 8 + (ltid >> 6), nw = gridDim.x * 8;
  float* hc = (float*)(KWS + OFF_HC);
  const u16* Y = (const u16*)(KWS + OFF_Y);
  u16* XN = (u16*)(KWS + OFF_XN);
  for (int row = gw; row < Mrows; row += nw) {
    int m = row < NLAT ? (row >> 12) : 8;
    float* hp = row < NLAT ? KOUT + (size_t)row * 1024 : hc + (size_t)(row - NLAT) * 1024;
    float4 h[4];
    if (init) {
      const float* src = row < NLAT ? KP(x) + (size_t)row * 1024 : KP(ctx) + (size_t)(row - NLAT) * 1024;
#pragma unroll
      for (int i = 0; i < 4; ++i) h[i] = ((const float4*)src)[lane + 64 * i];
    } else {
#pragma unroll
      for (int i = 0; i < 4; ++i) h[i] = ((const float4*)hp)[lane + 64 * i];
    }
    if (has_y) {
      float4 y[4];
      float ss = 0.f;
#pragma unroll
      for (int i = 0; i < 4; ++i) {
        uint2 u = ((const uint2*)(Y + (size_t)row * 1024))[lane + 64 * i];
        y[i].x = lo2f(u.x); y[i].y = hi2f(u.x); y[i].z = lo2f(u.y); y[i].w = hi2f(u.y);
        ss += y[i].x * y[i].x + y[i].y * y[i].y + y[i].z * y[i].z + y[i].w * y[i].w;
      }
      ss = wave_sum(ss);
      float rs = rsqrtf(ss * (1.f / 1024.f) + 1e-6f) * coef;
#pragma unroll
      for (int i = 0; i < 4; ++i) {
        float4 g = ((const float4*)(mod_gate + (size_t)m * 9216))[lane + 64 * i];
        float4 gp = ((const float4*)gpost)[lane + 64 * i];
        h[i].x += g.x * (y[i].x * rs * gp.x);
        h[i].y += g.y * (y[i].y * rs * gp.y);
        h[i].z += g.z * (y[i].z * rs * gp.z);
        h[i].w += g.w * (y[i].w * rs * gp.w);
      }
    }
    if (init || has_y) {
#pragma unroll
      for (int i = 0; i < 4; ++i) ((float4*)hp)[lane + 64 * i] = h[i];
    }
    if (has_next) {
      float ss = 0.f;
#pragma unroll
      for (int i = 0; i < 4; ++i) ss += h[i].x * h[i].x + h[i].y * h[i].y + h[i].z * h[i].z + h[i].w * h[i].w;
      ss = wave_sum(ss);
      float rs = rsqrtf(ss * (1.f / 1024.f) + 1e-6f);
#pragma unroll
      for (int i = 0; i < 4; ++i) {
        float4 gp = ((const float4*)gpre)[lane + 64 * i];
        float4 sh = ((const float4*)(mod_shift + (size_t)m * 9216))[lane + 64 * i];
        float4 scl = ((const float4*)(mod_scale + (size_t)m * 9216))[lane + 64 * i];
        float a = (h[i].x * rs * gp.x) * (1.f + scl.x) + sh.x;
        float b = (h[i].y * rs * gp.y) * (1.f + scl.y) + sh.y;
        float c = (h[i].z * rs * gp.z) * (1.f + scl.z) + sh.z;
        float d = (h[i].w * rs * gp.w) * (1.f + scl.w) + sh.w;
        uint2 o;
        o.x = pack2(a, b);
        o.y = pack2(c, d);
        ((uint2*)(XN + (size_t)row * 1024))[lane + 64 * i] = o;
      }
    }
  }
}

constexpr int BM = 256, BK = 64, HALF = 128, HT = HALF * BK;
DEV int lds_byte(int r, int c) {
  int st = (r >> 4) * 2 + (c >> 5), rr = r & 15, cc = c & 31, ob = rr * 64 + cc * 2;
  return st * 1024 + (ob ^ (((ob >> 9) & 1) << 5));
}
DEV void stage_rc(int b, int& R, int& C) {
  int st = b / 1024, sb = b % 1024, swz = sb ^ (((sb >> 9) & 1) << 5);
  R = (st >> 1) * 16 + swz / 64;
  C = (st & 1) * 32 + (swz % 64) / 2;
}
enum { EPI_UP = 0, EPI_Y = 1, EPI_Z = 2 };

template <int K, int EPI>
DEV void gemm_phase(const u16* __restrict__ A, const u16* __restrict__ Bt, int M, int N, u16* __restrict__ O0,
                    u16* __restrict__ O1) {
  const int ltid = my_tid();
  const int lbid = my_bid();
  (void)ltid; (void)lbid;
  u16* shm = (u16*)g_smem;
#define SA(b, h) (shm + ((b) * 2 + (h)) * HT)
#define SB(b, h) (shm + (4 + (b) * 2 + (h)) * HT)
#define STAGE(P, GB, kc)                                                                                        \
  do {                                                                                                           \
    __builtin_amdgcn_global_load_lds((const unsigned*)((const char*)(GB) + vb0 + (kc) * (BK * 2)),              \
                                     (unsigned*)((char*)(P) + wbase), 16, 0, 0);                                 \
    __builtin_amdgcn_global_load_lds((const unsigned*)((const char*)(GB) + vb1 + (kc) * (BK * 2)),              \
                                     (unsigned*)((char*)(P) + wbase + 8192), 16, 0, 0);                          \
  } while (0)
#define LDA(dst, b, h)                                                                                 \
  for (int m = 0; m < 4; ++m)                                                                          \
    for (int k = 0; k < 2; ++k)                                                                        \
  dst[m][k] = *reinterpret_cast<const bf16x8*>(aBase + (((b) * 2 + (h)) * 16384 + m * 2048 + k * 1024))
#define LDB(dst, b, h)                                                                                 \
  for (int n = 0; n < 2; ++n)                                                                          \
    for (int k = 0; k < 2; ++k)                                                                        \
  dst[n][k] = *reinterpret_cast<const bf16x8*>(bBase + (((b) * 2 + (h)) * 16384 + n * 2048 + k * 1024))
#define MMA(ai, bj, At_, Bt_)                                                                          \
  do {                                                                                                 \
    __builtin_amdgcn_s_setprio(1);                                                                     \
    for (int m = 0; m < 4; ++m)                                                                        \
      for (int n = 0; n < 2; ++n)                                                                      \
        for (int k = 0; k < 2; ++k)                                                                    \
          acc[ai][bj][m][n] =                                                                          \
              __builtin_amdgcn_mfma_f32_16x16x32_bf16(At_[m][k], Bt_[n][k], acc[ai][bj][m][n], 0, 0, 0); \
    __builtin_amdgcn_s_setprio(0);                                                                     \
  } while (0)
#define WAIT_V(n) asm volatile("s_waitcnt vmcnt(" #n ")" ::: "memory")
#define WAIT_L(n) asm volatile("s_waitcnt lgkmcnt(" #n ")" ::: "memory")
#define BAR __builtin_amdgcn_s_barrier()
#define SCHED __builtin_amdgcn_sched_barrier(0)

  const int tid = ltid;
  const int tid16 = tid * 16;
  unsigned off0, off1;
  {
    int r, c;
    stage_rc(tid16, r, c);
    off0 = (unsigned)(r * K + c) * 2u;
    stage_rc(tid16 + 8192, r, c);
    off1 = (unsigned)(r * K + c) * 2u;
  }
  const int wbase = __builtin_amdgcn_readfirstlane(tid >> 6) * 1024;
  const int wid = tid >> 6, lane = tid & 63, wr = wid >> 2, wc = wid & 3, fr = lane & 15, fq = lane >> 4;
  const int nM = M / BM, nN = N / BM, nwg = nM * nN;
  constexpr int nt = K / BK;
  const int lo_ = lds_byte(fr, fq * 8);
  const char* aBase = (const char*)g_smem + wr * 8192 + lo_;
  const char* bBase = (const char*)g_smem + 65536 + wc * 4096 + lo_;
  constexpr int WGM = 8;
  for (int tix = lbid; tix < nwg; tix += gridDim.x) {
    int wgid = tix;
    {
      int q = nwg / 8, r = nwg % 8, xcd = wgid % 8, off = wgid / 8;
      wgid = (xcd < r ? xcd * (q + 1) : r * (q + 1) + (xcd - r) * q) + off;
    }
    int nig = WGM * nN, gid = wgid / nig, fm = gid * WGM, gsz = min(nM - fm, WGM);
    int pm = fm + ((wgid % nig) % gsz), pn = (wgid % nig) / gsz, brow = pm * BM, bcol = pn * BM;
    f32x4 acc[2][2][4][2];
#pragma unroll
    for (int a = 0; a < 2; ++a)
#pragma unroll
      for (int b = 0; b < 2; ++b)
#pragma unroll
        for (int m = 0; m < 4; ++m)
#pragma unroll
          for (int n = 0; n < 2; ++n) acc[a][b][m][n] = f32x4{0.f, 0.f, 0.f, 0.f};
    bf16x8 At[4][2], B0[2][2], B1[2][2];
    const u16* gA0 = A + (size_t)brow * K;
    const u16* gA1 = gA0 + (size_t)HALF * K;
    const u16* gB0 = Bt + (size_t)bcol * K;
    const u16* gB1 = gB0 + (size_t)HALF * K;
    unsigned vb0 = off0, vb1 = off1;
    STAGE(SB(0, 0), gB0, 0);
    STAGE(SA(0, 0), gA0, 0);
    STAGE(SB(0, 1), gB1, 0);
    STAGE(SA(0, 1), gA1, 0);
    if (wr == 1) BAR;
    WAIT_V(4);
    BAR;
    STAGE(SB(1, 0), gB0, 1);
    STAGE(SA(1, 0), gA0, 1);
    STAGE(SB(1, 1), gB1, 1);
    WAIT_V(6);
    BAR;
#pragma unroll 1
    for (int t = 0; t < nt - 2; t += 2, vb0 += 2 * BK * 2, vb1 += 2 * BK * 2) {
      LDB(B0, 0, 0); SCHED; LDA(At, 0, 0); STAGE(SA(1, 1), gA1, 1);
      WAIT_L(8); BAR; WAIT_L(0); MMA(0, 0, At, B0); BAR; SCHED;
      LDB(B1, 0, 1); STAGE(SB(0, 0), gB0, 2);
      BAR; WAIT_L(0); MMA(0, 1, At, B1); BAR;
      LDA(At, 0, 1); STAGE(SA(0, 0), gA0, 2);
      BAR; WAIT_L(0); MMA(1, 0, At, B0); BAR; SCHED;
      STAGE(SB(0, 1), gB1, 2);
      WAIT_V(6); BAR; MMA(1, 1, At, B1); BAR;
      LDB(B0, 1, 0); SCHED; LDA(At, 1, 0); STAGE(SA(0, 1), gA1, 2);
      WAIT_L(8); BAR; WAIT_L(0); MMA(0, 0, At, B0); BAR; SCHED;
      LDB(B1, 1, 1); STAGE(SB(1, 0), gB0, 3);
      BAR; WAIT_L(0); MMA(0, 1, At, B1); BAR;
      LDA(At, 1, 1); STAGE(SA(1, 0), gA0, 3);
      BAR; WAIT_L(0); MMA(1, 0, At, B0); BAR; SCHED;
      STAGE(SB(1, 1), gB1, 3);
      WAIT_V(6); BAR; MMA(1, 1, At, B1); BAR;
    }
    {
      LDB(B0, 0, 0); LDA(At, 0, 0); STAGE(SA(1, 1), gA1, 1);
      BAR; WAIT_L(0); MMA(0, 0, At, B0); BAR;
      LDB(B1, 0, 1); BAR; WAIT_L(0); MMA(0, 1, At, B1); BAR;
      LDA(At, 0, 1); WAIT_V(4); BAR; WAIT_L(0); MMA(1, 0, At, B0); MMA(1, 1, At, B1); BAR;
    }
    {
      LDB(B0, 1, 0); LDA(At, 1, 0); WAIT_V(2); BAR; WAIT_L(0); MMA(0, 0, At, B0); BAR;
      LDB(B1, 1, 1); WAIT_V(0); BAR; WAIT_L(0); MMA(0, 1, At, B1); BAR;
      LDA(At, 1, 1); BAR; WAIT_L(0); MMA(1, 0, At, B0); MMA(1, 1, At, B1); BAR;
    }
    if (wr == 0) BAR;
#pragma unroll
    for (int ai = 0; ai < 2; ++ai)
#pragma unroll
      for (int bj = 0; bj < 2; ++bj)
#pragma unroll
        for (int m = 0; m < 4; ++m) {
          int rowb = brow + ai * HALF + wr * 64 + m * 16 + fq * 4;
          if (EPI == EPI_UP) {
            int hcol = ((bcol + bj * HALF + wc * 32) >> 1) + fr;
#pragma unroll
            for (int j = 0; j < 4; ++j) {
              float a = acc[ai][bj][m][0][j], b = acc[ai][bj][m][1][j];
              O0[(size_t)(rowb + j) * DFF + hcol] = f2bf(siluf_(a) * b);
            }
          } else {
#pragma unroll
            for (int n = 0; n < 2; ++n) {
              int col = bcol + bj * HALF + wc * 32 + n * 16 + fr;
#pragma unroll
              for (int j = 0; j < 4; ++j) {
                float v = acc[ai][bj][m][n][j];
                if (EPI == EPI_Y) {
                  O0[(size_t)(rowb + j) * DM + col] = f2bf(v);
                } else {
                  if (col < Z1W) O0[(size_t)(rowb + j) * Z1W + col] = f2bf(v);
                  else if (col < PIN) O1[(size_t)(rowb + j) * Z2W + (col - Z1W)] = f2bf(v);
                }
              }
            }
          }
        }
  }
#undef SA
#undef SB
#undef STAGE
#undef LDA
#undef LDB
#undef MMA
}

DEV bf16x8 ld_frag_g(const u16* p) { return *reinterpret_cast<const bf16x8*>(p); }
DEV bf16x8 ld_frag_s(const u16* p) { return *reinterpret_cast<const bf16x8*>(p); }

constexpr int ALD = 392;
constexpr int XLD = 264;
constexpr int GLD = 40;

DEV void phase_prep(PTag p, int l) {
  const int ltid = my_tid();
  const int lbid = my_bid();
  (void)ltid; (void)lbid;
  const int tid = ltid, lane = tid & 63, wid = tid >> 6;
  const int fr = lane & 15, fq = lane >> 4;
  char* ar = KWS + OFF_AR;
  const u16* Z1 = (const u16*)(ar + AR_Z1);
  const u16* Z2 = (const u16*)(ar + AR_Z2);
  u16* RWP = (u16*)(ar + AR_RWP);
  u16* LA = (u16*)(ar + AR_LA);
  float* invn = (float*)(KWS + OFF_INVN);
  u16* Gout = (u16*)(KWS + OFF_Y);
  u16* RGP = (u16*)(KWS + OFF_XN);
  const char* wb = KWS + OFF_WB;
  u16* A_lds = (u16*)g_smem;
  u16* X_lds = (u16*)(g_smem + 50176);
  u16* Gl_lds = (u16*)(g_smem + 50176 + 33792);
  const float* mu = KP(rw_mu) + (size_t)l * 1536;
  const float* k_k = KP(rw_k_k) + (size_t)l * 384;

  for (int tile = lbid; tile < NT / 64; tile += gridDim.x) {
    const int r0 = tile * 64;
    const bool lat = r0 < NLAT;
    const int tpos0 = lat ? (r0 & 4095) : ((r0 - NLAT) & 255);
    const int seglen = lat ? 4096 : 256;
    for (int it = 0; it < 24; ++it) {
      int q = it * NTHREADS + tid;
      int i = q / 192, cc = q % 192, c0 = cc * 8;
      int row = r0 + i, tpos = tpos0 + i;
      const u16* zr = Z2 + (size_t)row * Z2W + c0;
      uint4 own = *(const uint4*)zr;
      uint4 z4 = {0u, 0u, 0u, 0u};
      uint4 n0 = z4, n1 = z4, n2 = z4, n3 = z4;
      if (lat) {
        int gcol = tpos & 63, grow = tpos >> 6;
        if (gcol > 0) n0 = *(const uint4*)(zr - Z2W);
        if (gcol < 63) n1 = *(const uint4*)(zr + Z2W);
        if (grow > 0) n2 = *(const uint4*)(zr - 64 * Z2W);
        if (grow < 63) n3 = *(const uint4*)(zr + 64 * Z2W);
      } else {
        if (tpos > 0) n0 = *(const uint4*)(zr - Z2W);
        if (tpos < 255) n1 = *(const uint4*)(zr + Z2W);
        n2 = n0;
        n3 = n1;
      }
      float4 mu0 = *(const float4*)(mu + c0), mu1 = *(const float4*)(mu + c0 + 4);
      float f[8];
      {
        float o0 = lo2f(own.x), o1 = hi2f(own.x), o2 = lo2f(own.y), o3 = hi2f(own.y);
        float o4 = lo2f(own.z), o5 = hi2f(own.z), o6 = lo2f(own.w), o7 = hi2f(own.w);
        float s0 = lo2f(n0.x), s1 = hi2f(n1.x), s2 = lo2f(n2.y), s3 = hi2f(n3.y);
        float s4 = lo2f(n0.z), s5 = hi2f(n1.z), s6 = lo2f(n2.w), s7 = hi2f(n3.w);
        f[0] = o0 + mu0.x * (s0 - o0);
        f[1] = o1 + mu0.y * (s1 - o1);
        f[2] = o2 + mu0.z * (s2 - o2);
        f[3] = o3 + mu0.w * (s3 - o3);
        f[4] = o4 + mu1.x * (s4 - o4);
        f[5] = o5 + mu1.y * (s5 - o5);
        f[6] = o6 + mu1.z * (s6 - o6);
        f[7] = o7 + mu1.w * (s7 - o7);
      }
      if (c0 < 1152) {
        int arr = c0 / 384, cin = c0 % 384;
        uint4 o;
        o.x = pack2(f[0], f[1]); o.y = pack2(f[2], f[3]); o.z = pack2(f[4], f[5]); o.w = pack2(f[6], f[7]);
        *(uint4*)(RWP + (size_t)arr * NT * 384 + (size_t)row * 384 + cin) = o;
        if (arr == 1) {
          float4 kk0 = *(const float4*)(k_k + cin), kk1 = *(const float4*)(k_k + cin + 4);
          float a0 = f[0] * kk0.x, a1 = f[1] * kk0.y, a2 = f[2] * kk0.z, a3 = f[3] * kk0.w;
          float a4 = f[4] * kk1.x, a5 = f[5] * kk1.y, a6 = f[6] * kk1.z, a7 = f[7] * kk1.w;
          float ss = a0 * a0 + a1 * a1 + a2 * a2 + a3 * a3 + a4 * a4 + a5 * a5 + a6 * a6 + a7 * a7;
          ss += __shfl_xor(ss, 1, 64);
          ss += __shfl_xor(ss, 2, 64);
          ss += __shfl_xor(ss, 4, 64);
          if ((lane & 7) == 0) invn[(size_t)row * 8 + (cin >> 6)] = 1.f / fmaxf(sqrtf(ss), 1e-12f);
        }
      } else {
        int cl = c0 - 1152;
        if (cl < 128) {
#pragma unroll
          for (int e = 0; e < 8; ++e) f[e] = tanhf(f[e]);
        } else if (cl >= 256) {
#pragma unroll
          for (int e = 0; e < 8; ++e) f[e] = sigmoidf_(f[e]);
        }
        uint4 o;
        o.x = pack2(f[0], f[1]); o.y = pack2(f[2], f[3]); o.z = pack2(f[4], f[5]); o.w = pack2(f[6], f[7]);
        *(uint4*)(A_lds + i * ALD + cl) = o;
      }
    }
    {
      const float* cw = KP(rg_conv_w) + (size_t)l * 4 * 256;
      const float* cb = KP(rg_conv_b) + (size_t)l * 256;
      for (int it = 0; it < 4; ++it) {
        int q = it * NTHREADS + tid;
        int i = q >> 5, c0 = (q & 31) * 8;
        int row = r0 + i, tpos = tpos0 + i;
        float accv[8];
        {
          float4 b0 = *(const float4*)(cb + c0), b1 = *(const float4*)(cb + c0 + 4);
          accv[0] = b0.x; accv[1] = b0.y; accv[2] = b0.z; accv[3] = b0.w;
          accv[4] = b1.x; accv[5] = b1.y; accv[6] = b1.z; accv[7] = b1.w;
        }
#pragma unroll
        for (int j = 0; j < 4; ++j) {
          int tt = tpos + j - 2;
          if (tt >= 0 && tt < seglen) {
            uint4 xv = *(const uint4*)(Z1 + (size_t)(row + j - 2) * Z1W + c0);
            float4 w0 = *(const float4*)(cw + j * 256 + c0), w1 = *(const float4*)(cw + j * 256 + c0 + 4);
            accv[0] += w0.x * lo2f(xv.x); accv[1] += w0.y * hi2f(xv.x);
            accv[2] += w0.z * lo2f(xv.y); accv[3] += w0.w * hi2f(xv.y);
            accv[4] += w1.x * lo2f(xv.z); accv[5] += w1.y * hi2f(xv.z);
            accv[6] += w1.z * lo2f(xv.w); accv[7] += w1.w * hi2f(xv.w);
          }
        }
        uint4 o;
        o.x = pack2(accv[0], accv[1]); o.y = pack2(accv[2], accv[3]);
        o.z = pack2(accv[4], accv[5]); o.w = pack2(accv[6], accv[7]);
        *(uint4*)(X_lds + i * XLD + c0) = o;
      }
      {
        int q = tid;
        int i = q >> 3, d = (q >> 2) & 1, ch = q & 3;
        uint4 o = {0u, 0u, 0u, 0u};
        if (ch < 2) o = *(const uint4*)(Z1 + (size_t)(r0 + i) * Z1W + 1664 + d * 16 + ch * 8);
        *(uint4*)(Gl_lds + (d * 64 + i) * GLD + ch * 8) = o;
      }
    }
    __syncthreads();
    for (int u = wid; u < 120; u += 8) {
      int g = u / 24, ntile = u % 24, n0 = ntile * 16;
      int n = n0 + fr;
      f32x4 acc[4];
#pragma unroll
      for (int m = 0; m < 4; ++m) acc[m] = f32x4{0.f, 0.f, 0.f, 0.f};
      if (g < 4) {
        const u16* Bt = (const u16*)(wb + ((g < 2) ? WB_RWW2T : WB_RWA2T)) + (size_t)(g & 1) * 384 * 64;
        bf16x8 b0 = ld_frag_g(Bt + (size_t)n * 64 + fq * 8), b1 = ld_frag_g(Bt + (size_t)n * 64 + 32 + fq * 8);
#pragma unroll
        for (int m = 0; m < 4; ++m) {
          const u16* ap = A_lds + (m * 16 + fr) * ALD + g * 64 + fq * 8;
          acc[m] = __builtin_amdgcn_mfma_f32_16x16x32_bf16(ld_frag_s(ap), b0, acc[m], 0, 0, 0);
          acc[m] = __builtin_amdgcn_mfma_f32_16x16x32_bf16(ld_frag_s(ap + 32), b1, acc[m], 0, 0, 0);
        }
      } else {
        const u16* Bt = (const u16*)(wb + WB_RWG2T);
        bf16x8 b[4];
#pragma unroll
        for (int k = 0; k < 4; ++k) b[k] = ld_frag_g(Bt + (size_t)n * 128 + k * 32 + fq * 8);
#pragma unroll
        for (int m = 0; m < 4; ++m) {
          const u16* ap = A_lds + (m * 16 + fr) * ALD + 256 + fq * 8;
#pragma unroll
          for (int k = 0; k < 4; ++k)
            acc[m] = __builtin_amdgcn_mfma_f32_16x16x32_bf16(ld_frag_s(ap + k * 32), b[k], acc[m], 0, 0, 0);
        }
      }
      if (g < 2) {
        float w0v = KP(rw_w0)[(size_t)(l * 2 + g) * 384 + n];
        u16* dst = RWP + (size_t)(3 + g) * NT * 384;
#pragma unroll
        for (int m = 0; m < 4; ++m)
#pragma unroll
          for (int j = 0; j < 4; ++j) {
            int row = r0 + m * 16 + fq * 4 + j;
            dst[(size_t)row * 384 + n] = f2bf(sigmoidf_(w0v + acc[m][j]) * 0.60653066f);
          }
      } else if (g < 4) {
        float a0v = KP(rw_a0)[(size_t)(l * 2 + (g - 2)) * 384 + n];
        u16* dst = RWP + (size_t)(5 + (g - 2)) * NT * 384;
#pragma unroll
        for (int m = 0; m < 4; ++m)
#pragma unroll
          for (int j = 0; j < 4; ++j) {
            int row = r0 + m * 16 + fq * 4 + j;
            dst[(size_t)row * 384 + n] = f2bf(sigmoidf_(a0v + acc[m][j]));
          }
      } else {
#pragma unroll
        for (int m = 0; m < 4; ++m)
#pragma unroll
          for (int j = 0; j < 4; ++j) {
            int row = r0 + m * 16 + fq * 4 + j;
            Gout[(size_t)row * 384 + n] = f2bf(acc[m][j]);
          }
      }
    }
    for (int u = wid; u < 32; u += 8) {
      int d = u >> 4, hd = (u >> 2) & 3, ntile = u & 3;
      int nl = ntile * 16 + fr;
      int ch = hd * 64 + nl;
      const u16* Ba = (const u16*)(wb + WB_RGGT) + (size_t)((d * 2 + 0) * 4 + hd) * 4096 + nl * 64;
      const u16* Bx = (const u16*)(wb + WB_RGGT) + (size_t)((d * 2 + 1) * 4 + hd) * 4096 + nl * 64;
      bf16x8 ba0 = ld_frag_g(Ba + fq * 8), ba1 = ld_frag_g(Ba + 32 + fq * 8);
      bf16x8 bx0 = ld_frag_g(Bx + fq * 8), bx1 = ld_frag_g(Bx + 32 + fq * 8);
      float gab = KP(rg_gate_a_b)[(size_t)(l * 2 + d) * 256 + ch];
      float gxb = KP(rg_gate_x_b)[(size_t)(l * 2 + d) * 256 + ch];
      float lam = KP(rg_lambda)[(size_t)(l * 2 + d) * 256 + ch];
      float spl = log1pf(__expf(-lam)) * 8.f;
      u16* dla = RGP + (size_t)(d * 2 + 0) * NT * 256;
      u16* dbx = RGP + (size_t)(d * 2 + 1) * NT * 256;
#pragma unroll
      for (int m = 0; m < 4; ++m) {
        const u16* ap = X_lds + (m * 16 + fr) * XLD + hd * 64 + fq * 8;
        bf16x8 a0 = ld_frag_s(ap), a1 = ld_frag_s(ap + 32);
        f32x4 ca = f32x4{0.f, 0.f, 0.f, 0.f}, cx = ca;
        ca = __builtin_amdgcn_mfma_f32_16x16x32_bf16(a0, ba0, ca, 0, 0, 0);
        ca = __builtin_amdgcn_mfma_f32_16x16x32_bf16(a1, ba1, ca, 0, 0, 0);
        cx = __builtin_amdgcn_mfma_f32_16x16x32_bf16(a0, bx0, cx, 0, 0, 0);
        cx = __builtin_amdgcn_mfma_f32_16x16x32_bf16(a1, bx1, cx, 0, 0, 0);
#pragma unroll
        for (int j = 0; j < 4; ++j) {
          int il = m * 16 + fq * 4 + j;
          int row = r0 + il;
          float r = sigmoidf_(ca[j] + gab), ig = sigmoidf_(cx[j] + gxb);
          float loga = -r * spl;
          float mult = sqrtf(fmaxf(-expm1f(2.f * loga), 0.f));
          float xc = bf2f(X_lds[il * XLD + ch]);
          dla[(size_t)row * 256 + ch] = f2bf(loga);
          dbx[(size_t)row * 256 + ch] = f2bf(mult * ig * xc);
        }
      }
    }
    for (int u = wid; u < 24; u += 8) {
      int d = u / 12, ntile = u % 12;
      int n = ntile * 16 + fr;
      const u16* Bt = (const u16*)(wb + WB_GLAT) + (size_t)d * 192 * 32;
      bf16x8 b0 = ld_frag_g(Bt + (size_t)n * 32 + fq * 8);
      float bb = KP(gla_alpha_b)[(size_t)(l * 2 + d) * 192 + n];
      u16* dst = LA + (size_t)d * NT * 192;
#pragma unroll
      for (int m = 0; m < 4; ++m) {
        const u16* ap = Gl_lds + (d * 64 + m * 16 + fr) * GLD + fq * 8;
        f32x4 cacc = f32x4{0.f, 0.f, 0.f, 0.f};
        cacc = __builtin_amdgcn_mfma_f32_16x16x32_bf16(ld_frag_s(ap), b0, cacc, 0, 0, 0);
#pragma unroll
        for (int j = 0; j < 4; ++j) {
          int row = r0 + m * 16 + fq * 4 + j;
          dst[(size_t)row * 192 + n] = f2bf(log_sigmoidf_(cacc[j] + bb) * (1.f / 16.f));
        }
      }
    }
    __syncthreads();
  }
}

constexpr int TC = 32;
constexpr int NSTEP = 4352;

DEV void scan_rwkv(PTag p, int l, int task) {
  const int ltid = my_tid();
  const int lbid = my_bid();
  (void)ltid; (void)lbid;
  const int tid = ltid, lane = tid & 63, w = tid >> 6;
  const int b = task / 12, h = (task % 12) >> 1, dir = task & 1;
  char* ar = KWS + OFF_AR;
  const u16* RWP = (const u16*)(ar + AR_RWP);
  const u16* Rg = RWP, *Kg = RWP + (size_t)NT * 384, *Vg = RWP + (size_t)2 * NT * 384;
  const u16* Ug = RWP + (size_t)(3 + dir) * NT * 384, *Ag = RWP + (size_t)(5 + dir) * NT * 384;
  const float* invn = (const float*)(KWS + OFF_INVN);
  u16* Yd = (u16*)(ar + AR_Z2) + (size_t)dir * NT * 384;
  float* buf = (float*)g_smem;
  float* ybuf = buf + 2 * TC * 384;
  const int rl = lane >> 3, kg = lane & 7;
  const int lstep = tid >> 4, lq = tid & 15;
  const int ce = h * 64 + lq * 4;
  float4 kkc = *(const float4*)(KP(rw_k_k) + (size_t)l * 384 + ce);
  float4 kac = *(const float4*)(KP(rw_k_a) + (size_t)l * 384 + ce);
  float S[8];
#pragma unroll
  for (int j = 0; j < 8; ++j) S[j] = 0.f;

  uint2 gr, gk, gv, gu, ga;
  float gin;
  auto issue = [&](int c) {
    int row = seq_row(b, dir, c * TC + lstep);
    size_t o = (size_t)row * 384 + ce;
    gr = *(const uint2*)(Rg + o);
    gk = *(const uint2*)(Kg + o);
    gv = *(const uint2*)(Vg + o);
    gu = *(const uint2*)(Ug + o);
    ga = *(const uint2*)(Ag + o);
    gin = invn[(size_t)row * 8 + h];
  };
  auto commit = [&](int c) {
    float* d = buf + (size_t)((c & 1) * TC + lstep) * 384 + lq * 4;
    float r0 = lo2f(gr.x), r1 = hi2f(gr.x), r2 = lo2f(gr.y), r3 = hi2f(gr.y);
    float k0 = lo2f(gk.x), k1 = hi2f(gk.x), k2 = lo2f(gk.y), k3 = hi2f(gk.y);
    float v0 = lo2f(gv.x), v1 = hi2f(gv.x), v2 = lo2f(gv.y), v3 = hi2f(gv.y);
    float u0 = lo2f(gu.x), u1 = hi2f(gu.x), u2 = lo2f(gu.y), u3 = hi2f(gu.y);
    float a0 = lo2f(ga.x), a1 = hi2f(ga.x), a2 = lo2f(ga.y), a3 = hi2f(ga.y);
    *(float4*)(d + 0) = make_float4(__expf(-u0), __expf(-u1), __expf(-u2), __expf(-u3));
    *(float4*)(d + 64) = make_float4(k0 * (1.f + (a0 - 1.f) * kac.x), k1 * (1.f + (a1 - 1.f) * kac.y),
                                     k2 * (1.f + (a2 - 1.f) * kac.z), k3 * (1.f + (a3 - 1.f) * kac.w));
    float q0 = k0 * kkc.x * gin, q1 = k1 * kkc.y * gin, q2 = k2 * kkc.z * gin, q3 = k3 * kkc.w * gin;
    *(float4*)(d + 128) = make_float4(-q0, -q1, -q2, -q3);
    *(float4*)(d + 192) = make_float4(q0 * a0, q1 * a1, q2 * a2, q3 * a3);
    *(float4*)(d + 256) = make_float4(r0, r1, r2, r3);
    *(float4*)(d + 320) = make_float4(v0, v1, v2, v3);
  };
  issue(0);
  commit(0);
  __syncthreads();
  constexpr int NCH = NSTEP / TC;
#pragma unroll 1
  for (int c = 0; c < NCH; ++c) {
    if (c + 1 < NCH) issue(c + 1);
    const float* cb = buf + (size_t)(c & 1) * TC * 384;
    float* yb = ybuf + (c & 1) * TC * 64;
#pragma unroll 4
    for (int s = 0; s < TC; ++s) {
      const float* sb = cb + s * 384 + kg * 8;
      float4 w0 = *(const float4*)(sb), w1 = *(const float4*)(sb + 4);
      float4 k0 = *(const float4*)(sb + 64), k1 = *(const float4*)(sb + 68);
      float4 a0 = *(const float4*)(sb + 128), a1 = *(const float4*)(sb + 132);
      float4 b0 = *(const float4*)(sb + 192), b1 = *(const float4*)(sb + 196);
      float4 r0 = *(const float4*)(sb + 256), r1 = *(const float4*)(sb + 260);
      float vv = cb[s * 384 + 320 + w * 8 + rl];
      float sa = S[0] * a0.x;
      sa = fmaf(S[1], a0.y, sa); sa = fmaf(S[2], a0.z, sa); sa = fmaf(S[3], a0.w, sa);
      sa = fmaf(S[4], a1.x, sa); sa = fmaf(S[5], a1.y, sa); sa = fmaf(S[6], a1.z, sa); sa = fmaf(S[7], a1.w, sa);
      sa = oct_sum(sa);
      S[0] = fmaf(S[0], w0.x, fmaf(sa, b0.x, vv * k0.x));
      S[1] = fmaf(S[1], w0.y, fmaf(sa, b0.y, vv * k0.y));
      S[2] = fmaf(S[2], w0.z, fmaf(sa, b0.z, vv * k0.z));
      S[3] = fmaf(S[3], w0.w, fmaf(sa, b0.w, vv * k0.w));
      S[4] = fmaf(S[4], w1.x, fmaf(sa, b1.x, vv * k1.x));
      S[5] = fmaf(S[5], w1.y, fmaf(sa, b1.y, vv * k1.y));
      S[6] = fmaf(S[6], w1.z, fmaf(sa, b1.z, vv * k1.z));
      S[7] = fmaf(S[7], w1.w, fmaf(sa, b1.w, vv * k1.w));
      float y = S[0] * r0.x;
      y = fmaf(S[1], r0.y, y); y = fmaf(S[2], r0.z, y); y = fmaf(S[3], r0.w, y);
      y = fmaf(S[4], r1.x, y); y = fmaf(S[5], r1.y, y); y = fmaf(S[6], r1.z, y); y = fmaf(S[7], r1.w, y);
      y = oct_sum(y);
      if (kg == 0) yb[s * 64 + w * 8 + rl] = y;
    }
    if (c + 1 < NCH) commit(c + 1);
    __syncthreads();
    {
      int row = seq_row(b, dir, c * TC + lstep);
      float4 yv = *(const float4*)(yb + lstep * 64 + lq * 4);
      uint2 o;
      o.x = pack2(yv.x, yv.y);
      o.y = pack2(yv.z, yv.w);
      *(uint2*)(Yd + (size_t)row * 384 + ce) = o;
    }
  }
  __syncthreads();
}

DEV void scan_gla(PTag p, int l, int task) {
  const int ltid = my_tid();
  const int lbid = my_bid();
  (void)ltid; (void)lbid;
  const int tid = ltid, lane = tid & 63, w = tid >> 6;
  const int b = task >> 3, hd = (task >> 1) & 3, dir = task & 1;
  char* ar = KWS + OFF_AR;
  const u16* Z1 = (const u16*)(ar + AR_Z1);
  const u16* LAg = (const u16*)(ar + AR_LA) + (size_t)dir * NT * 192;
  u16* Od = (u16*)(ar + AR_Z2) + (size_t)(2 + dir) * NT * 384;
  float* buf = (float*)g_smem;
  float* obuf = buf + 2 * TC * 240;
  const int el = lane >> 2, dg = lane & 3;
  const int e = w * 16 + el;
  const int lstep = tid >> 4, lq = tid & 15;
  float S[12];
#pragma unroll
  for (int j = 0; j < 12; ++j) S[j] = 0.f;
  uint2 gq, gk, gl_, gv0, gv1;
  auto issue = [&](int c) {
    int row = seq_row(b, dir, c * TC + lstep);
    const u16* zr = Z1 + (size_t)row * Z1W;
    uint2 z = {0u, 0u};
    gq = z; gk = z; gl_ = z; gv1 = z;
    if (lq < 12) {
      gq = *(const uint2*)(zr + 512 + hd * 48 + lq * 4);
      gk = *(const uint2*)(zr + 704 + hd * 48 + lq * 4);
      gl_ = *(const uint2*)(LAg + (size_t)row * 192 + hd * 48 + lq * 4);
    }
    gv0 = *(const uint2*)(zr + 896 + hd * 96 + lq * 4);
    if (lq < 8) gv1 = *(const uint2*)(zr + 896 + hd * 96 + 64 + lq * 4);
  };
  auto commit = [&](int c) {
    float* d = buf + (size_t)((c & 1) * TC + lstep) * 240;
    const float qs = 0.14433756729740643f;
    if (lq < 12) {
      *(float4*)(d + lq * 4) = make_float4(__expf(lo2f(gl_.x)), __expf(hi2f(gl_.x)), __expf(lo2f(gl_.y)), __expf(hi2f(gl_.y)));
      *(float4*)(d + 48 + lq * 4) = make_float4(lo2f(gk.x), hi2f(gk.x), lo2f(gk.y), hi2f(gk.y));
      *(float4*)(d + 96 + lq * 4) = make_float4(lo2f(gq.x) * qs, hi2f(gq.x) * qs, lo2f(gq.y) * qs, hi2f(gq.y) * qs);
    }
    *(float4*)(d + 144 + lq * 4) = make_float4(lo2f(gv0.x), hi2f(gv0.x), lo2f(gv0.y), hi2f(gv0.y));
    if (lq < 8) *(float4*)(d + 144 + 64 + lq * 4) = make_float4(lo2f(gv1.x), hi2f(gv1.x), lo2f(gv1.y), hi2f(gv1.y));
  };
  issue(0);
  commit(0);
  __syncthreads();
  constexpr int NCH = NSTEP / TC;
#pragma unroll 1
  for (int c = 0; c < NCH; ++c) {
    if (c + 1 < NCH) issue(c + 1);
    const float* cb = buf + (size_t)(c & 1) * TC * 240;
    float* ob = obuf + (c & 1) * TC * 96;
    if (w < 6) {
#pragma unroll 4
      for (int s = 0; s < TC; ++s) {
        const float* sb = cb + s * 240 + dg * 12;
        float4 a0 = *(const float4*)(sb), a1 = *(const float4*)(sb + 4), a2 = *(const float4*)(sb + 8);
        float4 k0 = *(const float4*)(sb + 48), k1 = *(const float4*)(sb + 52), k2 = *(const float4*)(sb + 56);
        float4 q0 = *(const float4*)(sb + 96), q1 = *(const float4*)(sb + 100), q2 = *(const float4*)(sb + 104);
        float vv = cb[s * 240 + 144 + e];
        S[0] = fmaf(a0.x, S[0], k0.x * vv); S[1] = fmaf(a0.y, S[1], k0.y * vv);
        S[2] = fmaf(a0.z, S[2], k0.z * vv); S[3] = fmaf(a0.w, S[3], k0.w * vv);
        S[4] = fmaf(a1.x, S[4], k1.x * vv); S[5] = fmaf(a1.y, S[5], k1.y * vv);
        S[6] = fmaf(a1.z, S[6], k1.z * vv); S[7] = fmaf(a1.w, S[7], k1.w * vv);
        S[8] = fmaf(a2.x, S[8], k2.x * vv); S[9] = fmaf(a2.y, S[9], k2.y * vv);
        S[10] = fmaf(a2.z, S[10], k2.z * vv); S[11] = fmaf(a2.w, S[11], k2.w * vv);
        float o = q0.x * S[0];
        o = fmaf(q0.y, S[1], o); o = fmaf(q0.z, S[2], o); o = fmaf(q0.w, S[3], o);
        o = fmaf(q1.x, S[4], o); o = fmaf(q1.y, S[5], o); o = fmaf(q1.z, S[6], o); o = fmaf(q1.w, S[7], o);
        o = fmaf(q2.x, S[8], o); o = fmaf(q2.y, S[9], o); o = fmaf(q2.z, S[10], o); o = fmaf(q2.w, S[11], o);
        o = quad_sum(o);
        if (dg == 0) ob[s * 96 + e] = o;
      }
    }
    if (c + 1 < NCH) commit(c + 1);
    __syncthreads();
    {
      int row = seq_row(b, dir, c * TC + lstep);
      u16* orow = Od + (size_t)row * 384 + hd * 96;
      float4 v0 = *(const float4*)(ob + lstep * 96 + lq * 4);
      uint2 o;
      o.x = pack2(v0.x, v0.y); o.y = pack2(v0.z, v0.w);
      *(uint2*)(orow + lq * 4) = o;
      if (lq < 8) {
        float4 v1 = *(const float4*)(ob + lstep * 96 + 64 + lq * 4);
        o.x = pack2(v1.x, v1.y); o.y = pack2(v1.z, v1.w);
        *(uint2*)(orow + 64 + lq * 4) = o;
      }
    }
  }
  __syncthreads();
}

DEV void scan_rg(PTag p, int task) {
  const int ltid = my_tid();
  const int lbid = my_bid();
  (void)ltid; (void)lbid;
  const int tid = ltid;
  const int b = task >> 3, dir = (task >> 2) & 1, cq = task & 3;
  const u16* RGP = (const u16*)(KWS + OFF_XN);
  const u16* LAg = RGP + (size_t)(dir * 2 + 0) * NT * 256;
  const u16* BXg = RGP + (size_t)(dir * 2 + 1) * NT * 256;
  u16* Hd = (u16*)(KWS + OFF_Y) + (size_t)NT * 384 + (size_t)dir * NT * 256;
  float* sA = (float*)g_smem;
  float* sB = sA + 512;
  const int tcn = tid >> 6, lc = tid & 63, ch = cq * 64 + lc;
  const int s0 = tcn * 544;
  float A = 1.f, B = 0.f;
#pragma unroll 8
  for (int s = 0; s < 544; ++s) {
    int row = seq_row(b, dir, s0 + s);
    float la = bf2f(LAg[(size_t)row * 256 + ch]);
    float bx = bf2f(BXg[(size_t)row * 256 + ch]);
    float a = __expf(la);
    B = fmaf(a, B, bx);
    A *= a;
  }
  sA[tid] = A;
  sB[tid] = B;
  __syncthreads();
  float hst = 0.f;
  for (int c2 = 0; c2 < tcn; ++c2) hst = fmaf(sA[c2 * 64 + lc], hst, sB[c2 * 64 + lc]);
#pragma unroll 8
  for (int s = 0; s < 544; ++s) {
    int row = seq_row(b, dir, s0 + s);
    float la = bf2f(LAg[(size_t)row * 256 + ch]);
    float bx = bf2f(BXg[(size_t)row * 256 + ch]);
    float a = __expf(la);
    hst = fmaf(a, hst, bx);
    Hd[(size_t)row * 256 + ch] = f2bf(hst);
  }
  __syncthreads();
}

DEV void phase_scan(PTag p, int l) {
  const int ltid = my_tid();
  const int lbid = my_bid();
  (void)ltid; (void)lbid;
  for (int task = lbid; task < 224; task += gridDim.x) {
    if (task < 96) scan_rwkv(p, l, task);
    else if (task < 160) scan_gla(p, l, task - 96);
    else scan_rg(p, task - 160);
  }
}

DEV float gelu_tanh(float x) {
  float u = 0.7978845608028654f * (x + 0.044715f * x * x * x);
  return 0.5f * x * (1.f + tanhf(u));
}
DEV void phase_post(PTag p, int l) {
  const int ltid = my_tid();
  const int lbid = my_bid();
  (void)ltid; (void)lbid;
  const int lane = ltid & 63;
  const int gw = lbid * 8 + (ltid >> 6), nw = gridDim.x * 8;
  char* ar = KWS + OFF_AR;
  const u16* Z1 = (const u16*)(ar + AR_Z1);
  const u16* RWP = (const u16*)(ar + AR_RWP);
  const u16* RWY = (const u16*)(ar + AR_Z2);
  const u16* Gg = (const u16*)(KWS + OFF_Y);
  const u16* RGH = Gg + (size_t)NT * 384;
  u16* YM = (u16*)(KWS + OFF_XN);
  const float* gnorm = KP(gla_norm) + (size_t)l * 96;
  const float* r_k = KP(rw_r_k) + (size_t)l * 384;
  const float* k_a = KP(rw_k_a) + (size_t)l * 384;
  const float* ln_w = KP(rw_ln_w) + (size_t)l * 384;
  const float* ln_b = KP(rw_ln_b) + (size_t)l * 384;
  for (int row = gw; row < NT; row += nw) {
    {
      uint2 hf = *(const uint2*)(RGH + (size_t)row * 256 + lane * 4);
      uint2 hb = *(const uint2*)(RGH + (size_t)NT * 256 + (size_t)row * 256 + lane * 4);
      uint2 gb = *(const uint2*)(Z1 + (size_t)row * Z1W + 256 + lane * 4);
      float y0 = (lo2f(hf.x) + lo2f(hb.x)) * gelu_tanh(lo2f(gb.x));
      float y1 = (hi2f(hf.x) + hi2f(hb.x)) * gelu_tanh(hi2f(gb.x));
      float y2 = (lo2f(hf.y) + lo2f(hb.y)) * gelu_tanh(lo2f(gb.y));
      float y3 = (hi2f(hf.y) + hi2f(hb.y)) * gelu_tanh(hi2f(gb.y));
      uint2 o;
      o.x = pack2(y0, y1); o.y = pack2(y2, y3);
      *(uint2*)(YM + (size_t)row * 1024 + lane * 4) = o;
    }
    {
      const u16* of = RWY + (size_t)2 * NT * 384 + (size_t)row * 384;
      const u16* ob = RWY + (size_t)3 * NT * 384 + (size_t)row * 384;
      const u16* og = Z1 + (size_t)row * Z1W + 1280;
#pragma unroll
      for (int hd = 0; hd < 4; ++hd) {
        float v0 = bf2f(of[hd * 96 + lane]) + bf2f(ob[hd * 96 + lane]);
        float v1 = 0.f;
        if (lane < 32) v1 = bf2f(of[hd * 96 + 64 + lane]) + bf2f(ob[hd * 96 + 64 + lane]);
        float ss = wave_sum(v0 * v0 + v1 * v1);
        float rs = rsqrtf(ss * (1.f / 96.f) + 1e-6f);
        float g0 = bf2f(og[hd * 96 + lane]);
        YM[(size_t)row * 1024 + 256 + hd * 96 + lane] = f2bf(v0 * rs * gnorm[lane] * siluf_(g0));
        if (lane < 32) {
          float g1 = bf2f(og[hd * 96 + 64 + lane]);
          YM[(size_t)row * 1024 + 256 + hd * 96 + 64 + lane] = f2bf(v1 * rs * gnorm[64 + lane] * siluf_(g1));
        }
      }
    }
    {
      size_t ro = (size_t)row * 384;
#pragma unroll
      for (int j = 0; j < 6; ++j) {
        int idx = j * 64 + lane;
        float y = bf2f(RWY[ro + idx]) + bf2f(RWY[(size_t)NT * 384 + ro + idx]);
        float mean = wave_sum(y) * (1.f / 64.f);
        float dlt = y - mean;
        float var = wave_sum(dlt * dlt) * (1.f / 64.f);
        float yn = dlt * rsqrtf(var + 64e-5f) * ln_w[idx] + ln_b[idx];
        float r = bf2f(RWP[ro + idx]);
        float k = bf2f(RWP[(size_t)NT * 384 + ro + idx]);
        float v = bf2f(RWP[(size_t)2 * NT * 384 + ro + idx]);
        float af = bf2f(RWP[(size_t)5 * NT * 384 + ro + idx]);
        float ab = bf2f(RWP[(size_t)6 * NT * 384 + ro + idx]);
        float bon = wave_sum(r * k * r_k[idx] * (2.f + (af + ab - 2.f) * k_a[idx]));
        yn += bon * v;
        float g = bf2f(Gg[ro + idx]);
        YM[(size_t)row * 1024 + 640 + idx] = f2bf(yn * g);
      }
    }
  }
}

constexpr int NPHASES = 2 + 12 * 4;

DEV void run_phase(PTag p, int ph) {
  float* mod = (float*)(KWS + OFF_MOD);
  char* ws = KWS;
  u16* XN = (u16*)(ws + OFF_XN);
  u16* Yb = (u16*)(ws + OFF_Y);
  u16* U = (u16*)(ws + OFF_AR);
  if (ph == 0) {
    phase_adaln(p);
    __syncthreads();
    conv_ffn(p, 0, 0);
    return;
  }
  if (ph == 1) {
    phase_rows(p, 1, 0, nullptr, nullptr, 0.f, 1, KP(norm_pre) + 0, mod + 0 * 1024, mod + 1 * 1024, NT);
    return;
  }
  int q = ph - 2, l = q / 12, k = q % 12;
  const float* modl = mod + (size_t)l * 9 * 9216;
  const bool last = (l == 3);
  const int Mlate = last ? NLAT : NT;
  switch (k) {
    case 0:
      gemm_phase<1024, EPI_UP>(XN, (const u16*)(ws + OFF_WB + WB_W13T), NT, 5632, U, nullptr);
      break;
    case 1:
      gemm_phase<2816, EPI_Y>(U, (const u16*)(ws + OFF_WB + WB_W2T), NT, 1024, Yb, nullptr);
      break;
    case 2:
      phase_rows(p, 0, 1, KP(norm_post) + (size_t)(l * 3 + 0) * 1024, modl + 2 * 1024, 0.5f, 1,
                 KP(norm_pre) + (size_t)(l * 3 + 1) * 1024, modl + 3 * 1024, modl + 4 * 1024, NT);
      conv_mixer(p, l);
      break;
    case 3:
      gemm_phase<1024, EPI_Z>(XN, (const u16*)(ws + OFF_WB + WB_WINT), NT, PINP, (u16*)(ws + OFF_AR + AR_Z1),
                              (u16*)(ws + OFF_AR + AR_Z2));
      break;
    case 4:
      phase_prep(p, l);
      break;
    case 5:
      phase_scan(p, l);
      break;
    case 6:
      phase_post(p, l);
      break;
    case 7:
      gemm_phase<1024, EPI_Y>(XN, (const u16*)(ws + OFF_WB + WB_WOUTT), Mlate, 1024, Yb, nullptr);
      break;
    case 8:
      phase_rows(p, 0, 1, KP(norm_post) + (size_t)(l * 3 + 1) * 1024, modl + 5 * 1024, 1.0f, 1,
                 KP(norm_pre) + (size_t)(l * 3 + 2) * 1024, modl + 6 * 1024, modl + 7 * 1024, Mlate);
      conv_ffn(p, l, 1);
      break;
    case 9:
      gemm_phase<1024, EPI_UP>(XN, (const u16*)(ws + OFF_WB + WB_W13T), Mlate, 5632, U, nullptr);
      break;
    case 10:
      gemm_phase<2816, EPI_Y>(U, (const u16*)(ws + OFF_WB + WB_W2T), Mlate, 1024, Yb, nullptr);
      break;
    case 11:
      if (!last) {
        const float* modn = mod + (size_t)(l + 1) * 9 * 9216;
        phase_rows(p, 0, 1, KP(norm_post) + (size_t)(l * 3 + 2) * 1024, modl + 8 * 1024, 0.5f, 1,
                   KP(norm_pre) + (size_t)((l + 1) * 3 + 0) * 1024, modn + 0 * 1024, modn + 1 * 1024, NT);
        conv_ffn(p, l + 1, 0);
      } else {
        phase_rows(p, 0, 1, KP(norm_post) + (size_t)(l * 3 + 2) * 1024, modl + 8 * 1024, 0.5f, 0, nullptr, nullptr,
                   nullptr, NLAT);
      }
      break;
  }
}

__global__ void __launch_bounds__(NTHREADS, 2) mega_kernel(Params params_, int ph_lo, int ph_hi) {
  PTag p;
  cg::grid_group grid = cg::this_grid();
  for (int ph = ph_lo; ph < ph_hi; ++ph) {
    if (ph > ph_lo) grid.sync();
    run_phase(p, ph);
  }
}

extern "C" void kernel_launch(void* const* d_in, const int* in_sizes, int n_in, void* d_out, int out_size, void* d_ws,
                              size_t ws_size, hipStream_t stream) {
  static int grid_blocks = 0;
  if (!grid_blocks) {
    int dev = 0, cus = 0, per_cu = 0;
    hipGetDevice(&dev);
    hipDeviceGetAttribute(&cus, hipDeviceAttributeMultiprocessorCount, dev);
    hipFuncSetAttribute((const void*)mega_kernel, hipFuncAttributeMaxDynamicSharedMemorySize, (int)SMEM_BYTES);
    hipOccupancyMaxActiveBlocksPerMultiprocessor(&per_cu, mega_kernel, NTHREADS, SMEM_BYTES);
    if (per_cu < 1) per_cu = 1;
    grid_blocks = cus * per_cu;
    if (ws_size < WS_TOTAL) fprintf(stderr, "workspace too small: %zu < %zu\n", ws_size, (size_t)WS_TOTAL);
  }
  Params p{};
  const float** pp = (const float**)&p;
  for (int i = 0; i < 34; ++i) pp[i] = (const float*)d_in[i];
  p.out = (float*)d_out;
  p.ws = (char*)d_ws;
#ifdef MULTI_LAUNCH
  for (int ph = 0; ph < NPHASES; ++ph) {
    hipLaunchKernelGGL(mega_kernel, dim3(grid_blocks), dim3(NTHREADS), SMEM_BYTES, stream, p, ph, ph + 1);
  }
#else
  int lo = 0, hi = NPHASES;
  void* args[] = {&p, &lo, &hi};
  hipError_t e = hipLaunchCooperativeKernel((const void*)mega_kernel, dim3(grid_blocks), dim3(NTHREADS), args,
                                            SMEM_BYTES, stream);
  if (e != hipSuccess) fprintf(stderr, "cooperative launch failed: %s (grid %d)\n", hipGetErrorString(e), grid_blocks);
#endif
}
```

```cpp
#include <hip/hip_runtime.h>
#include <hip/hip_cooperative_groups.h>
#include <cstdio>
namespace cg = cooperative_groups;

typedef unsigned short u16;
using bf16x8 = __attribute__((ext_vector_type(8))) short;
using f32x4 = __attribute__((ext_vector_type(4))) float;

#define DEV __device__ __forceinline__

constexpr int NLAT = 32768, NCTXR = 2048, NT = 34816;
constexpr int DM = 1024, DFF = 2816, PIN = 3232, PINP = 3328;
constexpr int Z1W = 1696, Z2W = 1536;
constexpr int NTHREADS = 512;
constexpr size_t SMEM_BYTES = 131072;

constexpr size_t OFF_MOD = 0;
constexpr size_t SZ_MOD = 4ull * 9 * 9216 * 4;
constexpr size_t OFF_HC = OFF_MOD + SZ_MOD;
constexpr size_t SZ_HC = 2048ull * 1024 * 4;
constexpr size_t OFF_INVN = OFF_HC + SZ_HC;
constexpr size_t SZ_INVN = (size_t)NT * 8 * 4;
constexpr size_t OFF_WB = OFF_INVN + SZ_INVN;
constexpr size_t SZ_WB = 5632ull * 1024 * 2 + 1024ull * 2816 * 2;
constexpr size_t OFF_XN = OFF_WB + SZ_WB;
constexpr size_t SZ_XN = (size_t)NT * 1024 * 2;
constexpr size_t OFF_Y = OFF_XN + SZ_XN;
constexpr size_t SZ_Y = SZ_XN;
constexpr size_t OFF_AR = OFF_Y + SZ_Y;
constexpr size_t SZ_384 = (size_t)NT * 384 * 2;
constexpr size_t SZ_256 = (size_t)NT * 256 * 2;
constexpr size_t SZ_192 = (size_t)NT * 192 * 2;
constexpr size_t AR_Z1 = 0;
constexpr size_t AR_Z2 = AR_Z1 + (size_t)NT * Z1W * 2;
constexpr size_t AR_RWP = AR_Z2 + (size_t)NT * Z2W * 2;
constexpr size_t AR_LA = AR_RWP + 7 * SZ_384;
constexpr size_t SZ_AR = AR_LA + 2 * SZ_192;
constexpr size_t WS_TOTAL = OFF_AR + SZ_AR;
constexpr size_t WB_W13T = 0;
constexpr size_t WB_W2T = 5632ull * 1024 * 2;
constexpr size_t WB_WINT = 0;
constexpr size_t WB_WOUTT = WB_WINT + 3328ull * 1024 * 2;
constexpr size_t WB_RWW2T = WB_WOUTT + 1024ull * 1024 * 2;
constexpr size_t WB_RWA2T = WB_RWW2T + 2ull * 384 * 64 * 2;
constexpr size_t WB_RWG2T = WB_RWA2T + 2ull * 384 * 64 * 2;
constexpr size_t WB_RGGT = WB_RWG2T + 384ull * 128 * 2;
constexpr size_t WB_GLAT = WB_RGGT + 16ull * 64 * 64 * 2;

struct Params {
  const float *x, *c, *ctx, *c_ctx, *w_mod, *b_mod, *norm_pre, *norm_post, *ffn_w1, *ffn_w3, *ffn_w2, *w_in, *w_out,
      *rg_conv_w, *rg_conv_b, *rg_gate_a_w, *rg_gate_a_b, *rg_gate_x_w, *rg_gate_x_b, *rg_lambda,
      *gla_alpha_w2, *gla_alpha_b, *gla_norm, *rw_mu, *rw_w0, *rw_w2, *rw_a0, *rw_a2, *rw_g2, *rw_k_k, *rw_k_a,
      *rw_r_k, *rw_ln_w, *rw_ln_b;
  float* out;
  char* ws;
};

extern __shared__ __attribute__((aligned(16))) char g_smem[];

DEV const float* kparg(int off) {
  const char __attribute__((address_space(4)))* kp =
      (const char __attribute__((address_space(4)))*)__builtin_amdgcn_kernarg_segment_ptr();
  return *(const float* volatile const __attribute__((address_space(4)))*)(kp + off);
}
#define KP(name) kparg((int)__builtin_offsetof(Params, name))
#define KWS ((char*)kparg((int)__builtin_offsetof(Params, ws)))
#define KOUT ((float*)kparg((int)__builtin_offsetof(Params, out)))
struct PTag {};

DEV int my_tid() {
  int t = threadIdx.x;
  asm volatile("" : "+v"(t));
  return t;
}
DEV int my_bid() {
  int b = blockIdx.x;
  asm volatile("" : "+s"(b));
  return b;
}
DEV float bf2f(u16 u) { return __uint_as_float(((unsigned)u) << 16); }
DEV u16 f2bf(float f) {
  unsigned u = __float_as_uint(f);
  u += 0x7fffu + ((u >> 16) & 1u);
  return (u16)(u >> 16);
}
DEV unsigned pack2(float a, float b) { return (unsigned)f2bf(a) | ((unsigned)f2bf(b) << 16); }
DEV float lo2f(unsigned u) { return __uint_as_float(u << 16); }
DEV float hi2f(unsigned u) { return __uint_as_float(u & 0xffff0000u); }
DEV float wave_sum(float v) {
#pragma unroll
  for (int o = 32; o > 0; o >>= 1) v += __shfl_xor(v, o, 64);
  return v;
}
DEV float sigmoidf_(float x) { return __builtin_amdgcn_rcpf(1.f + __expf(-x)); }
DEV float siluf_(float x) { return x * __builtin_amdgcn_rcpf(1.f + __expf(-x)); }
DEV float tanhf_(float x) { return 1.f - 2.f * __builtin_amdgcn_rcpf(1.f + __expf(2.f * x)); }
DEV float log_sigmoidf_(float x) { return fminf(x, 0.f) - __logf(1.f + __expf(-fabsf(x))); }
template <int CTRL>
DEV float dpp_f(float x) {
  return __int_as_float(__builtin_amdgcn_update_dpp(0, __float_as_int(x), CTRL, 0xf, 0xf, true));
}
DEV float quad_sum(float x) {
  x += dpp_f<0xB1>(x);
  x += dpp_f<0x4E>(x);
  return x;
}
DEV float oct_sum(float x) {
  x = quad_sum(x);
  x += dpp_f<0x141>(x);
  return x;
}
DEV int seq_row(int b, int dir, int s) {
  if (s < 256) {
    int t = dir ? 255 - s : s;
    return NLAT + b * 256 + t;
  }
  int t = s - 256;
  t = dir ? 4095 - t : t;
  return b * 4096 + t;
}

DEV void phase_adaln(PTag p) {
  const int ltid = my_tid();
  const int lbid = my_bid();
  (void)ltid; (void)lbid;
  float* sc = (float*)g_smem;
  float* red = sc + 9 * 1024;
  float* mod = (float*)(KWS + OFF_MOD);
  const int tid = ltid;
  for (int i = tid; i < 9 * 1024; i += NTHREADS) {
    int m = i >> 10, k = i & 1023;
    float v = (m < 8) ? KP(c)[m * 1024 + k] : KP(c_ctx)[k];
    sc[i] = siluf_(v);
  }
  __syncthreads();
  for (int job = lbid; job < 256; job += gridDim.x) {
    int l = job >> 6, j0 = (job & 63) * 144;
    const float* W = KP(w_mod) + (size_t)l * 1024 * 9216;
    int cgp = tid % 36, ig = tid / 36;
    if (tid < 504) {
      float acc[9][4];
#pragma unroll
      for (int m = 0; m < 9; ++m)
#pragma unroll
        for (int q = 0; q < 4; ++q) acc[m][q] = 0.f;
#pragma unroll 4
      for (int i = ig; i < 1024; i += 14) {
        float4 w4 = *(const float4*)(W + (size_t)i * 9216 + j0 + cgp * 4);
#pragma unroll
        for (int m = 0; m < 9; ++m) {
          float s = sc[m * 1024 + i];
          acc[m][0] += s * w4.x;
          acc[m][1] += s * w4.y;
          acc[m][2] += s * w4.z;
          acc[m][3] += s * w4.w;
        }
      }
#pragma unroll
      for (int m = 0; m < 9; ++m)
#pragma unroll
        for (int q = 0; q < 4; ++q) red[(ig * 9 + m) * 144 + cgp * 4 + q] = acc[m][q];
    }
    __syncthreads();
    for (int o = tid; o < 9 * 144; o += NTHREADS) {
      int m = o / 144, cc = o % 144;
      float s = KP(b_mod)[l * 9216 + j0 + cc];
#pragma unroll
      for (int g = 0; g < 14; ++g) s += red[(g * 9 + m) * 144 + cc];
      mod[(size_t)(l * 9 + m) * 9216 + j0 + cc] = s;
    }
    __syncthreads();
  }
}

DEV void conv_job(const float* srcA, const float* srcB, int interleave, int ld, int Kvalid, int Nvalid, u16* dst,
                  int Kdst, int Ndst, int& tb) {
  const int ltid = my_tid();
  const int lbid = my_bid();
  (void)ltid; (void)lbid;
  float* tile = (float*)g_smem;
  const int tid = ltid;
  int tk = (Kdst + 63) / 64, nt = (Ndst / 64) * tk;
  int G = gridDim.x;
  int start = (((int)lbid - (tb % G)) % G + G) % G;
  for (int t = start; t < nt; t += G) {
    int nn0 = (t / tk) * 64, k0 = (t % tk) * 64;
    int nl = tid & 63, nn = nn0 + nl;
    const float* src;
    int col;
    bool nv;
    if (interleave) {
      int g = nn >> 5, w = nn & 31;
      col = g * 16 + (w & 15);
      src = (w < 16) ? srcA : srcB;
      nv = true;
    } else {
      col = nn;
      src = srcA;
      nv = nn < Nvalid;
    }
#pragma unroll
    for (int pass = 0; pass < 8; ++pass) {
      int kk = pass * 8 + (tid >> 6);
      int k = k0 + kk;
      float v = (nv && k < Kvalid) ? src[(size_t)k * ld + col] : 0.f;
      tile[nl * 65 + kk] = v;
    }
    __syncthreads();
    {
      int nl2 = tid >> 3, kc = tid & 7;
      int k = k0 + kc * 8;
      if (k < Kdst) {
        const float* tp = tile + nl2 * 65 + kc * 8;
        uint4 o;
        o.x = pack2(tp[0], tp[1]);
        o.y = pack2(tp[2], tp[3]);
        o.z = pack2(tp[4], tp[5]);
        o.w = pack2(tp[6], tp[7]);
        *(uint4*)(dst + (size_t)(nn0 + nl2) * Kdst + k) = o;
      }
    }
    __syncthreads();
  }
  tb += nt;
}

DEV void conv_ffn(PTag p, int l, int f) {
  int tb = 0;
  u16* wb = (u16*)(KWS + OFF_WB);
  size_t o13 = ((size_t)(l * 2 + f)) * 1024 * 2816;
  conv_job(KP(ffn_w1) + o13, KP(ffn_w3) + o13, 1, 2816, 1024, 5632, (u16*)((char*)wb + WB_W13T), 1024, 5632, tb);
  conv_job(KP(ffn_w2) + o13, nullptr, 0, 1024, 2816, 1024, (u16*)((char*)wb + WB_W2T), 2816, 1024, tb);
}
DEV void conv_mixer(PTag p, int l) {
  int tb = 0;
  char* wb = KWS + OFF_WB;
  conv_job(KP(w_in) + (size_t)l * 1024 * PIN, nullptr, 0, PIN, 1024, PIN, (u16*)(wb + WB_WINT), 1024, PINP, tb);
  conv_job(KP(w_out) + (size_t)l * 1024 * 1024, nullptr, 0, 1024, 1024, 1024, (u16*)(wb + WB_WOUTT), 1024, 1024, tb);
  for (int d = 0; d < 2; ++d) {
    conv_job(KP(rw_w2) + (size_t)(l * 2 + d) * 64 * 384, nullptr, 0, 384, 64, 384, (u16*)(wb + WB_RWW2T) + d * 384 * 64, 64,
             384, tb);
    conv_job(KP(rw_a2) + (size_t)(l * 2 + d) * 64 * 384, nullptr, 0, 384, 64, 384, (u16*)(wb + WB_RWA2T) + d * 384 * 64, 64,
             384, tb);
    conv_job(KP(gla_alpha_w2) + (size_t)(l * 2 + d) * 16 * 192, nullptr, 0, 192, 16, 192, (u16*)(wb + WB_GLAT) + d * 192 * 32,
             32, 192, tb);
    for (int h = 0; h < 4; ++h) {
      conv_job(KP(rg_gate_a_w) + (size_t)((l * 2 + d) * 4 + h) * 4096, nullptr, 0, 64, 64, 64,
               (u16*)(wb + WB_RGGT) + ((d * 2 + 0) * 4 + h) * 4096, 64, 64, tb);
      conv_job(KP(rg_gate_x_w) + (size_t)((l * 2 + d) * 4 + h) * 4096, nullptr, 0, 64, 64, 64,
               (u16*)(wb + WB_RGGT) + ((d * 2 + 1) * 4 + h) * 4096, 64, 64, tb);
    }
  }
  conv_job(KP(rw_g2) + (size_t)l * 128 * 384, nullptr, 0, 384, 128, 384, (u16*)(wb + WB_RWG2T), 128, 384, tb);
}

DEV void phase_rows(PTag p, int init, int has_y, const float* gpost, const float* mod_gate, float coef,
                    int has_next, const float* gpre, const float* mod_shift, const float* mod_scale, int Mrows) {
  const int ltid = my_tid();
  const int lbid = my_bid();
  (void)ltid; (void)lbid;
  const int lane = ltid & 63;
  const int gw = lbid * 8 + (ltid >> 6), nw = gridDim.x * 8;
  float* hc = (float*)(KWS + OFF_HC);
  const u16* Y = (const u16*)(KWS + OFF_Y);
  u16* XN = (u16*)(KWS + OFF_XN);
  for (int row = gw; row < Mrows; row += nw) {
    int m = row < NLAT ? (row >> 12) : 8;
    float* hp = row < NLAT ? KOUT + (size_t)row * 1024 : hc + (size_t)(row - NLAT) * 1024;
    float4 h[4];
    if (init) {
      const float* src = row < NLAT ? KP(x) + (size_t)row * 1024 : KP(ctx) + (size_t)(row - NLAT) * 1024;
#pragma unroll
      for (int i = 0; i < 4; ++i) h[i] = ((const float4*)src)[lane + 64 * i];
    } else {
#pragma unroll
      for (int i = 0; i < 4; ++i) h[i] = ((const float4*)hp)[lane + 64 * i];
    }
    if (has_y) {
      float4 y[4];
      float ss = 0.f;
#pragma unroll
      for (int i = 0; i < 4; ++i) {
        uint2 u = ((const uint2*)(Y + (size_t)row * 1024))[lane + 64 * i];
        y[i].x = lo2f(u.x); y[i].y = hi2f(u.x); y[i].z = lo2f(u.y); y[i].w = hi2f(u.y);
        ss += y[i].x * y[i].x + y[i].y * y[i].y + y[i].z * y[i].z + y[i].w * y[i].w;
      }
      ss = wave_sum(ss);
      float rs = rsqrtf(ss * (1.f / 1024.f) + 1e-6f) * coef;
#pragma unroll
      for (int i = 0; i < 4; ++i) {
        float4 g = ((const float4*)(mod_gate + (size_t)m * 9216))[lane + 64 * i];
        float4 gp = ((const float4*)gpost)[lane + 64 * i];
        h[i].x += g.x * (y[i].x * rs * gp.x);
        h[i].y += g.y * (y[i].y * rs * gp.y);
        h[i].z += g.z * (y[i].z * rs * gp.z);
        h[i].w += g.w * (y[i].w * rs * gp.w);
      }
    }
    if (init || has_y) {
#pragma unroll
      for (int i = 0; i < 4; ++i) ((float4*)hp)[lane + 64 * i] = h[i];
    }
    if (has_next) {
      float ss = 0.f;
#pragma unroll
      for (int i = 0; i < 4; ++i) ss += h[i].x * h[i].x + h[i].y * h[i].y + h[i].z * h[i].z + h[i].w * h[i].w;
      ss = wave_sum(ss);
      float rs = rsqrtf(ss * (1.f / 1024.f) + 1e-6f);
#pragma unroll
      for (int i = 0; i < 4; ++i) {
        float4 gp = ((const float4*)gpre)[lane + 64 * i];
        float4 sh = ((const float4*)(mod_shift + (size_t)m * 9216))[lane + 64 * i];
        float4 scl = ((const float4*)(mod_scale + (size_t)m * 9216))[lane + 64 * i];
        float a = (h[i].x * rs * gp.x) * (1.f + scl.x) + sh.x;
        float b = (h[i].y * rs * gp.y) * (1.f + scl.y) + sh.y;
        float c = (h[i].z * rs * gp.z) * (1.f + scl.z) + sh.z;
        float d = (h[i].w * rs * gp.w) * (1.f + scl.w) + sh.w;
        uint2 o;
        o.x = pack2(a, b);
        o.y = pack2(c, d);
        ((uint2*)(XN + (size_t)row * 1024))[lane + 64 * i] = o;
      }
    }
  }
}

constexpr int BM = 256, BK = 64, HALF = 128, HT = HALF * BK;
DEV int lds_byte(int r, int c) {
  int st = (r >> 4) * 2 + (c >> 5), rr = r & 15, cc = c & 31, ob = rr * 64 + cc * 2;
  return st * 1024 + (ob ^ (((ob >> 9) & 1) << 5));
}
DEV void stage_rc(int b, int& R, int& C) {
  int st = b / 1024, sb = b % 1024, swz = sb ^ (((sb >> 9) & 1) << 5);
  R = (st >> 1) * 16 + swz / 64;
  C = (st & 1) * 32 + (swz % 64) / 2;
}
enum { EPI_UP = 0, EPI_Y = 1, EPI_Z = 2 };

template <int K, int EPI>
DEV void gemm_phase(const u16* __restrict__ A, const u16* __restrict__ Bt, int M, int N, u16* __restrict__ O0,
                    u16* __restrict__ O1) {
  const int ltid = my_tid();
  const int lbid = my_bid();
  (void)ltid; (void)lbid;
  u16* shm = (u16*)g_smem;
#define SA(b, h) (shm + ((b) * 2 + (h)) * HT)
#define SB(b, h) (shm + (4 + (b) * 2 + (h)) * HT)
#define STAGE(P, GB, kc)                                                                                        \
  do {                                                                                                           \
    __builtin_amdgcn_global_load_lds((const unsigned*)((const char*)(GB) + vb0 + (kc) * (BK * 2)),              \
                                     (unsigned*)((char*)(P) + wbase), 16, 0, 0);                                 \
    __builtin_amdgcn_global_load_lds((const unsigned*)((const char*)(GB) + vb1 + (kc) * (BK * 2)),              \
                                     (unsigned*)((char*)(P) + wbase + 8192), 16, 0, 0);                          \
  } while (0)
#define LDA(dst, b, h)                                                                                 \
  for (int m = 0; m < 4; ++m)                                                                          \
    for (int k = 0; k < 2; ++k)                                                                        \
  dst[m][k] = *reinterpret_cast<const bf16x8*>(aBase + (((b) * 2 + (h)) * 16384 + m * 2048 + k * 1024))
#define LDB(dst, b, h)                                                                                 \
  for (int n = 0; n < 2; ++n)                                                                          \
    for (int k = 0; k < 2; ++k)                                                                        \
  dst[n][k] = *reinterpret_cast<const bf16x8*>(bBase + (((b) * 2 + (h)) * 16384 + n * 2048 + k * 1024))
#define MMA(ai, bj, At_, Bt_)                                                                          \
  do {                                                                                                 \
    __builtin_amdgcn_s_setprio(1);                                                                     \
    for (int m = 0; m < 4; ++m)                                                                        \
      for (int n = 0; n < 2; ++n)                                                                      \
        for (int k = 0; k < 2; ++k)                                                                    \
          acc[ai][bj][m][n] =                                                                          \
              __builtin_amdgcn_mfma_f32_16x16x32_bf16(At_[m][k], Bt_[n][k], acc[ai][bj][m][n], 0, 0, 0); \
    __builtin_amdgcn_s_setprio(0);                                                                     \
  } while (0)
#define WAIT_V(n) asm volatile("s_waitcnt vmcnt(" #n ")" ::: "memory")
#define WAIT_L(n) asm volatile("s_waitcnt lgkmcnt(" #n ")" ::: "memory")
#define BAR __builtin_amdgcn_s_barrier()
#define SCHED __builtin_amdgcn_sched_barrier(0)

  const int tid = ltid;
  const int tid16 = tid * 16;
  unsigned off0, off1;
  {
    int r, c;
    stage_rc(tid16, r, c);
    off0 = (unsigned)(r * K + c) * 2u;
    stage_rc(tid16 + 8192, r, c);
    off1 = (unsigned)(r * K + c) * 2u;
  }
  const int wbase = __builtin_amdgcn_readfirstlane(tid >> 6) * 1024;
  const int wid = tid >> 6, lane = tid & 63, wr = wid >> 2, wc = wid & 3, fr = lane & 15, fq = lane >> 4;
  const int nM = M / BM, nN = N / BM, nwg = nM * nN;
  constexpr int nt = K / BK;
  const int lo_ = lds_byte(fr, fq * 8);
  const char* aBase = (const char*)g_smem + wr * 8192 + lo_;
  const char* bBase = (const char*)g_smem + 65536 + wc * 4096 + lo_;
  constexpr int WGM = 8;
  for (int tix = lbid; tix < nwg; tix += gridDim.x) {
    int wgid = tix;
    {
      int q = nwg / 8, r = nwg % 8, xcd = wgid % 8, off = wgid / 8;
      wgid = (xcd < r ? xcd * (q + 1) : r * (q + 1) + (xcd - r) * q) + off;
    }
    int nig = WGM * nN, gid = wgid / nig, fm = gid * WGM, gsz = min(nM - fm, WGM);
    int pm = fm + ((wgid % nig) % gsz), pn = (wgid % nig) / gsz, brow = pm * BM, bcol = pn * BM;
    f32x4 acc[2][2][4][2];
#pragma unroll
    for (int a = 0; a < 2; ++a)
#pragma unroll
      for (int b = 0; b < 2; ++b)
#pragma unroll
        for (int m = 0; m < 4; ++m)
#pragma unroll
          for (int n = 0; n < 2; ++n) acc[a][b][m][n] = f32x4{0.f, 0.f, 0.f, 0.f};
    bf16x8 At[4][2], B0[2][2], B1[2][2];
    const u16* gA0 = A + (size_t)brow * K;
    const u16* gA1 = gA0 + (size_t)HALF * K;
    const u16* gB0 = Bt + (size_t)bcol * K;
    const u16* gB1 = gB0 + (size_t)HALF * K;
    unsigned vb0 = off0, vb1 = off1;
    STAGE(SB(0, 0), gB0, 0);
    STAGE(SA(0, 0), gA0, 0);
    STAGE(SB(0, 1), gB1, 0);
    STAGE(SA(0, 1), gA1, 0);
    if (wr == 1) BAR;
    WAIT_V(4);
    BAR;
    STAGE(SB(1, 0), gB0, 1);
    STAGE(SA(1, 0), gA0, 1);
    STAGE(SB(1, 1), gB1, 1);
    WAIT_V(6);
    BAR;
#pragma unroll 1
    for (int t = 0; t < nt - 2; t += 2, vb0 += 2 * BK * 2, vb1 += 2 * BK * 2) {
      LDB(B0, 0, 0); SCHED; LDA(At, 0, 0); STAGE(SA(1, 1), gA1, 1);
      WAIT_L(8); BAR; WAIT_L(0); MMA(0, 0, At, B0); BAR; SCHED;
      LDB(B1, 0, 1); STAGE(SB(0, 0), gB0, 2);
      BAR; WAIT_L(0); MMA(0, 1, At, B1); BAR;
      LDA(At, 0, 1); STAGE(SA(0, 0), gA0, 2);
      BAR; WAIT_L(0); MMA(1, 0, At, B0); BAR; SCHED;
      STAGE(SB(0, 1), gB1, 2);
      WAIT_V(6); BAR; MMA(1, 1, At, B1); BAR;
      LDB(B0, 1, 0); SCHED; LDA(At, 1, 0); STAGE(SA(0, 1), gA1, 2);
      WAIT_L(8); BAR; WAIT_L(0); MMA(0, 0, At, B0); BAR; SCHED;
      LDB(B1, 1, 1); STAGE(SB(1, 0), gB0, 3);
      BAR; WAIT_L(0); MMA(0, 1, At, B1); BAR;
      LDA(At, 1, 1); STAGE(SA(1, 0), gA0, 3);
      BAR; WAIT_L(0); MMA(1, 0, At, B0); BAR; SCHED;
      STAGE(SB(1, 1), gB1, 3);
      WAIT_V(6); BAR; MMA(1, 1, At, B1); BAR;
    }
    {
      LDB(B0, 0, 0); LDA(At, 0, 0); STAGE(SA(1, 1), gA1, 1);
      BAR; WAIT_L(0); MMA(0, 0, At, B0); BAR;
      LDB(B1, 0, 1); BAR; WAIT_L(0); MMA(0, 1, At, B1); BAR;
      LDA(At, 0, 1); WAIT_V(4); BAR; WAIT_L(0); MMA(1, 0, At, B0); MMA(1, 1, At, B1); BAR;
    }
    {
      LDB(B0, 1, 0); LDA(At, 1, 0); WAIT_V(2); BAR; WAIT_L(0); MMA(0, 0, At, B0); BAR;
      LDB(B1, 1, 1); WAIT_V(0); BAR; WAIT_L(0); MMA(0, 1, At, B1); BAR;
      LDA(At, 1, 1); BAR; WAIT_L(0); MMA(1, 0, At, B0); MMA(1, 1, At, B1); BAR;
    }
    if (wr == 0) BAR;
#pragma unroll
    for (int ai = 0; ai < 2; ++ai)
#pragma unroll
      for (int bj = 0; bj < 2; ++bj)
#pragma unroll
        for (int m = 0; m < 4; ++m) {
          int rowb = brow + ai * HALF + wr * 64 + m * 16 + fq * 4;
          if (EPI == EPI_UP) {
            int hcol = ((bcol + bj * HALF + wc * 32) >> 1) + fr;
#pragma unroll
            for (int j = 0; j < 4; ++j) {
              float a = acc[ai][bj][m][0][j], b = acc[ai][bj][m][1][j];
              O0[(size_t)(rowb + j) * DFF + hcol] = f2bf(siluf_(a) * b);
            }
          } else {
#pragma unroll
            for (int n = 0; n < 2; ++n) {
              int col = bcol + bj * HALF + wc * 32 + n * 16 + fr;
#pragma unroll
              for (int j = 0; j < 4; ++j) {
                float v = acc[ai][bj][m][n][j];
                if (EPI == EPI_Y) {
                  O0[(size_t)(rowb + j) * DM + col] = f2bf(v);
                } else {
                  if (col < Z1W) O0[(size_t)(rowb + j) * Z1W + col] = f2bf(v);
                  else if (col < PIN) O1[(size_t)(rowb + j) * Z2W + (col - Z1W)] = f2bf(v);
                }
              }
            }
          }
        }
  }
#undef SA
#undef SB
#undef STAGE
#undef LDA
#undef LDB
#undef MMA
}

DEV bf16x8 ld_frag_g(const u16* p) { return *reinterpret_cast<const bf16x8*>(p); }
DEV bf16x8 ld_frag_s(const u16* p) { return *reinterpret_cast<const bf16x8*>(p); }

constexpr int ALD = 392;
constexpr int XLD = 264;
constexpr int GLD = 40;

DEV void phase_prep(PTag p, int l) {
  const int ltid = my_tid();
  const int lbid = my_bid();
  (void)ltid; (void)lbid;
  const int tid = ltid, lane = tid & 63, wid = tid >> 6;
  const int fr = lane & 15, fq = lane >> 4;
  char* ar = KWS + OFF_AR;
  const u16* Z1 = (const u16*)(ar + AR_Z1);
  const u16* Z2 = (const u16*)(ar + AR_Z2);
  u16* RWP = (u16*)(ar + AR_RWP);
  u16* LA = (u16*)(ar + AR_LA);
  float* invn = (float*)(KWS + OFF_INVN);
  u16* Gout = (u16*)(KWS + OFF_Y);
  u16* RGP = (u16*)(KWS + OFF_XN);
  const char* wb = KWS + OFF_WB;
  u16* A_lds = (u16*)g_smem;
  u16* X_lds = (u16*)(g_smem + 50176);
  u16* Gl_lds = (u16*)(g_smem + 50176 + 33792);
  const float* mu = KP(rw_mu) + (size_t)l * 1536;
  const float* k_k = KP(rw_k_k) + (size_t)l * 384;

  for (int tile = lbid; tile < NT / 64; tile += gridDim.x) {
    const int r0 = tile * 64;
    const bool lat = r0 < NLAT;
    const int tpos0 = lat ? (r0 & 4095) : ((r0 - NLAT) & 255);
    const int seglen = lat ? 4096 : 256;
    for (int it = 0; it < 24; ++it) {
      int q = it * NTHREADS + tid;
      int i = q / 192, cc = q % 192, c0 = cc * 8;
      int row = r0 + i, tpos = tpos0 + i;
      const u16* zr = Z2 + (size_t)row * Z2W + c0;
      uint4 own = *(const uint4*)zr;
      uint4 z4 = {0u, 0u, 0u, 0u};
      uint4 n0 = z4, n1 = z4, n2 = z4, n3 = z4;
      if (lat) {
        int gcol = tpos & 63, grow = tpos >> 6;
        if (gcol > 0) n0 = *(const uint4*)(zr - Z2W);
        if (gcol < 63) n1 = *(const uint4*)(zr + Z2W);
        if (grow > 0) n2 = *(const uint4*)(zr - 64 * Z2W);
        if (grow < 63) n3 = *(const uint4*)(zr + 64 * Z2W);
      } else {
        if (tpos > 0) n0 = *(const uint4*)(zr - Z2W);
        if (tpos < 255) n1 = *(const uint4*)(zr + Z2W);
        n2 = n0;
        n3 = n1;
      }
      float4 mu0 = *(const float4*)(mu + c0), mu1 = *(const float4*)(mu + c0 + 4);
      float f[8];
      {
        float o0 = lo2f(own.x), o1 = hi2f(own.x), o2 = lo2f(own.y), o3 = hi2f(own.y);
        float o4 = lo2f(own.z), o5 = hi2f(own.z), o6 = lo2f(own.w), o7 = hi2f(own.w);
        float s0 = lo2f(n0.x), s1 = hi2f(n1.x), s2 = lo2f(n2.y), s3 = hi2f(n3.y);
        float s4 = lo2f(n0.z), s5 = hi2f(n1.z), s6 = lo2f(n2.w), s7 = hi2f(n3.w);
        f[0] = o0 + mu0.x * (s0 - o0);
        f[1] = o1 + mu0.y * (s1 - o1);
        f[2] = o2 + mu0.z * (s2 - o2);
        f[3] = o3 + mu0.w * (s3 - o3);
        f[4] = o4 + mu1.x * (s4 - o4);
        f[5] = o5 + mu1.y * (s5 - o5);
        f[6] = o6 + mu1.z * (s6 - o6);
        f[7] = o7 + mu1.w * (s7 - o7);
      }
      if (c0 < 1152) {
        int arr = c0 / 384, cin = c0 % 384;
        uint4 o;
        o.x = pack2(f[0], f[1]); o.y = pack2(f[2], f[3]); o.z = pack2(f[4], f[5]); o.w = pack2(f[6], f[7]);
        *(uint4*)(RWP + (size_t)arr * NT * 384 + (size_t)row * 384 + cin) = o;
        if (arr == 1) {
          float4 kk0 = *(const float4*)(k_k + cin), kk1 = *(const float4*)(k_k + cin + 4);
          float a0 = f[0] * kk0.x, a1 = f[1] * kk0.y, a2 = f[2] * kk0.z, a3 = f[3] * kk0.w;
          float a4 = f[4] * kk1.x, a5 = f[5] * kk1.y, a6 = f[6] * kk1.z, a7 = f[7] * kk1.w;
          float ss = a0 * a0 + a1 * a1 + a2 * a2 + a3 * a3 + a4 * a4 + a5 * a5 + a6 * a6 + a7 * a7;
          ss += __shfl_xor(ss, 1, 64);
          ss += __shfl_xor(ss, 2, 64);
          ss += __shfl_xor(ss, 4, 64);
          if ((lane & 7) == 0) invn[(size_t)row * 8 + (cin >> 6)] = 1.f / fmaxf(sqrtf(ss), 1e-12f);
        }
      } else {
        int cl = c0 - 1152;
        if (cl < 128) {
#pragma unroll
          for (int e = 0; e < 8; ++e) f[e] = tanhf_(f[e]);
        } else if (cl >= 256) {
#pragma unroll
          for (int e = 0; e < 8; ++e) f[e] = sigmoidf_(f[e]);
        }
        uint4 o;
        o.x = pack2(f[0], f[1]); o.y = pack2(f[2], f[3]); o.z = pack2(f[4], f[5]); o.w = pack2(f[6], f[7]);
        *(uint4*)(A_lds + i * ALD + cl) = o;
      }
    }
    {
      const float* cw = KP(rg_conv_w) + (size_t)l * 4 * 256;
      const float* cb = KP(rg_conv_b) + (size_t)l * 256;
      for (int it = 0; it < 4; ++it) {
        int q = it * NTHREADS + tid;
        int i = q >> 5, c0 = (q & 31) * 8;
        int row = r0 + i, tpos = tpos0 + i;
        float accv[8];
        {
          float4 b0 = *(const float4*)(cb + c0), b1 = *(const float4*)(cb + c0 + 4);
          accv[0] = b0.x; accv[1] = b0.y; accv[2] = b0.z; accv[3] = b0.w;
          accv[4] = b1.x; accv[5] = b1.y; accv[6] = b1.z; accv[7] = b1.w;
        }
#pragma unroll
        for (int j = 0; j < 4; ++j) {
          int tt = tpos + j - 2;
          if (tt >= 0 && tt < seglen) {
            uint4 xv = *(const uint4*)(Z1 + (size_t)(row + j - 2) * Z1W + c0);
            float4 w0 = *(const float4*)(cw + j * 256 + c0), w1 = *(const float4*)(cw + j * 256 + c0 + 4);
            accv[0] += w0.x * lo2f(xv.x); accv[1] += w0.y * hi2f(xv.x);
            accv[2] += w0.z * lo2f(xv.y); accv[3] += w0.w * hi2f(xv.y);
            accv[4] += w1.x * lo2f(xv.z); accv[5] += w1.y * hi2f(xv.z);
            accv[6] += w1.z * lo2f(xv.w); accv[7] += w1.w * hi2f(xv.w);
          }
        }
        uint4 o;
        o.x = pack2(accv[0], accv[1]); o.y = pack2(accv[2], accv[3]);
        o.z = pack2(accv[4], accv[5]); o.w = pack2(accv[6], accv[7]);
        *(uint4*)(X_lds + i * XLD + c0) = o;
      }
      {
        int q = tid;
        int i = q >> 3, d = (q >> 2) & 1, ch = q & 3;
        uint4 o = {0u, 0u, 0u, 0u};
        if (ch < 2) o = *(const uint4*)(Z1 + (size_t)(r0 + i) * Z1W + 1664 + d * 16 + ch * 8);
        *(uint4*)(Gl_lds + (d * 64 + i) * GLD + ch * 8) = o;
      }
    }
    __syncthreads();
    for (int u = wid; u < 120; u += 8) {
      int g = u / 24, ntile = u % 24, n0 = ntile * 16;
      int n = n0 + fr;
      int nc = n0 + fq * 4;
      f32x4 acc[4];
#pragma unroll
      for (int m = 0; m < 4; ++m) acc[m] = f32x4{0.f, 0.f, 0.f, 0.f};
      if (g < 4) {
        const u16* Bt = (const u16*)(wb + ((g < 2) ? WB_RWW2T : WB_RWA2T)) + (size_t)(g & 1) * 384 * 64;
        bf16x8 b0 = ld_frag_g(Bt + (size_t)n * 64 + fq * 8), b1 = ld_frag_g(Bt + (size_t)n * 64 + 32 + fq * 8);
#pragma unroll
        for (int m = 0; m < 4; ++m) {
          const u16* ap = A_lds + (m * 16 + fr) * ALD + g * 64 + fq * 8;
          acc[m] = __builtin_amdgcn_mfma_f32_16x16x32_bf16(b0, ld_frag_s(ap), acc[m], 0, 0, 0);
          acc[m] = __builtin_amdgcn_mfma_f32_16x16x32_bf16(b1, ld_frag_s(ap + 32), acc[m], 0, 0, 0);
        }
      } else {
        const u16* Bt = (const u16*)(wb + WB_RWG2T);
        bf16x8 b[4];
#pragma unroll
        for (int k = 0; k < 4; ++k) b[k] = ld_frag_g(Bt + (size_t)n * 128 + k * 32 + fq * 8);
#pragma unroll
        for (int m = 0; m < 4; ++m) {
          const u16* ap = A_lds + (m * 16 + fr) * ALD + 256 + fq * 8;
#pragma unroll
          for (int k = 0; k < 4; ++k)
            acc[m] = __builtin_amdgcn_mfma_f32_16x16x32_bf16(b[k], ld_frag_s(ap + k * 32), acc[m], 0, 0, 0);
        }
      }
      if (g < 2) {
        float4 w0v = *(const float4*)(KP(rw_w0) + (size_t)(l * 2 + g) * 384 + nc);
        u16* dst = RWP + (size_t)(3 + g) * NT * 384;
#pragma unroll
        for (int m = 0; m < 4; ++m) {
          int row = r0 + m * 16 + fr;
          uint2 o;
          o.x = pack2(sigmoidf_(w0v.x + acc[m][0]) * 0.60653066f, sigmoidf_(w0v.y + acc[m][1]) * 0.60653066f);
          o.y = pack2(sigmoidf_(w0v.z + acc[m][2]) * 0.60653066f, sigmoidf_(w0v.w + acc[m][3]) * 0.60653066f);
          *(uint2*)(dst + (size_t)row * 384 + nc) = o;
        }
      } else if (g < 4) {
        float4 a0v = *(const float4*)(KP(rw_a0) + (size_t)(l * 2 + (g - 2)) * 384 + nc);
        u16* dst = RWP + (size_t)(5 + (g - 2)) * NT * 384;
#pragma unroll
        for (int m = 0; m < 4; ++m) {
          int row = r0 + m * 16 + fr;
          uint2 o;
          o.x = pack2(sigmoidf_(a0v.x + acc[m][0]), sigmoidf_(a0v.y + acc[m][1]));
          o.y = pack2(sigmoidf_(a0v.z + acc[m][2]), sigmoidf_(a0v.w + acc[m][3]));
          *(uint2*)(dst + (size_t)row * 384 + nc) = o;
        }
      } else {
#pragma unroll
        for (int m = 0; m < 4; ++m) {
          int row = r0 + m * 16 + fr;
          uint2 o;
          o.x = pack2(acc[m][0], acc[m][1]);
          o.y = pack2(acc[m][2], acc[m][3]);
          *(uint2*)(Gout + (size_t)row * 384 + nc) = o;
        }
      }
    }
    for (int u = wid; u < 32; u += 8) {
      int d = u >> 4, hd = (u >> 2) & 3, ntile = u & 3;
      int nl = ntile * 16 + fr;
      int chc = hd * 64 + ntile * 16 + fq * 4;
      const u16* Ba = (const u16*)(wb + WB_RGGT) + (size_t)((d * 2 + 0) * 4 + hd) * 4096 + nl * 64;
      const u16* Bx = (const u16*)(wb + WB_RGGT) + (size_t)((d * 2 + 1) * 4 + hd) * 4096 + nl * 64;
      bf16x8 ba0 = ld_frag_g(Ba + fq * 8), ba1 = ld_frag_g(Ba + 32 + fq * 8);
      bf16x8 bx0 = ld_frag_g(Bx + fq * 8), bx1 = ld_frag_g(Bx + 32 + fq * 8);
      float4 gab = *(const float4*)(KP(rg_gate_a_b) + (size_t)(l * 2 + d) * 256 + chc);
      float4 gxb = *(const float4*)(KP(rg_gate_x_b) + (size_t)(l * 2 + d) * 256 + chc);
      float4 lam = *(const float4*)(KP(rg_lambda) + (size_t)(l * 2 + d) * 256 + chc);
      float spl[4] = {__logf(1.f + __expf(-lam.x)) * 8.f, __logf(1.f + __expf(-lam.y)) * 8.f,
                      __logf(1.f + __expf(-lam.z)) * 8.f, __logf(1.f + __expf(-lam.w)) * 8.f};
      float gabv[4] = {gab.x, gab.y, gab.z, gab.w}, gxbv[4] = {gxb.x, gxb.y, gxb.z, gxb.w};
      u16* dla = RGP + (size_t)(d * 2 + 0) * NT * 256;
      u16* dbx = RGP + (size_t)(d * 2 + 1) * NT * 256;
#pragma unroll
      for (int m = 0; m < 4; ++m) {
        const u16* ap = X_lds + (m * 16 + fr) * XLD + hd * 64 + fq * 8;
        bf16x8 a0 = ld_frag_s(ap), a1 = ld_frag_s(ap + 32);
        f32x4 ca = f32x4{0.f, 0.f, 0.f, 0.f}, cx = ca;
        ca = __builtin_amdgcn_mfma_f32_16x16x32_bf16(ba0, a0, ca, 0, 0, 0);
        ca = __builtin_amdgcn_mfma_f32_16x16x32_bf16(ba1, a1, ca, 0, 0, 0);
        cx = __builtin_amdgcn_mfma_f32_16x16x32_bf16(bx0, a0, cx, 0, 0, 0);
        cx = __builtin_amdgcn_mfma_f32_16x16x32_bf16(bx1, a1, cx, 0, 0, 0);
        int il = m * 16 + fr;
        int row = r0 + il;
        uint2 xcv = *(const uint2*)(X_lds + il * XLD + chc);
        float xc[4] = {lo2f(xcv.x), hi2f(xcv.x), lo2f(xcv.y), hi2f(xcv.y)};
        float la[4], bx[4];
#pragma unroll
        for (int j = 0; j < 4; ++j) {
          float r = sigmoidf_(ca[j] + gabv[j]), ig = sigmoidf_(cx[j] + gxbv[j]);
          float loga = -r * spl[j];
          float mult = __builtin_amdgcn_sqrtf(fmaxf(1.f - __expf(2.f * loga), 0.f));
          la[j] = loga;
          bx[j] = mult * ig * xc[j];
        }
        uint2 o;
        o.x = pack2(la[0], la[1]); o.y = pack2(la[2], la[3]);
        *(uint2*)(dla + (size_t)row * 256 + chc) = o;
        o.x = pack2(bx[0], bx[1]); o.y = pack2(bx[2], bx[3]);
        *(uint2*)(dbx + (size_t)row * 256 + chc) = o;
      }
    }
    for (int u = wid; u < 24; u += 8) {
      int d = u / 12, ntile = u % 12;
      int n = ntile * 16 + fr;
      int nc = ntile * 16 + fq * 4;
      const u16* Bt = (const u16*)(wb + WB_GLAT) + (size_t)d * 192 * 32;
      bf16x8 b0 = ld_frag_g(Bt + (size_t)n * 32 + fq * 8);
      float4 bb = *(const float4*)(KP(gla_alpha_b) + (size_t)(l * 2 + d) * 192 + nc);
      u16* dst = LA + (size_t)d * NT * 192;
#pragma unroll
      for (int m = 0; m < 4; ++m) {
        const u16* ap = Gl_lds + (d * 64 + m * 16 + fr) * GLD + fq * 8;
        f32x4 cacc = f32x4{0.f, 0.f, 0.f, 0.f};
        cacc = __builtin_amdgcn_mfma_f32_16x16x32_bf16(b0, ld_frag_s(ap), cacc, 0, 0, 0);
        int row = r0 + m * 16 + fr;
        uint2 o;
        o.x = pack2(log_sigmoidf_(cacc[0] + bb.x) * (1.f / 16.f), log_sigmoidf_(cacc[1] + bb.y) * (1.f / 16.f));
        o.y = pack2(log_sigmoidf_(cacc[2] + bb.z) * (1.f / 16.f), log_sigmoidf_(cacc[3] + bb.w) * (1.f / 16.f));
        *(uint2*)(dst + (size_t)row * 192 + nc) = o;
      }
    }
    __syncthreads();
  }
}

constexpr int TC = 32;
constexpr int NSTEP = 4352;
typedef float v2f __attribute__((ext_vector_type(2)));
DEV v2f pkfma(v2f a, v2f b, v2f c) { return __builtin_elementwise_fma(a, b, c); }
DEV float hex_sum(float x) {
  x = quad_sum(x);
  x += dpp_f<0x141>(x);
  x += dpp_f<0x140>(x);
  return x;
}

DEV void scan_rwkv(PTag p, int l, int task) {
  const int ltid = my_tid();
  const int tid = ltid, lane = tid & 63, w = tid >> 6;
  const int half = task & 1, sc = task >> 1;
  const int b = sc / 12, h = (sc % 12) >> 1, dir = sc & 1;
  char* ar = KWS + OFF_AR;
  const u16* RWP = (const u16*)(ar + AR_RWP);
  const u16* Rg = RWP, *Kg = RWP + (size_t)NT * 384, *Vg = RWP + (size_t)2 * NT * 384;
  const u16* Ug = RWP + (size_t)(3 + dir) * NT * 384, *Ag = RWP + (size_t)(5 + dir) * NT * 384;
  const float* invn = (const float*)(KWS + OFF_INVN);
  u16* Yd = (u16*)(ar + AR_Z2) + (size_t)dir * NT * 384;
  float* buf = (float*)g_smem;
  float* ybuf = buf + 2 * TC * 384;
  const int rl = lane >> 4, kg = lane & 15;
  const int lrow = w * 4 + rl;
  const int lstep = tid >> 4, lq = tid & 15;
  const int ce = h * 64 + lq * 4;
  float4 kkc = *(const float4*)(KP(rw_k_k) + (size_t)l * 384 + ce);
  float4 kac = *(const float4*)(KP(rw_k_a) + (size_t)l * 384 + ce);
  v2f S0 = {0.f, 0.f}, S1 = {0.f, 0.f};

  uint2 gr, gk, gv, gu, ga;
  float gin;
  auto issue = [&](int c) {
    int row = seq_row(b, dir, c * TC + lstep);
    size_t o = (size_t)row * 384 + ce;
    gr = *(const uint2*)(Rg + o);
    gk = *(const uint2*)(Kg + o);
    gv = *(const uint2*)(Vg + o);
    gu = *(const uint2*)(Ug + o);
    ga = *(const uint2*)(Ag + o);
    gin = invn[(size_t)row * 8 + h];
  };
  auto commit = [&](int c) {
    float* d = buf + (size_t)((c & 1) * TC + lstep) * 384 + lq * 4;
    float r0 = lo2f(gr.x), r1 = hi2f(gr.x), r2 = lo2f(gr.y), r3 = hi2f(gr.y);
    float k0 = lo2f(gk.x), k1 = hi2f(gk.x), k2 = lo2f(gk.y), k3 = hi2f(gk.y);
    float v0 = lo2f(gv.x), v1 = hi2f(gv.x), v2 = lo2f(gv.y), v3 = hi2f(gv.y);
    float u0 = lo2f(gu.x), u1 = hi2f(gu.x), u2 = lo2f(gu.y), u3 = hi2f(gu.y);
    float a0 = lo2f(ga.x), a1 = hi2f(ga.x), a2 = lo2f(ga.y), a3 = hi2f(ga.y);
    *(float4*)(d + 0) = make_float4(__expf(-u0), __expf(-u1), __expf(-u2), __expf(-u3));
    *(float4*)(d + 64) = make_float4(k0 * (1.f + (a0 - 1.f) * kac.x), k1 * (1.f + (a1 - 1.f) * kac.y),
                                     k2 * (1.f + (a2 - 1.f) * kac.z), k3 * (1.f + (a3 - 1.f) * kac.w));
    float q0 = k0 * kkc.x * gin, q1 = k1 * kkc.y * gin, q2 = k2 * kkc.z * gin, q3 = k3 * kkc.w * gin;
    *(float4*)(d + 128) = make_float4(-q0, -q1, -q2, -q3);
    *(float4*)(d + 192) = make_float4(q0 * a0, q1 * a1, q2 * a2, q3 * a3);
    *(float4*)(d + 256) = make_float4(r0, r1, r2, r3);
    *(float4*)(d + 320) = make_float4(v0, v1, v2, v3);
  };
  issue(0);
  commit(0);
  __syncthreads();
  constexpr int NCH = NSTEP / TC;
#pragma unroll 1
  for (int c = 0; c < NCH; ++c) {
    if (c + 1 < NCH) issue(c + 1);
    const float* cb = buf + (size_t)(c & 1) * TC * 384;
    float* yb = ybuf + (c & 1) * TC * 32;
#pragma unroll 4
    for (int s = 0; s < TC; ++s) {
      const float* sb = cb + s * 384 + kg * 4;
      float4 w4 = *(const float4*)(sb), k4 = *(const float4*)(sb + 64), a4 = *(const float4*)(sb + 128);
      float4 b4 = *(const float4*)(sb + 192), r4 = *(const float4*)(sb + 256);
      float vv = cb[s * 384 + 320 + half * 32 + lrow];
      v2f t = S0 * v2f{a4.x, a4.y};
      t = pkfma(S1, v2f{a4.z, a4.w}, t);
      float sa = hex_sum(t.x + t.y);
      v2f sa2 = {sa, sa}, vv2 = {vv, vv};
      S0 = pkfma(S0, v2f{w4.x, w4.y}, pkfma(sa2, v2f{b4.x, b4.y}, vv2 * v2f{k4.x, k4.y}));
      S1 = pkfma(S1, v2f{w4.z, w4.w}, pkfma(sa2, v2f{b4.z, b4.w}, vv2 * v2f{k4.z, k4.w}));
      v2f y2 = S0 * v2f{r4.x, r4.y};
      y2 = pkfma(S1, v2f{r4.z, r4.w}, y2);
      float y = hex_sum(y2.x + y2.y);
      if (kg == 0) yb[s * 32 + lrow] = y;
    }
    if (c + 1 < NCH) commit(c + 1);
    __syncthreads();
    if (lq < 8) {
      int row = seq_row(b, dir, c * TC + lstep);
      float4 yv = *(const float4*)(yb + lstep * 32 + lq * 4);
      uint2 o;
      o.x = pack2(yv.x, yv.y);
      o.y = pack2(yv.z, yv.w);
      *(uint2*)(Yd + (size_t)row * 384 + h * 64 + half * 32 + lq * 4) = o;
    }
  }
  __syncthreads();
}

DEV void scan_gla_rg(PTag p, int l, int task) {
  const int ltid = my_tid();
  const int tid = ltid, lane = tid & 63, w = tid >> 6;
  const int b = task >> 3, hd = (task >> 1) & 3, dir = task & 1;
  char* ar = KWS + OFF_AR;
  const u16* Z1 = (const u16*)(ar + AR_Z1);
  const u16* LAg = (const u16*)(ar + AR_LA) + (size_t)dir * NT * 192;
  u16* Od = (u16*)(ar + AR_Z2) + (size_t)(2 + dir) * NT * 384;
  const u16* RGP = (const u16*)(KWS + OFF_XN);
  const u16* RLA = RGP + (size_t)(dir * 2 + 0) * NT * 256;
  const u16* RBX = RGP + (size_t)(dir * 2 + 1) * NT * 256;
  u16* Hd = (u16*)(KWS + OFF_Y) + (size_t)NT * 384 + (size_t)dir * NT * 256;
  constexpr int GST = 288;
  float* buf = (float*)g_smem;
  float* obuf = buf + 2 * TC * GST;
  unsigned* rgbuf = (unsigned*)(obuf + 2 * TC * 96);
  u16* hbuf = (u16*)(rgbuf + 2 * TC * 64);
  const int el = lane >> 3, dg = lane & 7;
  const int c0 = w * 16 + el, c1 = c0 + 8;
  const int lstep = tid >> 4, lq = tid & 15;
  v2f S[2][3];
#pragma unroll
  for (int c = 0; c < 2; ++c)
#pragma unroll
    for (int j = 0; j < 3; ++j) S[c][j] = v2f{0.f, 0.f};
  float hst = 0.f;
  uint2 gq, gk, gl_, gv0, gv1, rla, rbx;
  auto issue = [&](int c) {
    int row = seq_row(b, dir, c * TC + lstep);
    const u16* zr = Z1 + (size_t)row * Z1W;
    uint2 z = {0u, 0u};
    gq = z; gk = z; gl_ = z; gv1 = z;
    if (lq < 12) {
      gq = *(const uint2*)(zr + 512 + hd * 48 + lq * 4);
      gk = *(const uint2*)(zr + 704 + hd * 48 + lq * 4);
      gl_ = *(const uint2*)(LAg + (size_t)row * 192 + hd * 48 + lq * 4);
    }
    gv0 = *(const uint2*)(zr + 896 + hd * 96 + lq * 4);
    if (lq < 8) gv1 = *(const uint2*)(zr + 896 + hd * 96 + 64 + lq * 4);
    rla = *(const uint2*)(RLA + (size_t)row * 256 + hd * 64 + lq * 4);
    rbx = *(const uint2*)(RBX + (size_t)row * 256 + hd * 64 + lq * 4);
  };
  auto commit = [&](int c) {
    float* d = buf + (size_t)((c & 1) * TC + lstep) * GST;
    const float qs = 0.14433756729740643f;
    if (lq < 12) {
      float av[4] = {__expf(lo2f(gl_.x)), __expf(hi2f(gl_.x)), __expf(lo2f(gl_.y)), __expf(hi2f(gl_.y))};
      float kv[4] = {lo2f(gk.x), hi2f(gk.x), lo2f(gk.y), hi2f(gk.y)};
      float qv[4] = {lo2f(gq.x) * qs, hi2f(gq.x) * qs, lo2f(gq.y) * qs, hi2f(gq.y) * qs};
#pragma unroll
      for (int e = 0; e < 4; ++e) {
        int dd = lq * 4 + e;
        int pos = (dd / 6) * 8 + (dd % 6);
        d[pos] = av[e];
        d[64 + pos] = kv[e];
        d[128 + pos] = qv[e];
      }
    }
    *(float4*)(d + 192 + lq * 4) = make_float4(lo2f(gv0.x), hi2f(gv0.x), lo2f(gv0.y), hi2f(gv0.y));
    if (lq < 8) *(float4*)(d + 192 + 64 + lq * 4) = make_float4(lo2f(gv1.x), hi2f(gv1.x), lo2f(gv1.y), hi2f(gv1.y));
    unsigned* rd = rgbuf + (size_t)((c & 1) * TC + lstep) * 64 + lq * 4;
    uint4 ro;
    ro.x = (rla.x & 0xffffu) | (rbx.x << 16);
    ro.y = (rla.x >> 16) | (rbx.x & 0xffff0000u);
    ro.z = (rla.y & 0xffffu) | (rbx.y << 16);
    ro.w = (rla.y >> 16) | (rbx.y & 0xffff0000u);
    *(uint4*)rd = ro;
  };
  issue(0);
  commit(0);
  __syncthreads();
  constexpr int NCH = NSTEP / TC;
#pragma unroll 1
  for (int c = 0; c < NCH; ++c) {
    if (c + 1 < NCH) issue(c + 1);
    const float* cb = buf + (size_t)(c & 1) * TC * GST;
    float* ob = obuf + (c & 1) * TC * 96;
    if (w < 6) {
#pragma unroll 4
      for (int s = 0; s < TC; ++s) {
        const float* sb = cb + s * GST + dg * 8;
        float4 a03 = *(const float4*)(sb);
        float2 a45 = *(const float2*)(sb + 4);
        float4 k03 = *(const float4*)(sb + 64);
        float2 k45 = *(const float2*)(sb + 68);
        float4 q03 = *(const float4*)(sb + 128);
        float2 q45 = *(const float2*)(sb + 132);
        float v0 = cb[s * GST + 192 + c0], v1 = cb[s * GST + 192 + c1];
        v2f al[3] = {v2f{a03.x, a03.y}, v2f{a03.z, a03.w}, v2f{a45.x, a45.y}};
        v2f kk[3] = {v2f{k03.x, k03.y}, v2f{k03.z, k03.w}, v2f{k45.x, k45.y}};
        v2f qq[3] = {v2f{q03.x, q03.y}, v2f{q03.z, q03.w}, v2f{q45.x, q45.y}};
        v2f vv0 = {v0, v0}, vv1 = {v1, v1};
#pragma unroll
        for (int j = 0; j < 3; ++j) {
          S[0][j] = pkfma(al[j], S[0][j], kk[j] * vv0);
          S[1][j] = pkfma(al[j], S[1][j], kk[j] * vv1);
        }
        v2f o0 = qq[0] * S[0][0], o1 = qq[0] * S[1][0];
        o0 = pkfma(qq[1], S[0][1], o0); o1 = pkfma(qq[1], S[1][1], o1);
        o0 = pkfma(qq[2], S[0][2], o0); o1 = pkfma(qq[2], S[1][2], o1);
        float r0 = oct_sum(o0.x + o0.y), r1 = oct_sum(o1.x + o1.y);
        if (dg == 0) {
          ob[s * 96 + c0] = r0;
          ob[s * 96 + c1] = r1;
        }
      }
    } else if (w == 6) {
      const unsigned* rb = rgbuf + (size_t)(c & 1) * TC * 64 + lane;
      u16* hb = hbuf + (size_t)(c & 1) * TC * 64 + lane;
#pragma unroll 8
      for (int s = 0; s < TC; ++s) {
        unsigned u = rb[s * 64];
        float a = __expf(lo2f(u));
        hst = fmaf(a, hst, hi2f(u));
        hb[s * 64] = f2bf(hst);
      }
    }
    if (c + 1 < NCH) commit(c + 1);
    __syncthreads();
    {
      int row = seq_row(b, dir, c * TC + lstep);
      u16* orow = Od + (size_t)row * 384 + hd * 96;
      float4 x0 = *(const float4*)(ob + lstep * 96 + lq * 4);
      uint2 o;
      o.x = pack2(x0.x, x0.y); o.y = pack2(x0.z, x0.w);
      *(uint2*)(orow + lq * 4) = o;
      if (lq < 8) {
        float4 x1 = *(const float4*)(ob + lstep * 96 + 64 + lq * 4);
        o.x = pack2(x1.x, x1.y); o.y = pack2(x1.z, x1.w);
        *(uint2*)(orow + 64 + lq * 4) = o;
      }
      uint2 hv = *(const uint2*)(hbuf + (size_t)((c & 1) * TC + lstep) * 64 + lq * 4);
      *(uint2*)(Hd + (size_t)row * 256 + hd * 64 + lq * 4) = hv;
    }
  }
  __syncthreads();
}

DEV void phase_scan(PTag p, int l) {
  const int lbid = my_bid();
  for (int task = lbid; task < 256; task += gridDim.x) {
    if (task < 192) scan_rwkv(p, l, task);
    else scan_gla_rg(p, l, task - 192);
  }
}

DEV float gelu_tanh(float x) {
  float u = 0.7978845608028654f * (x + 0.044715f * x * x * x);
  return 0.5f * x * (1.f + tanhf_(u));
}
DEV void phase_post(PTag p, int l) {
  const int ltid = my_tid();
  const int lbid = my_bid();
  (void)ltid; (void)lbid;
  const int lane = ltid & 63;
  const int gw = lbid * 8 + (ltid >> 6), nw = gridDim.x * 8;
  char* ar = KWS + OFF_AR;
  const u16* Z1 = (const u16*)(ar + AR_Z1);
  const u16* RWP = (const u16*)(ar + AR_RWP);
  const u16* RWY = (const u16*)(ar + AR_Z2);
  const u16* Gg = (const u16*)(KWS + OFF_Y);
  const u16* RGH = Gg + (size_t)NT * 384;
  u16* YM = (u16*)(KWS + OFF_XN);
  const float* gnorm = KP(gla_norm) + (size_t)l * 96;
  const float* r_k = KP(rw_r_k) + (size_t)l * 384;
  const float* k_a = KP(rw_k_a) + (size_t)l * 384;
  const float* ln_w = KP(rw_ln_w) + (size_t)l * 384;
  const float* ln_b = KP(rw_ln_b) + (size_t)l * 384;
  for (int row = gw; row < NT; row += nw) {
    {
      uint2 hf = *(const uint2*)(RGH + (size_t)row * 256 + lane * 4);
      uint2 hb = *(const uint2*)(RGH + (size_t)NT * 256 + (size_t)row * 256 + lane * 4);
      uint2 gb = *(const uint2*)(Z1 + (size_t)row * Z1W + 256 + lane * 4);
      float y0 = (lo2f(hf.x) + lo2f(hb.x)) * gelu_tanh(lo2f(gb.x));
      float y1 = (hi2f(hf.x) + hi2f(hb.x)) * gelu_tanh(hi2f(gb.x));
      float y2 = (lo2f(hf.y) + lo2f(hb.y)) * gelu_tanh(lo2f(gb.y));
      float y3 = (hi2f(hf.y) + hi2f(hb.y)) * gelu_tanh(hi2f(gb.y));
      uint2 o;
      o.x = pack2(y0, y1); o.y = pack2(y2, y3);
      *(uint2*)(YM + (size_t)row * 1024 + lane * 4) = o;
    }
    {
      const u16* of = RWY + (size_t)2 * NT * 384 + (size_t)row * 384;
      const u16* ob = RWY + (size_t)3 * NT * 384 + (size_t)row * 384;
      const u16* og = Z1 + (size_t)row * Z1W + 1280;
#pragma unroll
      for (int hd = 0; hd < 4; ++hd) {
        float v0 = bf2f(of[hd * 96 + lane]) + bf2f(ob[hd * 96 + lane]);
        float v1 = 0.f;
        if (lane < 32) v1 = bf2f(of[hd * 96 + 64 + lane]) + bf2f(ob[hd * 96 + 64 + lane]);
        float ss = wave_sum(v0 * v0 + v1 * v1);
        float rs = rsqrtf(ss * (1.f / 96.f) + 1e-6f);
        float g0 = bf2f(og[hd * 96 + lane]);
        YM[(size_t)row * 1024 + 256 + hd * 96 + lane] = f2bf(v0 * rs * gnorm[lane] * siluf_(g0));
        if (lane < 32) {
          float g1 = bf2f(og[hd * 96 + 64 + lane]);
          YM[(size_t)row * 1024 + 256 + hd * 96 + 64 + lane] = f2bf(v1 * rs * gnorm[64 + lane] * siluf_(g1));
        }
      }
    }
    {
      size_t ro = (size_t)row * 384;
#pragma unroll
      for (int j = 0; j < 6; ++j) {
        int idx = j * 64 + lane;
        float y = bf2f(RWY[ro + idx]) + bf2f(RWY[(size_t)NT * 384 + ro + idx]);
        float mean = wave_sum(y) * (1.f / 64.f);
        float dlt = y - mean;
        float var = wave_sum(dlt * dlt) * (1.f / 64.f);
        float yn = dlt * rsqrtf(var + 64e-5f) * ln_w[idx] + ln_b[idx];
        float r = bf2f(RWP[ro + idx]);
        float k = bf2f(RWP[(size_t)NT * 384 + ro + idx]);
        float v = bf2f(RWP[(size_t)2 * NT * 384 + ro + idx]);
        float af = bf2f(RWP[(size_t)5 * NT * 384 + ro + idx]);
        float ab = bf2f(RWP[(size_t)6 * NT * 384 + ro + idx]);
        float bon = wave_sum(r * k * r_k[idx] * (2.f + (af + ab - 2.f) * k_a[idx]));
        yn += bon * v;
        float g = bf2f(Gg[ro + idx]);
        YM[(size_t)row * 1024 + 640 + idx] = f2bf(yn * g);
      }
    }
  }
}

constexpr int NPHASES = 2 + 12 * 4;

DEV void run_phase(PTag p, int ph) {
  float* mod = (float*)(KWS + OFF_MOD);
  char* ws = KWS;
  u16* XN = (u16*)(ws + OFF_XN);
  u16* Yb = (u16*)(ws + OFF_Y);
  u16* U = (u16*)(ws + OFF_AR);
  if (ph == 0) {
    phase_adaln(p);
    __syncthreads();
    conv_ffn(p, 0, 0);
    return;
  }
  if (ph == 1) {
    phase_rows(p, 1, 0, nullptr, nullptr, 0.f, 1, KP(norm_pre) + 0, mod + 0 * 1024, mod + 1 * 1024, NT);
    return;
  }
  int q = ph - 2, l = q / 12, k = q % 12;
  const float* modl = mod + (size_t)l * 9 * 9216;
  const bool last = (l == 3);
  const int Mlate = last ? NLAT : NT;
  switch (k) {
    case 0:
      gemm_phase<1024, EPI_UP>(XN, (const u16*)(ws + OFF_WB + WB_W13T), NT, 5632, U, nullptr);
      break;
    case 1:
      gemm_phase<2816, EPI_Y>(U, (const u16*)(ws + OFF_WB + WB_W2T), NT, 1024, Yb, nullptr);
      break;
    case 2:
      phase_rows(p, 0, 1, KP(norm_post) + (size_t)(l * 3 + 0) * 1024, modl + 2 * 1024, 0.5f, 1,
                 KP(norm_pre) + (size_t)(l * 3 + 1) * 1024, modl + 3 * 1024, modl + 4 * 1024, NT);
      conv_mixer(p, l);
      break;
    case 3:
      gemm_phase<1024, EPI_Z>(XN, (const u16*)(ws + OFF_WB + WB_WINT), NT, PINP, (u16*)(ws + OFF_AR + AR_Z1),
                              (u16*)(ws + OFF_AR + AR_Z2));
      break;
    case 4:
      phase_prep(p, l);
      break;
    case 5:
      phase_scan(p, l);
      break;
    case 6:
      phase_post(p, l);
      break;
    case 7:
      gemm_phase<1024, EPI_Y>(XN, (const u16*)(ws + OFF_WB + WB_WOUTT), Mlate, 1024, Yb, nullptr);
      break;
    case 8:
      phase_rows(p, 0, 1, KP(norm_post) + (size_t)(l * 3 + 1) * 1024, modl + 5 * 1024, 1.0f, 1,
                 KP(norm_pre) + (size_t)(l * 3 + 2) * 1024, modl + 6 * 1024, modl + 7 * 1024, Mlate);
      conv_ffn(p, l, 1);
      break;
    case 9:
      gemm_phase<1024, EPI_UP>(XN, (const u16*)(ws + OFF_WB + WB_W13T), Mlate, 5632, U, nullptr);
      break;
    case 10:
      gemm_phase<2816, EPI_Y>(U, (const u16*)(ws + OFF_WB + WB_W2T), Mlate, 1024, Yb, nullptr);
      break;
    case 11:
      if (!last) {
        const float* modn = mod + (size_t)(l + 1) * 9 * 9216;
        phase_rows(p, 0, 1, KP(norm_post) + (size_t)(l * 3 + 2) * 1024, modl + 8 * 1024, 0.5f, 1,
                   KP(norm_pre) + (size_t)((l + 1) * 3 + 0) * 1024, modn + 0 * 1024, modn + 1 * 1024, NT);
        conv_ffn(p, l + 1, 0);
      } else {
        phase_rows(p, 0, 1, KP(norm_post) + (size_t)(l * 3 + 2) * 1024, modl + 8 * 1024, 0.5f, 0, nullptr, nullptr,
                   nullptr, NLAT);
      }
      break;
  }
}

#ifndef REP_SCAN
#define REP_SCAN 1
#endif
#ifndef REP_GEMM
#define REP_GEMM 1
#endif
#ifndef REP_PREP
#define REP_PREP 1
#endif
#ifndef REP_POST
#define REP_POST 1
#endif
DEV int phase_reps(int ph) {
  if (ph < 2) return 1;
  int k = (ph - 2) % 12;
  if (k == 5) return REP_SCAN;
  if (k == 4) return REP_PREP;
  if (k == 6) return REP_POST;
  if (k == 0 || k == 1 || k == 3 || k == 7 || k == 9 || k == 10) return REP_GEMM;
  return 1;
}
__global__ void __launch_bounds__(NTHREADS, 2) mega_kernel(Params params_, int ph_lo, int ph_hi) {
  PTag p;
  cg::grid_group grid = cg::this_grid();
  for (int ph = ph_lo; ph < ph_hi; ++ph) {
    const int reps = phase_reps(ph);
    for (int r = 0; r < reps; ++r) {
      if (ph > ph_lo || r > 0) grid.sync();
      run_phase(p, ph);
    }
  }
}

extern "C" void kernel_launch(void* const* d_in, const int* in_sizes, int n_in, void* d_out, int out_size, void* d_ws,
                              size_t ws_size, hipStream_t stream) {
  static int grid_blocks = 0;
  if (!grid_blocks) {
    int dev = 0, cus = 0, per_cu = 0;
    hipGetDevice(&dev);
    hipDeviceGetAttribute(&cus, hipDeviceAttributeMultiprocessorCount, dev);
    hipFuncSetAttribute((const void*)mega_kernel, hipFuncAttributeMaxDynamicSharedMemorySize, (int)SMEM_BYTES);
    hipOccupancyMaxActiveBlocksPerMultiprocessor(&per_cu, mega_kernel, NTHREADS, SMEM_BYTES);
    if (per_cu < 1) per_cu = 1;
    grid_blocks = cus * per_cu;
    if (ws_size < WS_TOTAL) fprintf(stderr, "workspace too small: %zu < %zu\n", ws_size, (size_t)WS_TOTAL);
  }
  Params p{};
  const float** pp = (const float**)&p;
  for (int i = 0; i < 34; ++i) pp[i] = (const float*)d_in[i];
  p.out = (float*)d_out;
  p.ws = (char*)d_ws;
#ifdef MULTI_LAUNCH
  for (int ph = 0; ph < NPHASES; ++ph) {
    hipLaunchKernelGGL(mega_kernel, dim3(grid_blocks), dim3(NTHREADS), SMEM_BYTES, stream, p, ph, ph + 1);
  }
#else
  int lo = 0, hi = NPHASES;
  void* args[] = {&p, &lo, &hi};
  hipError_t e = hipLaunchCooperativeKernel((const void*)mega_kernel, dim3(grid_blocks), dim3(NTHREADS), args,
                                            SMEM_BYTES, stream);
  if (e != hipSuccess) fprintf(stderr, "cooperative launch failed: %s (grid %d)\n", hipGetErrorString(e), grid_blocks);
#endif
}
```

```cpp
#include <hip/hip_runtime.h>
#include <hip/hip_cooperative_groups.h>
#include <cstdio>
namespace cg = cooperative_groups;
#define SCAN_PROBE_MODE 0

typedef unsigned short u16;
using bf16x8 = __attribute__((ext_vector_type(8))) short;
using f32x4 = __attribute__((ext_vector_type(4))) float;

#define DEV __device__ __forceinline__

constexpr int NLAT = 32768, NCTXR = 2048, NT = 34816;
constexpr int DM = 1024, DFF = 2816, PIN = 3232, PINP = 3328;
constexpr int Z1W = 1696, Z2W = 1536;
constexpr int NTHREADS = 512;
constexpr size_t SMEM_BYTES = 131072;

constexpr size_t OFF_MOD = 0;
constexpr size_t SZ_MOD = 4ull * 9 * 9216 * 4;
constexpr size_t OFF_HC = OFF_MOD + SZ_MOD;
constexpr size_t SZ_HC = 2048ull * 1024 * 4;
constexpr size_t OFF_INVN = OFF_HC + SZ_HC;
constexpr size_t SZ_INVN = (size_t)NT * 8 * 4;
constexpr size_t OFF_WB = OFF_INVN + SZ_INVN;
constexpr size_t SZ_WB = 5632ull * 1024 * 2 + 1024ull * 2816 * 2;
constexpr size_t OFF_XN = OFF_WB + SZ_WB;
constexpr size_t SZ_XN = (size_t)NT * 1024 * 2;
constexpr size_t OFF_Y = OFF_XN + SZ_XN;
constexpr size_t SZ_Y = SZ_XN;
constexpr size_t OFF_AR = OFF_Y + SZ_Y;
constexpr size_t SZ_384 = (size_t)NT * 384 * 2;
constexpr size_t SZ_256 = (size_t)NT * 256 * 2;
constexpr size_t SZ_192 = (size_t)NT * 192 * 2;
constexpr size_t AR_Z1 = 0;
constexpr size_t AR_Z2 = AR_Z1 + (size_t)NT * Z1W * 2;
constexpr size_t AR_RWP = AR_Z2 + (size_t)NT * Z2W * 2;
constexpr size_t AR_LA = AR_RWP + 7 * SZ_384;
constexpr size_t SZ_AR = AR_LA + 2 * SZ_192;
constexpr size_t WS_TOTAL = OFF_AR + SZ_AR;
constexpr size_t WB_W13T = 0;
constexpr size_t WB_W2T = 5632ull * 1024 * 2;
constexpr size_t WB_WINT = 0;
constexpr size_t WB_WOUTT = WB_WINT + 3328ull * 1024 * 2;
constexpr size_t WB_RWW2T = WB_WOUTT + 1024ull * 1024 * 2;
constexpr size_t WB_RWA2T = WB_RWW2T + 2ull * 384 * 64 * 2;
constexpr size_t WB_RWG2T = WB_RWA2T + 2ull * 384 * 64 * 2;
constexpr size_t WB_RGGT = WB_RWG2T + 384ull * 128 * 2;
constexpr size_t WB_GLAT = WB_RGGT + 16ull * 64 * 64 * 2;

struct Params {
  const float *x, *c, *ctx, *c_ctx, *w_mod, *b_mod, *norm_pre, *norm_post, *ffn_w1, *ffn_w3, *ffn_w2, *w_in, *w_out,
      *rg_conv_w, *rg_conv_b, *rg_gate_a_w, *rg_gate_a_b, *rg_gate_x_w, *rg_gate_x_b, *rg_lambda,
      *gla_alpha_w2, *gla_alpha_b, *gla_norm, *rw_mu, *rw_w0, *rw_w2, *rw_a0, *rw_a2, *rw_g2, *rw_k_k, *rw_k_a,
      *rw_r_k, *rw_ln_w, *rw_ln_b;
  float* out;
  char* ws;
};

extern __shared__ __attribute__((aligned(16))) char g_smem[];

DEV const float* kparg(int off) {
  const char __attribute__((address_space(4)))* kp =
      (const char __attribute__((address_space(4)))*)__builtin_amdgcn_kernarg_segment_ptr();
  return *(const float* volatile const __attribute__((address_space(4)))*)(kp + off);
}
#define KP(name) kparg((int)__builtin_offsetof(Params, name))
#define KWS ((char*)kparg((int)__builtin_offsetof(Params, ws)))
#define KOUT ((float*)kparg((int)__builtin_offsetof(Params, out)))
struct PTag {};

DEV int my_tid() {
  int t = threadIdx.x;
  asm volatile("" : "+v"(t));
  return t;
}
DEV int my_bid() {
  int b = blockIdx.x;
  asm volatile("" : "+s"(b));
  return b;
}
DEV float bf2f(u16 u) { return __uint_as_float(((unsigned)u) << 16); }
DEV u16 f2bf(float f) {
  unsigned u = __float_as_uint(f);
  u += 0x7fffu + ((u >> 16) & 1u);
  return (u16)(u >> 16);
}
DEV unsigned pack2(float a, float b) { return (unsigned)f2bf(a) | ((unsigned)f2bf(b) << 16); }
DEV float lo2f(unsigned u) { return __uint_as_float(u << 16); }
DEV float hi2f(unsigned u) { return __uint_as_float(u & 0xffff0000u); }
DEV float wave_sum(float v);
DEV float sigmoidf_(float x) { return __builtin_amdgcn_rcpf(1.f + __expf(-x)); }
DEV float siluf_(float x) { return x * __builtin_amdgcn_rcpf(1.f + __expf(-x)); }
DEV float tanhf_(float x) { return 1.f - 2.f * __builtin_amdgcn_rcpf(1.f + __expf(2.f * x)); }
DEV float log_sigmoidf_(float x) { return fminf(x, 0.f) - __logf(1.f + __expf(-fabsf(x))); }
template <int CTRL>
DEV float dpp_f(float x) {
  return __int_as_float(__builtin_amdgcn_update_dpp(0, __float_as_int(x), CTRL, 0xf, 0xf, true));
}
DEV float quad_sum(float x) {
  x += dpp_f<0xB1>(x);
  x += dpp_f<0x4E>(x);
  return x;
}
DEV float oct_sum(float x) {
  x = quad_sum(x);
  x += dpp_f<0x141>(x);
  return x;
}
DEV float wave_sum(float x) {
  x = quad_sum(x);
  x += dpp_f<0x141>(x);
  x += dpp_f<0x140>(x);
  float r0 = __int_as_float(__builtin_amdgcn_readlane(__float_as_int(x), 0));
  float r1 = __int_as_float(__builtin_amdgcn_readlane(__float_as_int(x), 16));
  float r2 = __int_as_float(__builtin_amdgcn_readlane(__float_as_int(x), 32));
  float r3 = __int_as_float(__builtin_amdgcn_readlane(__float_as_int(x), 48));
  return (r0 + r1) + (r2 + r3);
}
DEV int seq_row(int b, int dir, int s) {
  if (s < 256) {
    int t = dir ? 255 - s : s;
    return NLAT + b * 256 + t;
  }
  int t = s - 256;
  t = dir ? 4095 - t : t;
  return b * 4096 + t;
}

DEV void phase_adaln(PTag p) {
  const int ltid = my_tid();
  const int lbid = my_bid();
  (void)ltid; (void)lbid;
  float* sc = (float*)g_smem;
  float* red = sc + 9 * 1024;
  float* mod = (float*)(KWS + OFF_MOD);
  const int tid = ltid;
  for (int i = tid; i < 9 * 1024; i += NTHREADS) {
    int m = i >> 10, k = i & 1023;
    float v = (m < 8) ? KP(c)[m * 1024 + k] : KP(c_ctx)[k];
    sc[i] = siluf_(v);
  }
  __syncthreads();
  for (int job = lbid; job < 256; job += gridDim.x) {
    int l = job >> 6, j0 = (job & 63) * 144;
    const float* W = KP(w_mod) + (size_t)l * 1024 * 9216;
    int cgp = tid % 36, ig = tid / 36;
    if (tid < 504) {
      float acc[9][4];
#pragma unroll
      for (int m = 0; m < 9; ++m)
#pragma unroll
        for (int q = 0; q < 4; ++q) acc[m][q] = 0.f;
#pragma unroll 4
      for (int i = ig; i < 1024; i += 14) {
        float4 w4 = *(const float4*)(W + (size_t)i * 9216 + j0 + cgp * 4);
#pragma unroll
        for (int m = 0; m < 9; ++m) {
          float s = sc[m * 1024 + i];
          acc[m][0] += s * w4.x;
          acc[m][1] += s * w4.y;
          acc[m][2] += s * w4.z;
          acc[m][3] += s * w4.w;
        }
      }
#pragma unroll
      for (int m = 0; m < 9; ++m)
#pragma unroll
        for (int q = 0; q < 4; ++q) red[(ig * 9 + m) * 144 + cgp * 4 + q] = acc[m][q];
    }
    __syncthreads();
    for (int o = tid; o < 9 * 144; o += NTHREADS) {
      int m = o / 144, cc = o % 144;
      float s = KP(b_mod)[l * 9216 + j0 + cc];
#pragma unroll
      for (int g = 0; g < 14; ++g) s += red[(g * 9 + m) * 144 + cc];
      mod[(size_t)(l * 9 + m) * 9216 + j0 + cc] = s;
    }
    __syncthreads();
  }
}

DEV void conv_job(const float* srcA, const float* srcB, int interleave, int ld, int Kvalid, int Nvalid, u16* dst,
                  int Kdst, int Ndst, int& tb) {
  const int ltid = my_tid();
  const int lbid = my_bid();
  (void)ltid; (void)lbid;
  float* tile = (float*)g_smem;
  const int tid = ltid;
  int tk = (Kdst + 63) / 64, nt = (Ndst / 64) * tk;
  int G = gridDim.x;
  int start = (((int)lbid - (tb % G)) % G + G) % G;
  for (int t = start; t < nt; t += G) {
    int nn0 = (t / tk) * 64, k0 = (t % tk) * 64;
    int nl = tid & 63, nn = nn0 + nl;
    const float* src;
    int col;
    bool nv;
    if (interleave) {
      int g = nn >> 5, w = nn & 31;
      col = g * 16 + (w & 15);
      src = (w < 16) ? srcA : srcB;
      nv = true;
    } else {
      col = nn;
      src = srcA;
      nv = nn < Nvalid;
    }
#pragma unroll
    for (int pass = 0; pass < 8; ++pass) {
      int kk = pass * 8 + (tid >> 6);
      int k = k0 + kk;
      float v = (nv && k < Kvalid) ? src[(size_t)k * ld + col] : 0.f;
      tile[nl * 65 + kk] = v;
    }
    __syncthreads();
    {
      int nl2 = tid >> 3, kc = tid & 7;
      int k = k0 + kc * 8;
      if (k < Kdst) {
        const float* tp = tile + nl2 * 65 + kc * 8;
        uint4 o;
        o.x = pack2(tp[0], tp[1]);
        o.y = pack2(tp[2], tp[3]);
        o.z = pack2(tp[4], tp[5]);
        o.w = pack2(tp[6], tp[7]);
        *(uint4*)(dst + (size_t)(nn0 + nl2) * Kdst + k) = o;
      }
    }
    __syncthreads();
  }
  tb += nt;
}

DEV void conv_ffn(PTag p, int l, int f) {
  int tb = 0;
  u16* wb = (u16*)(KWS + OFF_WB);
  size_t o13 = ((size_t)(l * 2 + f)) * 1024 * 2816;
  conv_job(KP(ffn_w1) + o13, KP(ffn_w3) + o13, 1, 2816, 1024, 5632, (u16*)((char*)wb + WB_W13T), 1024, 5632, tb);
  conv_job(KP(ffn_w2) + o13, nullptr, 0, 1024, 2816, 1024, (u16*)((char*)wb + WB_W2T), 2816, 1024, tb);
}
DEV void conv_mixer(PTag p, int l) {
  int tb = 0;
  char* wb = KWS + OFF_WB;
  conv_job(KP(w_in) + (size_t)l * 1024 * PIN, nullptr, 0, PIN, 1024, PIN, (u16*)(wb + WB_WINT), 1024, PINP, tb);
  conv_job(KP(w_out) + (size_t)l * 1024 * 1024, nullptr, 0, 1024, 1024, 1024, (u16*)(wb + WB_WOUTT), 1024, 1024, tb);
  for (int d = 0; d < 2; ++d) {
    conv_job(KP(rw_w2) + (size_t)(l * 2 + d) * 64 * 384, nullptr, 0, 384, 64, 384, (u16*)(wb + WB_RWW2T) + d * 384 * 64, 64,
             384, tb);
    conv_job(KP(rw_a2) + (size_t)(l * 2 + d) * 64 * 384, nullptr, 0, 384, 64, 384, (u16*)(wb + WB_RWA2T) + d * 384 * 64, 64,
             384, tb);
    conv_job(KP(gla_alpha_w2) + (size_t)(l * 2 + d) * 16 * 192, nullptr, 0, 192, 16, 192, (u16*)(wb + WB_GLAT) + d * 192 * 32,
             32, 192, tb);
    for (int h = 0; h < 4; ++h) {
      conv_job(KP(rg_gate_a_w) + (size_t)((l * 2 + d) * 4 + h) * 4096, nullptr, 0, 64, 64, 64,
               (u16*)(wb + WB_RGGT) + ((d * 2 + 0) * 4 + h) * 4096, 64, 64, tb);
      conv_job(KP(rg_gate_x_w) + (size_t)((l * 2 + d) * 4 + h) * 4096, nullptr, 0, 64, 64, 64,
               (u16*)(wb + WB_RGGT) + ((d * 2 + 1) * 4 + h) * 4096, 64, 64, tb);
    }
  }
  conv_job(KP(rw_g2) + (size_t)l * 128 * 384, nullptr, 0, 384, 128, 384, (u16*)(wb + WB_RWG2T), 128, 384, tb);
}

DEV void phase_rows(PTag p, int init, int has_y, const float* gpost, const float* mod_gate, float coef,
                    int has_next, const float* gpre, const float* mod_shift, const float* mod_scale, int Mrows) {
  const int ltid = my_tid();
  const int lbid = my_bid();
  const int lane = ltid & 63;
  const int gw = lbid * 8 + (ltid >> 6), nw = gridDim.x * 8;
  float* hc = (float*)(KWS + OFF_HC);
  const u16* Y = (const u16*)(KWS + OFF_Y);
  u16* XN = (u16*)(KWS + OFF_XN);
  float* outp = KOUT;
  const float* xin = KP(x);
  const float* cin = KP(ctx);
  float4 gpo[4], gpr[4];
#pragma unroll
  for (int i = 0; i < 4; ++i) {
    gpo[i] = has_y ? ((const float4*)gpost)[lane + 64 * i] : make_float4(0.f, 0.f, 0.f, 0.f);
    gpr[i] = has_next ? ((const float4*)gpre)[lane + 64 * i] : make_float4(0.f, 0.f, 0.f, 0.f);
  }
  for (int row0 = gw; row0 < Mrows; row0 += 2 * nw) {
    float4 h[2][4], g[2][4], sh[2][4], sc[2][4];
    uint2 yr[2][4];
    bool valid[2];
    float* hp[2];
    int rows[2];
#pragma unroll
    for (int r = 0; r < 2; ++r) {
      int row = row0 + r * nw;
      valid[r] = row < Mrows;
      if (!valid[r]) row = row0;
      rows[r] = row;
      int m = row < NLAT ? (row >> 12) : 8;
      hp[r] = row < NLAT ? outp + (size_t)row * 1024 : hc + (size_t)(row - NLAT) * 1024;
      const float* src = hp[r];
      if (init) src = row < NLAT ? xin + (size_t)row * 1024 : cin + (size_t)(row - NLAT) * 1024;
#pragma unroll
      for (int i = 0; i < 4; ++i) h[r][i] = ((const float4*)src)[lane + 64 * i];
      if (has_y) {
#pragma unroll
        for (int i = 0; i < 4; ++i) {
          yr[r][i] = ((const uint2*)(Y + (size_t)row * 1024))[lane + 64 * i];
          g[r][i] = ((const float4*)(mod_gate + (size_t)m * 9216))[lane + 64 * i];
        }
      }
      if (has_next) {
#pragma unroll
        for (int i = 0; i < 4; ++i) {
          sh[r][i] = ((const float4*)(mod_shift + (size_t)m * 9216))[lane + 64 * i];
          sc[r][i] = ((const float4*)(mod_scale + (size_t)m * 9216))[lane + 64 * i];
        }
      }
    }
#pragma unroll
    for (int r = 0; r < 2; ++r) {
      if (has_y) {
        float4 y[4];
        float ss = 0.f;
#pragma unroll
        for (int i = 0; i < 4; ++i) {
          uint2 u = yr[r][i];
          y[i].x = lo2f(u.x); y[i].y = hi2f(u.x); y[i].z = lo2f(u.y); y[i].w = hi2f(u.y);
          ss += y[i].x * y[i].x + y[i].y * y[i].y + y[i].z * y[i].z + y[i].w * y[i].w;
        }
        ss = wave_sum(ss);
        float rs = rsqrtf(ss * (1.f / 1024.f) + 1e-6f) * coef;
#pragma unroll
        for (int i = 0; i < 4; ++i) {
          h[r][i].x += g[r][i].x * (y[i].x * rs * gpo[i].x);
          h[r][i].y += g[r][i].y * (y[i].y * rs * gpo[i].y);
          h[r][i].z += g[r][i].z * (y[i].z * rs * gpo[i].z);
          h[r][i].w += g[r][i].w * (y[i].w * rs * gpo[i].w);
        }
      }
    }
#pragma unroll
    for (int r = 0; r < 2; ++r) {
      if ((init || has_y) && valid[r]) {
#pragma unroll
        for (int i = 0; i < 4; ++i) ((float4*)hp[r])[lane + 64 * i] = h[r][i];
      }
      if (has_next) {
        float ss = 0.f;
#pragma unroll
        for (int i = 0; i < 4; ++i)
          ss += h[r][i].x * h[r][i].x + h[r][i].y * h[r][i].y + h[r][i].z * h[r][i].z + h[r][i].w * h[r][i].w;
        ss = wave_sum(ss);
        float rs = rsqrtf(ss * (1.f / 1024.f) + 1e-6f);
        if (valid[r]) {
#pragma unroll
          for (int i = 0; i < 4; ++i) {
            float a = (h[r][i].x * rs * gpr[i].x) * (1.f + sc[r][i].x) + sh[r][i].x;
            float b = (h[r][i].y * rs * gpr[i].y) * (1.f + sc[r][i].y) + sh[r][i].y;
            float c = (h[r][i].z * rs * gpr[i].z) * (1.f + sc[r][i].z) + sh[r][i].z;
            float d = (h[r][i].w * rs * gpr[i].w) * (1.f + sc[r][i].w) + sh[r][i].w;
            uint2 o;
            o.x = pack2(a, b);
            o.y = pack2(c, d);
            ((uint2*)(XN + (size_t)rows[r] * 1024))[lane + 64 * i] = o;
          }
        }
      }
    }
  }
}

constexpr int BM = 256, BK = 64, HALF = 128, HT = HALF * BK;
DEV int lds_byte(int r, int c) {
  int st = (r >> 4) * 2 + (c >> 5), rr = r & 15, cc = c & 31, ob = rr * 64 + cc * 2;
  return st * 1024 + (ob ^ (((ob >> 9) & 1) << 5));
}
DEV void stage_rc(int b, int& R, int& C) {
  int st = b / 1024, sb = b % 1024, swz = sb ^ (((sb >> 9) & 1) << 5);
  R = (st >> 1) * 16 + swz / 64;
  C = (st & 1) * 32 + (swz % 64) / 2;
}
enum { EPI_UP = 0, EPI_Y = 1, EPI_Z = 2 };

template <int K, int EPI>
DEV void gemm_phase(const u16* __restrict__ A, const u16* __restrict__ Bt, int M, int N, u16* __restrict__ O0,
                    u16* __restrict__ O1) {
  const int ltid = my_tid();
  const int lbid = my_bid();
  (void)ltid; (void)lbid;
  u16* shm = (u16*)g_smem;
#define SA(b, h) (shm + ((b) * 2 + (h)) * HT)
#define SB(b, h) (shm + (4 + (b) * 2 + (h)) * HT)
#define STAGE(P, GB, kc)                                                                                        \
  do {                                                                                                           \
    __builtin_amdgcn_global_load_lds((const unsigned*)((const char*)(GB) + vb0 + (kc) * (BK * 2)),              \
                                     (unsigned*)((char*)(P) + wbase), 16, 0, 0);                                 \
    __builtin_amdgcn_global_load_lds((const unsigned*)((const char*)(GB) + vb1 + (kc) * (BK * 2)),              \
                                     (unsigned*)((char*)(P) + wbase + 8192), 16, 0, 0);                          \
  } while (0)
#define LDA(dst, b, h)                                                                                 \
  for (int m = 0; m < 4; ++m)                                                                          \
    for (int k = 0; k < 2; ++k)                                                                        \
  dst[m][k] = *reinterpret_cast<const bf16x8*>(aBase + (((b) * 2 + (h)) * 16384 + m * 2048 + k * 1024))
#define LDB(dst, b, h)                                                                                 \
  for (int n = 0; n < 2; ++n)                                                                          \
    for (int k = 0; k < 2; ++k)                                                                        \
  dst[n][k] = *reinterpret_cast<const bf16x8*>(bBase + (((b) * 2 + (h)) * 16384 + n * 2048 + k * 1024))
#define MMA(ai, bj, At_, Bt_)                                                                          \
  do {                                                                                                 \
    __builtin_amdgcn_s_setprio(1);                                                                     \
    for (int m = 0; m < 4; ++m)                                                                        \
      for (int n = 0; n < 2; ++n)                                                                      \
        for (int k = 0; k < 2; ++k)                                                                    \
          acc[ai][bj][m][n] =                                                                          \
              __builtin_amdgcn_mfma_f32_16x16x32_bf16(At_[m][k], Bt_[n][k], acc[ai][bj][m][n], 0, 0, 0); \
    __builtin_amdgcn_s_setprio(0);                                                                     \
  } while (0)
#define WAIT_V(n) asm volatile("s_waitcnt vmcnt(" #n ")" ::: "memory")
#define WAIT_L(n) asm volatile("s_waitcnt lgkmcnt(" #n ")" ::: "memory")
#define BAR __builtin_amdgcn_s_barrier()
#define SCHED __builtin_amdgcn_sched_barrier(0)

  const int tid = ltid;
  const int tid16 = tid * 16;
  unsigned off0, off1;
  {
    int r, c;
    stage_rc(tid16, r, c);
    off0 = (unsigned)(r * K + c) * 2u;
    stage_rc(tid16 + 8192, r, c);
    off1 = (unsigned)(r * K + c) * 2u;
  }
  const int wbase = __builtin_amdgcn_readfirstlane(tid >> 6) * 1024;
  const int wid = tid >> 6, lane = tid & 63, wr = wid >> 2, wc = wid & 3, fr = lane & 15, fq = lane >> 4;
  const int nM = M / BM, nN = N / BM, nwg = nM * nN;
  constexpr int nt = K / BK;
  const int lo_ = lds_byte(fr, fq * 8);
  const char* aBase = (const char*)g_smem + wr * 8192 + lo_;
  const char* bBase = (const char*)g_smem + 65536 + wc * 4096 + lo_;
  constexpr int WGM = 8;
  for (int tix = lbid; tix < nwg; tix += gridDim.x) {
    int wgid = tix;
    {
      int q = nwg / 8, r = nwg % 8, xcd = wgid % 8, off = wgid / 8;
      wgid = (xcd < r ? xcd * (q + 1) : r * (q + 1) + (xcd - r) * q) + off;
    }
    int nig = WGM * nN, gid = wgid / nig, fm = gid * WGM, gsz = min(nM - fm, WGM);
    int pm = fm + ((wgid % nig) % gsz), pn = (wgid % nig) / gsz, brow = pm * BM, bcol = pn * BM;
    f32x4 acc[2][2][4][2];
#pragma unroll
    for (int a = 0; a < 2; ++a)
#pragma unroll
      for (int b = 0; b < 2; ++b)
#pragma unroll
        for (int m = 0; m < 4; ++m)
#pragma unroll
          for (int n = 0; n < 2; ++n) acc[a][b][m][n] = f32x4{0.f, 0.f, 0.f, 0.f};
    bf16x8 At[4][2], B0[2][2], B1[2][2];
    const u16* gA0 = A + (size_t)brow * K;
    const u16* gA1 = gA0 + (size_t)HALF * K;
    const u16* gB0 = Bt + (size_t)bcol * K;
    const u16* gB1 = gB0 + (size_t)HALF * K;
    unsigned vb0 = off0, vb1 = off1;
    STAGE(SB(0, 0), gB0, 0);
    STAGE(SA(0, 0), gA0, 0);
    STAGE(SB(0, 1), gB1, 0);
    STAGE(SA(0, 1), gA1, 0);
    if (wr == 1) BAR;
    WAIT_V(4);
    BAR;
    STAGE(SB(1, 0), gB0, 1);
    STAGE(SA(1, 0), gA0, 1);
    STAGE(SB(1, 1), gB1, 1);
    WAIT_V(6);
    BAR;
#pragma unroll 1
    for (int t = 0; t < nt - 2; t += 2, vb0 += 2 * BK * 2, vb1 += 2 * BK * 2) {
      LDB(B0, 0, 0); SCHED; LDA(At, 0, 0); STAGE(SA(1, 1), gA1, 1);
      WAIT_L(8); BAR; WAIT_L(0); MMA(0, 0, At, B0); BAR; SCHED;
      LDB(B1, 0, 1); STAGE(SB(0, 0), gB0, 2);
      BAR; WAIT_L(0); MMA(0, 1, At, B1); BAR;
      LDA(At, 0, 1); STAGE(SA(0, 0), gA0, 2);
      BAR; WAIT_L(0); MMA(1, 0, At, B0); BAR; SCHED;
      STAGE(SB(0, 1), gB1, 2);
      WAIT_V(6); BAR; MMA(1, 1, At, B1); BAR;
      LDB(B0, 1, 0); SCHED; LDA(At, 1, 0); STAGE(SA(0, 1), gA1, 2);
      WAIT_L(8); BAR; WAIT_L(0); MMA(0, 0, At, B0); BAR; SCHED;
      LDB(B1, 1, 1); STAGE(SB(1, 0), gB0, 3);
      BAR; WAIT_L(0); MMA(0, 1, At, B1); BAR;
      LDA(At, 1, 1); STAGE(SA(1, 0), gA0, 3);
      BAR; WAIT_L(0); MMA(1, 0, At, B0); BAR; SCHED;
      STAGE(SB(1, 1), gB1, 3);
      WAIT_V(6); BAR; MMA(1, 1, At, B1); BAR;
    }
    {
      LDB(B0, 0, 0); LDA(At, 0, 0); STAGE(SA(1, 1), gA1, 1);
      BAR; WAIT_L(0); MMA(0, 0, At, B0); BAR;
      LDB(B1, 0, 1); BAR; WAIT_L(0); MMA(0, 1, At, B1); BAR;
      LDA(At, 0, 1); WAIT_V(4); BAR; WAIT_L(0); MMA(1, 0, At, B0); MMA(1, 1, At, B1); BAR;
    }
    {
      LDB(B0, 1, 0); LDA(At, 1, 0); WAIT_V(2); BAR; WAIT_L(0); MMA(0, 0, At, B0); BAR;
      LDB(B1, 1, 1); WAIT_V(0); BAR; WAIT_L(0); MMA(0, 1, At, B1); BAR;
      LDA(At, 1, 1); BAR; WAIT_L(0); MMA(1, 0, At, B0); MMA(1, 1, At, B1); BAR;
    }
    if (wr == 0) BAR;
#pragma unroll
    for (int ai = 0; ai < 2; ++ai)
#pragma unroll
      for (int bj = 0; bj < 2; ++bj)
#pragma unroll
        for (int m = 0; m < 4; ++m) {
          int rowb = brow + ai * HALF + wr * 64 + m * 16 + fq * 4;
          if (EPI == EPI_UP) {
            int hcol = ((bcol + bj * HALF + wc * 32) >> 1) + fr;
#pragma unroll
            for (int j = 0; j < 4; ++j) {
              float a = acc[ai][bj][m][0][j], b = acc[ai][bj][m][1][j];
              O0[(size_t)(rowb + j) * DFF + hcol] = f2bf(siluf_(a) * b);
            }
          } else {
#pragma unroll
            for (int n = 0; n < 2; ++n) {
              int col = bcol + bj * HALF + wc * 32 + n * 16 + fr;
#pragma unroll
              for (int j = 0; j < 4; ++j) {
                float v = acc[ai][bj][m][n][j];
                if (EPI == EPI_Y) {
                  O0[(size_t)(rowb + j) * DM + col] = f2bf(v);
                } else {
                  if (col < Z1W) O0[(size_t)(rowb + j) * Z1W + col] = f2bf(v);
                  else if (col < PIN) O1[(size_t)(rowb + j) * Z2W + (col - Z1W)] = f2bf(v);
                }
              }
            }
          }
        }
  }
#undef SA
#undef SB
#undef STAGE
#undef LDA
#undef LDB
#undef MMA
}

DEV bf16x8 ld_frag_g(const u16* p) { return *reinterpret_cast<const bf16x8*>(p); }
DEV bf16x8 ld_frag_s(const u16* p) { return *reinterpret_cast<const bf16x8*>(p); }

constexpr int ALD = 392;
constexpr int XLD = 264;
constexpr int GLD = 40;

DEV void phase_prep(PTag p, int l) {
  const int ltid = my_tid();
  const int lbid = my_bid();
  (void)ltid; (void)lbid;
  const int tid = ltid, lane = tid & 63, wid = tid >> 6;
  const int fr = lane & 15, fq = lane >> 4;
  char* ar = KWS + OFF_AR;
  const u16* Z1 = (const u16*)(ar + AR_Z1);
  const u16* Z2 = (const u16*)(ar + AR_Z2);
  u16* RWP = (u16*)(ar + AR_RWP);
  u16* LA = (u16*)(ar + AR_LA);
  float* invn = (float*)(KWS + OFF_INVN);
  u16* Gout = (u16*)(KWS + OFF_Y);
  u16* RGP = (u16*)(KWS + OFF_XN);
  const char* wb = KWS + OFF_WB;
  u16* A_lds = (u16*)g_smem;
  u16* X_lds = (u16*)(g_smem + 50176);
  u16* Gl_lds = (u16*)(g_smem + 50176 + 33792);
  const float* mu = KP(rw_mu) + (size_t)l * 1536;
  const float* k_k = KP(rw_k_k) + (size_t)l * 384;

  for (int tile = lbid; tile < NT / 64; tile += gridDim.x) {
    const int r0 = tile * 64;
    const bool lat = r0 < NLAT;
    const int tpos0 = lat ? (r0 & 4095) : ((r0 - NLAT) & 255);
    const int seglen = lat ? 4096 : 256;
    for (int it0 = 0; it0 < 24; it0 += 4) {
      uint4 own[4], n0[4], n1[4], n2[4], n3[4];
#pragma unroll
      for (int b4 = 0; b4 < 4; ++b4) {
        int q = (it0 + b4) * NTHREADS + tid;
        int i = q / 192, cc = q % 192, c0 = cc * 8;
        int row = r0 + i, tpos = tpos0 + i;
        const u16* zr = Z2 + (size_t)row * Z2W + c0;
        uint4 z4 = {0u, 0u, 0u, 0u};
        own[b4] = *(const uint4*)zr;
        n0[b4] = z4; n1[b4] = z4; n2[b4] = z4; n3[b4] = z4;
        if (lat) {
          int gcol = tpos & 63, grow = tpos >> 6;
          if (gcol > 0) n0[b4] = *(const uint4*)(zr - Z2W);
          if (gcol < 63) n1[b4] = *(const uint4*)(zr + Z2W);
          if (grow > 0) n2[b4] = *(const uint4*)(zr - 64 * Z2W);
          if (grow < 63) n3[b4] = *(const uint4*)(zr + 64 * Z2W);
        } else {
          if (tpos > 0) n0[b4] = *(const uint4*)(zr - Z2W);
          if (tpos < 255) n1[b4] = *(const uint4*)(zr + Z2W);
          n2[b4] = n0[b4];
          n3[b4] = n1[b4];
        }
      }
#pragma unroll
      for (int b4 = 0; b4 < 4; ++b4) {
        int q = (it0 + b4) * NTHREADS + tid;
        int i = q / 192, cc = q % 192, c0 = cc * 8;
        int row = r0 + i;
        float4 mu0 = *(const float4*)(mu + c0), mu1 = *(const float4*)(mu + c0 + 4);
        float f[8];
        {
          float o0 = lo2f(own[b4].x), o1 = hi2f(own[b4].x), o2 = lo2f(own[b4].y), o3 = hi2f(own[b4].y);
          float o4 = lo2f(own[b4].z), o5 = hi2f(own[b4].z), o6 = lo2f(own[b4].w), o7 = hi2f(own[b4].w);
          float s0 = lo2f(n0[b4].x), s1 = hi2f(n1[b4].x), s2 = lo2f(n2[b4].y), s3 = hi2f(n3[b4].y);
          float s4 = lo2f(n0[b4].z), s5 = hi2f(n1[b4].z), s6 = lo2f(n2[b4].w), s7 = hi2f(n3[b4].w);
          f[0] = o0 + mu0.x * (s0 - o0);
          f[1] = o1 + mu0.y * (s1 - o1);
          f[2] = o2 + mu0.z * (s2 - o2);
          f[3] = o3 + mu0.w * (s3 - o3);
          f[4] = o4 + mu1.x * (s4 - o4);
          f[5] = o5 + mu1.y * (s5 - o5);
          f[6] = o6 + mu1.z * (s6 - o6);
          f[7] = o7 + mu1.w * (s7 - o7);
        }
        if (c0 < 1152) {
          int arr = c0 / 384, cin = c0 % 384;
          uint4 o;
          o.x = pack2(f[0], f[1]); o.y = pack2(f[2], f[3]); o.z = pack2(f[4], f[5]); o.w = pack2(f[6], f[7]);
          *(uint4*)(RWP + (size_t)arr * NT * 384 + (size_t)row * 384 + cin) = o;
          if (arr == 1) {
            float4 kk0 = *(const float4*)(k_k + cin), kk1 = *(const float4*)(k_k + cin + 4);
            float a0 = f[0] * kk0.x, a1 = f[1] * kk0.y, a2 = f[2] * kk0.z, a3 = f[3] * kk0.w;
            float a4 = f[4] * kk1.x, a5 = f[5] * kk1.y, a6 = f[6] * kk1.z, a7 = f[7] * kk1.w;
            float ss = a0 * a0 + a1 * a1 + a2 * a2 + a3 * a3 + a4 * a4 + a5 * a5 + a6 * a6 + a7 * a7;
            ss = oct_sum(ss);
            if ((lane & 7) == 0) invn[(size_t)row * 8 + (cin >> 6)] = 1.f / fmaxf(sqrtf(ss), 1e-12f);
          }
        } else {
          int cl = c0 - 1152;
          if (cl < 128) {
#pragma unroll
            for (int e = 0; e < 8; ++e) f[e] = tanhf_(f[e]);
          } else if (cl >= 256) {
#pragma unroll
            for (int e = 0; e < 8; ++e) f[e] = sigmoidf_(f[e]);
          }
          uint4 o;
          o.x = pack2(f[0], f[1]); o.y = pack2(f[2], f[3]); o.z = pack2(f[4], f[5]); o.w = pack2(f[6], f[7]);
          *(uint4*)(A_lds + i * ALD + cl) = o;
        }
      }
    }
    {
      const float* cw = KP(rg_conv_w) + (size_t)l * 4 * 256;
      const float* cb = KP(rg_conv_b) + (size_t)l * 256;
      for (int it = 0; it < 4; ++it) {
        int q = it * NTHREADS + tid;
        int i = q >> 5, c0 = (q & 31) * 8;
        int row = r0 + i, tpos = tpos0 + i;
        float accv[8];
        {
          float4 b0 = *(const float4*)(cb + c0), b1 = *(const float4*)(cb + c0 + 4);
          accv[0] = b0.x; accv[1] = b0.y; accv[2] = b0.z; accv[3] = b0.w;
          accv[4] = b1.x; accv[5] = b1.y; accv[6] = b1.z; accv[7] = b1.w;
        }
#pragma unroll
        for (int j = 0; j < 4; ++j) {
          int tt = tpos + j - 2;
          if (tt >= 0 && tt < seglen) {
            uint4 xv = *(const uint4*)(Z1 + (size_t)(row + j - 2) * Z1W + c0);
            float4 w0 = *(const float4*)(cw + j * 256 + c0), w1 = *(const float4*)(cw + j * 256 + c0 + 4);
            accv[0] += w0.x * lo2f(xv.x); accv[1] += w0.y * hi2f(xv.x);
            accv[2] += w0.z * lo2f(xv.y); accv[3] += w0.w * hi2f(xv.y);
            accv[4] += w1.x * lo2f(xv.z); accv[5] += w1.y * hi2f(xv.z);
            accv[6] += w1.z * lo2f(xv.w); accv[7] += w1.w * hi2f(xv.w);
          }
        }
        uint4 o;
        o.x = pack2(accv[0], accv[1]); o.y = pack2(accv[2], accv[3]);
        o.z = pack2(accv[4], accv[5]); o.w = pack2(accv[6], accv[7]);
        *(uint4*)(X_lds + i * XLD + c0) = o;
      }
      {
        int q = tid;
        int i = q >> 3, d = (q >> 2) & 1, ch = q & 3;
        uint4 o = {0u, 0u, 0u, 0u};
        if (ch < 2) o = *(const uint4*)(Z1 + (size_t)(r0 + i) * Z1W + 1664 + d * 16 + ch * 8);
        *(uint4*)(Gl_lds + (d * 64 + i) * GLD + ch * 8) = o;
      }
    }
    __syncthreads();
    for (int u = wid; u < 120; u += 8) {
      int g = u / 24, ntile = u % 24, n0 = ntile * 16;
      int n = n0 + fr;
      int nc = n0 + fq * 4;
      f32x4 acc[4];
#pragma unroll
      for (int m = 0; m < 4; ++m) acc[m] = f32x4{0.f, 0.f, 0.f, 0.f};
      if (g < 4) {
        const u16* Bt = (const u16*)(wb + ((g < 2) ? WB_RWW2T : WB_RWA2T)) + (size_t)(g & 1) * 384 * 64;
        bf16x8 b0 = ld_frag_g(Bt + (size_t)n * 64 + fq * 8), b1 = ld_frag_g(Bt + (size_t)n * 64 + 32 + fq * 8);
#pragma unroll
        for (int m = 0; m < 4; ++m) {
          const u16* ap = A_lds + (m * 16 + fr) * ALD + g * 64 + fq * 8;
          acc[m] = __builtin_amdgcn_mfma_f32_16x16x32_bf16(b0, ld_frag_s(ap), acc[m], 0, 0, 0);
          acc[m] = __builtin_amdgcn_mfma_f32_16x16x32_bf16(b1, ld_frag_s(ap + 32), acc[m], 0, 0, 0);
        }
      } else {
        const u16* Bt = (const u16*)(wb + WB_RWG2T);
        bf16x8 b[4];
#pragma unroll
        for (int k = 0; k < 4; ++k) b[k] = ld_frag_g(Bt + (size_t)n * 128 + k * 32 + fq * 8);
#pragma unroll
        for (int m = 0; m < 4; ++m) {
          const u16* ap = A_lds + (m * 16 + fr) * ALD + 256 + fq * 8;
#pragma unroll
          for (int k = 0; k < 4; ++k)
            acc[m] = __builtin_amdgcn_mfma_f32_16x16x32_bf16(b[k], ld_frag_s(ap + k * 32), acc[m], 0, 0, 0);
        }
      }
      if (g < 2) {
        float4 w0v = *(const float4*)(KP(rw_w0) + (size_t)(l * 2 + g) * 384 + nc);
        u16* dst = RWP + (size_t)(3 + g) * NT * 384;
#pragma unroll
        for (int m = 0; m < 4; ++m) {
          int row = r0 + m * 16 + fr;
          uint2 o;
          o.x = pack2(sigmoidf_(w0v.x + acc[m][0]) * 0.60653066f, sigmoidf_(w0v.y + acc[m][1]) * 0.60653066f);
          o.y = pack2(sigmoidf_(w0v.z + acc[m][2]) * 0.60653066f, sigmoidf_(w0v.w + acc[m][3]) * 0.60653066f);
          *(uint2*)(dst + (size_t)row * 384 + nc) = o;
        }
      } else if (g < 4) {
        float4 a0v = *(const float4*)(KP(rw_a0) + (size_t)(l * 2 + (g - 2)) * 384 + nc);
        u16* dst = RWP + (size_t)(5 + (g - 2)) * NT * 384;
#pragma unroll
        for (int m = 0; m < 4; ++m) {
          int row = r0 + m * 16 + fr;
          uint2 o;
          o.x = pack2(sigmoidf_(a0v.x + acc[m][0]), sigmoidf_(a0v.y + acc[m][1]));
          o.y = pack2(sigmoidf_(a0v.z + acc[m][2]), sigmoidf_(a0v.w + acc[m][3]));
          *(uint2*)(dst + (size_t)row * 384 + nc) = o;
        }
      } else {
#pragma unroll
        for (int m = 0; m < 4; ++m) {
          int row = r0 + m * 16 + fr;
          uint2 o;
          o.x = pack2(acc[m][0], acc[m][1]);
          o.y = pack2(acc[m][2], acc[m][3]);
          *(uint2*)(Gout + (size_t)row * 384 + nc) = o;
        }
      }
    }
    for (int u = wid; u < 32; u += 8) {
      int d = u >> 4, hd = (u >> 2) & 3, ntile = u & 3;
      int nl = ntile * 16 + fr;
      int chc = hd * 64 + ntile * 16 + fq * 4;
      const u16* Ba = (const u16*)(wb + WB_RGGT) + (size_t)((d * 2 + 0) * 4 + hd) * 4096 + nl * 64;
      const u16* Bx = (const u16*)(wb + WB_RGGT) + (size_t)((d * 2 + 1) * 4 + hd) * 4096 + nl * 64;
      bf16x8 ba0 = ld_frag_g(Ba + fq * 8), ba1 = ld_frag_g(Ba + 32 + fq * 8);
      bf16x8 bx0 = ld_frag_g(Bx + fq * 8), bx1 = ld_frag_g(Bx + 32 + fq * 8);
      float4 gab = *(const float4*)(KP(rg_gate_a_b) + (size_t)(l * 2 + d) * 256 + chc);
      float4 gxb = *(const float4*)(KP(rg_gate_x_b) + (size_t)(l * 2 + d) * 256 + chc);
      float4 lam = *(const float4*)(KP(rg_lambda) + (size_t)(l * 2 + d) * 256 + chc);
      float spl[4] = {__logf(1.f + __expf(-lam.x)) * 8.f, __logf(1.f + __expf(-lam.y)) * 8.f,
                      __logf(1.f + __expf(-lam.z)) * 8.f, __logf(1.f + __expf(-lam.w)) * 8.f};
      float gabv[4] = {gab.x, gab.y, gab.z, gab.w}, gxbv[4] = {gxb.x, gxb.y, gxb.z, gxb.w};
      u16* dla = RGP + (size_t)(d * 2 + 0) * NT * 256;
      u16* dbx = RGP + (size_t)(d * 2 + 1) * NT * 256;
#pragma unroll
      for (int m = 0; m < 4; ++m) {
        const u16* ap = X_lds + (m * 16 + fr) * XLD + hd * 64 + fq * 8;
        bf16x8 a0 = ld_frag_s(ap), a1 = ld_frag_s(ap + 32);
        f32x4 ca = f32x4{0.f, 0.f, 0.f, 0.f}, cx = ca;
        ca = __builtin_amdgcn_mfma_f32_16x16x32_bf16(ba0, a0, ca, 0, 0, 0);
        ca = __builtin_amdgcn_mfma_f32_16x16x32_bf16(ba1, a1, ca, 0, 0, 0);
        cx = __builtin_amdgcn_mfma_f32_16x16x32_bf16(bx0, a0, cx, 0, 0, 0);
        cx = __builtin_amdgcn_mfma_f32_16x16x32_bf16(bx1, a1, cx, 0, 0, 0);
        int il = m * 16 + fr;
        int row = r0 + il;
        uint2 xcv = *(const uint2*)(X_lds + il * XLD + chc);
        float xc[4] = {lo2f(xcv.x), hi2f(xcv.x), lo2f(xcv.y), hi2f(xcv.y)};
        float la[4], bx[4];
#pragma unroll
        for (int j = 0; j < 4; ++j) {
          float r = sigmoidf_(ca[j] + gabv[j]), ig = sigmoidf_(cx[j] + gxbv[j]);
          float loga = -r * spl[j];
          float mult = __builtin_amdgcn_sqrtf(fmaxf(1.f - __expf(2.f * loga), 0.f));
          la[j] = loga;
          bx[j] = mult * ig * xc[j];
        }
        uint2 o;
        o.x = pack2(la[0], la[1]); o.y = pack2(la[2], la[3]);
        *(uint2*)(dla + (size_t)row * 256 + chc) = o;
        o.x = pack2(bx[0], bx[1]); o.y = pack2(bx[2], bx[3]);
        *(uint2*)(dbx + (size_t)row * 256 + chc) = o;
      }
    }
    for (int u = wid; u < 24; u += 8) {
      int d = u / 12, ntile = u % 12;
      int n = ntile * 16 + fr;
      int nc = ntile * 16 + fq * 4;
      const u16* Bt = (const u16*)(wb + WB_GLAT) + (size_t)d * 192 * 32;
      bf16x8 b0 = ld_frag_g(Bt + (size_t)n * 32 + fq * 8);
      float4 bb = *(const float4*)(KP(gla_alpha_b) + (size_t)(l * 2 + d) * 192 + nc);
      u16* dst = LA + (size_t)d * NT * 192;
#pragma unroll
      for (int m = 0; m < 4; ++m) {
        const u16* ap = Gl_lds + (d * 64 + m * 16 + fr) * GLD + fq * 8;
        f32x4 cacc = f32x4{0.f, 0.f, 0.f, 0.f};
        cacc = __builtin_amdgcn_mfma_f32_16x16x32_bf16(b0, ld_frag_s(ap), cacc, 0, 0, 0);
        int row = r0 + m * 16 + fr;
        uint2 o;
        o.x = pack2(log_sigmoidf_(cacc[0] + bb.x) * (1.f / 16.f), log_sigmoidf_(cacc[1] + bb.y) * (1.f / 16.f));
        o.y = pack2(log_sigmoidf_(cacc[2] + bb.z) * (1.f / 16.f), log_sigmoidf_(cacc[3] + bb.w) * (1.f / 16.f));
        *(uint2*)(dst + (size_t)row * 192 + nc) = o;
      }
    }
    __syncthreads();
  }
}

constexpr int TC = 32;
constexpr int NSTEP = 4352;
typedef float v2f __attribute__((ext_vector_type(2)));
DEV v2f pkfma(v2f a, v2f b, v2f c) { return __builtin_elementwise_fma(a, b, c); }
DEV float hex_sum(float x) {
  x = quad_sum(x);
  x += dpp_f<0x141>(x);
  x += dpp_f<0x140>(x);
  return x;
}
DEV void hex_sum2(float& x, float& y) {
  x += dpp_f<0xB1>(x); y += dpp_f<0xB1>(y);
  x += dpp_f<0x4E>(x); y += dpp_f<0x4E>(y);
  x += dpp_f<0x141>(x); y += dpp_f<0x141>(y);
  x += dpp_f<0x140>(x); y += dpp_f<0x140>(y);
}

constexpr int RST = 392;
struct RwOps { float4 w, k, a, b, wr; float2 vv; float2 sc; };
DEV void scan_rwkv(PTag p, int l, int task) {
  const int ltid = my_tid();
  const int tid = ltid, lane = tid & 63, w = tid >> 6;
  const int half = task & 1, sc = task >> 1;
  const int b = sc / 12, h = (sc % 12) >> 1, dir = sc & 1;
  char* ar = KWS + OFF_AR;
  const u16* RWP = (const u16*)(ar + AR_RWP);
  const u16* Rg = RWP, *Kg = RWP + (size_t)NT * 384, *Vg = RWP + (size_t)2 * NT * 384;
  const u16* Ug = RWP + (size_t)(3 + dir) * NT * 384, *Ag = RWP + (size_t)(5 + dir) * NT * 384;
  const float* invn = (const float*)(KWS + OFF_INVN);
  u16* Yd = (u16*)(ar + AR_Z2) + (size_t)dir * NT * 384;
  float* buf = (float*)g_smem;
  float* ybuf = buf + 2 * TC * RST;
  const int rl = lane >> 4, kg = lane & 15;
  const int lrow = w * 8 + rl * 2;
  const int lstep = tid >> 4, lq = tid & 15;
  const int ce = h * 64 + lq * 4;
  float4 kkc = *(const float4*)(KP(rw_k_k) + (size_t)l * 384 + ce);
  float4 kac = *(const float4*)(KP(rw_k_a) + (size_t)l * 384 + ce);
  v2f S0 = {0.f, 0.f}, S1 = {0.f, 0.f}, T0 = {0.f, 0.f}, T1 = {0.f, 0.f};

  uint2 gr, gk, gv, gu, ga;
  float gin;
  auto issue = [&](int c) {
    int row = seq_row(b, dir, c * TC + lstep);
    size_t o = (size_t)row * 384 + ce;
    gr = *(const uint2*)(Rg + o);
    gk = *(const uint2*)(Kg + o);
    gv = *(const uint2*)(Vg + o);
    gu = *(const uint2*)(Ug + o);
    ga = *(const uint2*)(Ag + o);
    gin = invn[(size_t)row * 8 + h];
  };
  auto commit = [&](int c, int) {
    float* d = buf + (size_t)((c & 1) * TC + lstep) * RST;
    float r0 = lo2f(gr.x), r1 = hi2f(gr.x), r2 = lo2f(gr.y), r3 = hi2f(gr.y);
    float k0 = lo2f(gk.x), k1 = hi2f(gk.x), k2 = lo2f(gk.y), k3 = hi2f(gk.y);
    float v0 = lo2f(gv.x), v1 = hi2f(gv.x), v2 = lo2f(gv.y), v3 = hi2f(gv.y);
    float u0 = lo2f(gu.x), u1 = hi2f(gu.x), u2 = lo2f(gu.y), u3 = hi2f(gu.y);
    float a0 = lo2f(ga.x), a1 = hi2f(ga.x), a2 = lo2f(ga.y), a3 = hi2f(ga.y);
    float w0 = __expf(-u0), w1 = __expf(-u1), w2 = __expf(-u2), w3 = __expf(-u3);
    float d0 = k0 * (1.f + (a0 - 1.f) * kac.x), d1 = k1 * (1.f + (a1 - 1.f) * kac.y);
    float d2 = k2 * (1.f + (a2 - 1.f) * kac.z), d3 = k3 * (1.f + (a3 - 1.f) * kac.w);
    float q0 = k0 * kkc.x * gin, q1 = k1 * kkc.y * gin, q2 = k2 * kkc.z * gin, q3 = k3 * kkc.w * gin;
    float b0 = q0 * a0, b1 = q1 * a1, b2 = q2 * a2, b3 = q3 * a3;
    *(float4*)(d + lq * 4) = make_float4(w0, w1, w2, w3);
    *(float4*)(d + 64 + lq * 4) = make_float4(d0, d1, d2, d3);
    *(float4*)(d + 128 + lq * 4) = make_float4(-q0, -q1, -q2, -q3);
    *(float4*)(d + 192 + lq * 4) = make_float4(b0, b1, b2, b3);
    *(float4*)(d + 256 + lq * 4) = make_float4(w0 * r0, w1 * r1, w2 * r2, w3 * r3);
    *(float4*)(d + 320 + lq * 4) = make_float4(v0, v1, v2, v3);
    float br = b0 * r0 + b1 * r1 + b2 * r2 + b3 * r3;
    float kr = d0 * r0 + d1 * r1 + d2 * r2 + d3 * r3;
    hex_sum2(br, kr);
    if (lq == 0) *(float2*)(d + 384) = make_float2(br, kr);
  };
  issue(0);
  commit(0, 0);
  __syncthreads();
  constexpr int NCH = NSTEP / TC;
#pragma unroll 1
  for (int c = 0; c < NCH; ++c) {
    const int cn = (c + 1 < NCH) ? c + 1 : c;
    issue(cn);
    const float* cb = buf + (size_t)(c & 1) * TC * RST;
    float* yb = ybuf + (c & 1) * TC * 32;
    if (w < 4) {
      auto ld = [&](int s) {
        RwOps o;
        const float* sb = cb + s * RST + kg * 4;
        o.w = *(const float4*)(sb);
        o.k = *(const float4*)(sb + 64);
        o.a = *(const float4*)(sb + 128);
        o.b = *(const float4*)(sb + 192);
        o.wr = *(const float4*)(sb + 256);
        o.vv = *(const float2*)(cb + s * RST + 320 + half * 32 + lrow);
        o.sc = *(const float2*)(cb + s * RST + 384);
        return o;
      };
      RwOps cur = ld(0);
#pragma unroll 4
      for (int s = 0; s < TC; ++s) {
        RwOps nxt = ld((s + 1) & (TC - 1));
        v2f a01 = {cur.a.x, cur.a.y}, a23 = {cur.a.z, cur.a.w};
        v2f r01 = {cur.wr.x, cur.wr.y}, r23 = {cur.wr.z, cur.wr.w};
        v2f t1 = S0 * a01, t2 = S0 * r01, u1 = T0 * a01, u2 = T0 * r01;
        t1 = pkfma(S1, a23, t1);
        t2 = pkfma(S1, r23, t2);
        u1 = pkfma(T1, a23, u1);
        u2 = pkfma(T1, r23, u2);
        float sa = t1.x + t1.y, yy = t2.x + t2.y, sb_ = u1.x + u1.y, yz = u2.x + u2.y;
        hex_sum2(sa, sb_);
        hex_sum2(yy, yz);
        v2f w01 = {cur.w.x, cur.w.y}, w23 = {cur.w.z, cur.w.w};
        v2f b01 = {cur.b.x, cur.b.y}, b23 = {cur.b.z, cur.b.w};
        v2f k01 = {cur.k.x, cur.k.y}, k23 = {cur.k.z, cur.k.w};
        v2f sa2 = {sa, sa}, sb2 = {sb_, sb_}, va2 = {cur.vv.x, cur.vv.x}, vb2 = {cur.vv.y, cur.vv.y};
        S0 = pkfma(S0, w01, pkfma(sa2, b01, va2 * k01));
        S1 = pkfma(S1, w23, pkfma(sa2, b23, va2 * k23));
        T0 = pkfma(T0, w01, pkfma(sb2, b01, vb2 * k01));
        T1 = pkfma(T1, w23, pkfma(sb2, b23, vb2 * k23));
        yy = fmaf(sa, cur.sc.x, fmaf(cur.vv.x, cur.sc.y, yy));
        yz = fmaf(sb_, cur.sc.x, fmaf(cur.vv.y, cur.sc.y, yz));
        *(float2*)(yb + s * 32 + lrow) = make_float2(yy, yz);
        cur = nxt;
      }
    }
    commit(c + 1, cn);
    __syncthreads();
    if (lq < 8) {
      int row = seq_row(b, dir, c * TC + lstep);
      float4 yv = *(const float4*)(yb + lstep * 32 + lq * 4);
      uint2 o;
      o.x = pack2(yv.x, yv.y);
      o.y = pack2(yv.z, yv.w);
      *(uint2*)(Yd + (size_t)row * 384 + h * 64 + half * 32 + lq * 4) = o;
    }
  }
  __syncthreads();
}

constexpr int GST = 288;
struct GlOps { float4 a03, k03, q03; float2 a45, k45, q45; float v0, v1, v2; };
DEV void scan_gla_rg(PTag p, int l, int task) {
  const int ltid = my_tid();
  const int tid = ltid, lane = tid & 63, w = tid >> 6;
  const int b = task >> 3, hd = (task >> 1) & 3, dir = task & 1;
  char* ar = KWS + OFF_AR;
  const u16* Z1 = (const u16*)(ar + AR_Z1);
  const u16* LAg = (const u16*)(ar + AR_LA) + (size_t)dir * NT * 192;
  u16* Od = (u16*)(ar + AR_Z2) + (size_t)(2 + dir) * NT * 384;
  const u16* RGP = (const u16*)(KWS + OFF_XN);
  const u16* RLA = RGP + (size_t)(dir * 2 + 0) * NT * 256;
  const u16* RBX = RGP + (size_t)(dir * 2 + 1) * NT * 256;
  u16* Hd = (u16*)(KWS + OFF_Y) + (size_t)NT * 384 + (size_t)dir * NT * 256;
  float* buf = (float*)g_smem;
  float* obuf = buf + 2 * TC * GST;
  unsigned* rgbuf = (unsigned*)(obuf + 2 * TC * 96);
  u16* hbuf = (u16*)(rgbuf + 2 * TC * 64);
  const int el = lane >> 3, dg = lane & 7;
  const int c0 = w * 24 + el;
  const int lstep = tid >> 4, lq = tid & 15;
  v2f S[3][3];
#pragma unroll
  for (int c = 0; c < 3; ++c)
#pragma unroll
    for (int j = 0; j < 3; ++j) S[c][j] = v2f{0.f, 0.f};
  float hst = 0.f;
  uint2 gq, gk, gl_, gv0, gv1, rla, rbx;
  auto issue = [&](int c) {
    int row = seq_row(b, dir, c * TC + lstep);
    const u16* zr = Z1 + (size_t)row * Z1W;
    uint2 z = {0u, 0u};
    gq = z; gk = z; gl_ = z; gv1 = z;
    if (lq < 12) {
      gq = *(const uint2*)(zr + 512 + hd * 48 + lq * 4);
      gk = *(const uint2*)(zr + 704 + hd * 48 + lq * 4);
      gl_ = *(const uint2*)(LAg + (size_t)row * 192 + hd * 48 + lq * 4);
    }
    gv0 = *(const uint2*)(zr + 896 + hd * 96 + lq * 4);
    if (lq < 8) gv1 = *(const uint2*)(zr + 896 + hd * 96 + 64 + lq * 4);
    rla = *(const uint2*)(RLA + (size_t)row * 256 + hd * 64 + lq * 4);
    rbx = *(const uint2*)(RBX + (size_t)row * 256 + hd * 64 + lq * 4);
  };
  auto commit = [&](int c, int) {
    float* d = buf + (size_t)((c & 1) * TC + lstep) * GST;
    const float qs = 0.14433756729740643f;
    if (lq < 12) {
      float av[4] = {__expf(lo2f(gl_.x)), __expf(hi2f(gl_.x)), __expf(lo2f(gl_.y)), __expf(hi2f(gl_.y))};
      float kv[4] = {lo2f(gk.x), hi2f(gk.x), lo2f(gk.y), hi2f(gk.y)};
      float qv[4] = {lo2f(gq.x) * qs, hi2f(gq.x) * qs, lo2f(gq.y) * qs, hi2f(gq.y) * qs};
#pragma unroll
      for (int e = 0; e < 4; ++e) {
        int dd = lq * 4 + e;
        int pos = (dd / 6) * 8 + (dd % 6);
        d[pos] = av[e];
        d[64 + pos] = kv[e];
        d[128 + pos] = qv[e];
      }
    }
    *(float4*)(d + 192 + lq * 4) = make_float4(lo2f(gv0.x), hi2f(gv0.x), lo2f(gv0.y), hi2f(gv0.y));
    if (lq < 8) *(float4*)(d + 192 + 64 + lq * 4) = make_float4(lo2f(gv1.x), hi2f(gv1.x), lo2f(gv1.y), hi2f(gv1.y));
    unsigned* rd = rgbuf + (size_t)((c & 1) * TC + lstep) * 64 + lq * 4;
    uint4 ro;
    ro.x = (rla.x & 0xffffu) | (rbx.x << 16);
    ro.y = (rla.x >> 16) | (rbx.x & 0xffff0000u);
    ro.z = (rla.y & 0xffffu) | (rbx.y << 16);
    ro.w = (rla.y >> 16) | (rbx.y & 0xffff0000u);
    *(uint4*)rd = ro;
  };
  issue(0);
  commit(0, 0);
  __syncthreads();
  constexpr int NCH = NSTEP / TC;
#pragma unroll 1
  for (int c = 0; c < NCH; ++c) {
    const int cn = (c + 1 < NCH) ? c + 1 : c;
    issue(cn);
    const float* cb = buf + (size_t)(c & 1) * TC * GST;
    float* ob = obuf + (c & 1) * TC * 96;
    if (w < 4) {
      auto ld = [&](int s) {
        GlOps o;
        const float* sb = cb + s * GST + dg * 8;
        o.a03 = *(const float4*)(sb);
        o.a45 = *(const float2*)(sb + 4);
        o.k03 = *(const float4*)(sb + 64);
        o.k45 = *(const float2*)(sb + 68);
        o.q03 = *(const float4*)(sb + 128);
        o.q45 = *(const float2*)(sb + 132);
        const float* vb = cb + s * GST + 192 + c0;
        o.v0 = vb[0]; o.v1 = vb[8]; o.v2 = vb[16];
        return o;
      };
      GlOps cur = ld(0);
#pragma unroll 4
      for (int s = 0; s < TC; ++s) {
        GlOps nxt = ld((s + 1) & (TC - 1));
        v2f al[3] = {v2f{cur.a03.x, cur.a03.y}, v2f{cur.a03.z, cur.a03.w}, v2f{cur.a45.x, cur.a45.y}};
        v2f kk[3] = {v2f{cur.k03.x, cur.k03.y}, v2f{cur.k03.z, cur.k03.w}, v2f{cur.k45.x, cur.k45.y}};
        v2f qq[3] = {v2f{cur.q03.x, cur.q03.y}, v2f{cur.q03.z, cur.q03.w}, v2f{cur.q45.x, cur.q45.y}};
        v2f vv[3] = {v2f{cur.v0, cur.v0}, v2f{cur.v1, cur.v1}, v2f{cur.v2, cur.v2}};
        float r[3];
#pragma unroll
        for (int ci = 0; ci < 3; ++ci) {
#pragma unroll
          for (int j = 0; j < 3; ++j) S[ci][j] = pkfma(al[j], S[ci][j], kk[j] * vv[ci]);
          v2f o = qq[0] * S[ci][0];
          o = pkfma(qq[1], S[ci][1], o);
          o = pkfma(qq[2], S[ci][2], o);
          r[ci] = o.x + o.y;
        }
        r[0] += dpp_f<0xB1>(r[0]); r[1] += dpp_f<0xB1>(r[1]); r[2] += dpp_f<0xB1>(r[2]);
        r[0] += dpp_f<0x4E>(r[0]); r[1] += dpp_f<0x4E>(r[1]); r[2] += dpp_f<0x4E>(r[2]);
        r[0] += dpp_f<0x141>(r[0]); r[1] += dpp_f<0x141>(r[1]); r[2] += dpp_f<0x141>(r[2]);
        float* op = ob + s * 96 + c0;
        op[0] = r[0]; op[8] = r[1]; op[16] = r[2];
        cur = nxt;
      }
    } else if (w == 4) {
      const unsigned* rb = rgbuf + (size_t)(c & 1) * TC * 64 + lane;
      u16* hb = hbuf + (size_t)(c & 1) * TC * 64 + lane;
      unsigned uu[TC];
#pragma unroll
      for (int s = 0; s < TC; ++s) uu[s] = rb[s * 64];
#pragma unroll
      for (int s = 0; s < TC; ++s) {
        float a = __expf(lo2f(uu[s]));
        hst = fmaf(a, hst, hi2f(uu[s]));
        hb[s * 64] = f2bf(hst);
      }
    }
    commit(c + 1, cn);
    __syncthreads();
    {
      int row = seq_row(b, dir, c * TC + lstep);
      u16* orow = Od + (size_t)row * 384 + hd * 96;
      float4 x0 = *(const float4*)(ob + lstep * 96 + lq * 4);
      uint2 o;
      o.x = pack2(x0.x, x0.y); o.y = pack2(x0.z, x0.w);
      *(uint2*)(orow + lq * 4) = o;
      if (lq < 8) {
        float4 x1 = *(const float4*)(ob + lstep * 96 + 64 + lq * 4);
        o.x = pack2(x1.x, x1.y); o.y = pack2(x1.z, x1.w);
        *(uint2*)(orow + 64 + lq * 4) = o;
      }
      uint2 hv = *(const uint2*)(hbuf + (size_t)((c & 1) * TC + lstep) * 64 + lq * 4);
      *(uint2*)(Hd + (size_t)row * 256 + hd * 64 + lq * 4) = hv;
    }
  }
  __syncthreads();
}

DEV void phase_scan(PTag p, int l, int mode) {
  const int lbid = my_bid();
  for (int task = lbid; task < 256; task += gridDim.x) {
    if (task < 192) { if (mode != 2) scan_rwkv(p, l, task); }
    else { if (mode != 1) scan_gla_rg(p, l, task - 192); }
  }
}

DEV float gelu_tanh(float x) {
  float u = 0.7978845608028654f * (x + 0.044715f * x * x * x);
  return 0.5f * x * (1.f + tanhf_(u));
}
DEV void phase_post(PTag p, int l) {
  const int ltid = my_tid();
  const int lbid = my_bid();
  const int lane = ltid & 63;
  const int gw = lbid * 8 + (ltid >> 6), nw = gridDim.x * 8;
  char* ar = KWS + OFF_AR;
  const u16* Z1 = (const u16*)(ar + AR_Z1);
  const u16* RWP = (const u16*)(ar + AR_RWP);
  const u16* RWY = (const u16*)(ar + AR_Z2);
  const u16* Gg = (const u16*)(KWS + OFF_Y);
  const u16* RGH = Gg + (size_t)NT * 384;
  u16* YM = (u16*)(KWS + OFF_XN);
  const float* gnorm = KP(gla_norm) + (size_t)l * 96;
  const float* r_k = KP(rw_r_k) + (size_t)l * 384;
  const float* k_a = KP(rw_k_a) + (size_t)l * 384;
  const float* ln_w = KP(rw_ln_w) + (size_t)l * 384;
  const float* ln_b = KP(rw_ln_b) + (size_t)l * 384;
  float gn0 = gnorm[lane], gn1 = (lane < 32) ? gnorm[64 + lane] : 0.f;
  float rkc[6], kac[6], lwc[6], lbc[6];
#pragma unroll
  for (int j = 0; j < 6; ++j) {
    rkc[j] = r_k[j * 64 + lane]; kac[j] = k_a[j * 64 + lane];
    lwc[j] = ln_w[j * 64 + lane]; lbc[j] = ln_b[j * 64 + lane];
  }
  const int l32 = lane < 32 ? lane : 0;
  for (int row = gw; row < NT; row += nw) {
    uint2 hf = *(const uint2*)(RGH + (size_t)row * 256 + lane * 4);
    uint2 hb = *(const uint2*)(RGH + (size_t)NT * 256 + (size_t)row * 256 + lane * 4);
    uint2 gb = *(const uint2*)(Z1 + (size_t)row * Z1W + 256 + lane * 4);
    const u16* of = RWY + (size_t)2 * NT * 384 + (size_t)row * 384;
    const u16* ob = RWY + (size_t)3 * NT * 384 + (size_t)row * 384;
    const u16* og = Z1 + (size_t)row * Z1W + 1280;
    u16 gof0[4], gob0[4], gog0[4], gof1[4], gob1[4], gog1[4];
#pragma unroll
    for (int hd = 0; hd < 4; ++hd) {
      gof0[hd] = of[hd * 96 + lane]; gob0[hd] = ob[hd * 96 + lane]; gog0[hd] = og[hd * 96 + lane];
      gof1[hd] = of[hd * 96 + 64 + l32]; gob1[hd] = ob[hd * 96 + 64 + l32]; gog1[hd] = og[hd * 96 + 64 + l32];
    }
    size_t ro = (size_t)row * 384;
    u16 wyf[6], wyb[6], wr[6], wk[6], wv[6], waf[6], wab[6], wg[6];
#pragma unroll
    for (int j = 0; j < 6; ++j) {
      int idx = j * 64 + lane;
      wyf[j] = RWY[ro + idx]; wyb[j] = RWY[(size_t)NT * 384 + ro + idx];
      wr[j] = RWP[ro + idx]; wk[j] = RWP[(size_t)NT * 384 + ro + idx]; wv[j] = RWP[(size_t)2 * NT * 384 + ro + idx];
      waf[j] = RWP[(size_t)5 * NT * 384 + ro + idx]; wab[j] = RWP[(size_t)6 * NT * 384 + ro + idx];
      wg[j] = Gg[ro + idx];
    }
    {
      float y0 = (lo2f(hf.x) + lo2f(hb.x)) * gelu_tanh(lo2f(gb.x));
      float y1 = (hi2f(hf.x) + hi2f(hb.x)) * gelu_tanh(hi2f(gb.x));
      float y2 = (lo2f(hf.y) + lo2f(hb.y)) * gelu_tanh(lo2f(gb.y));
      float y3 = (hi2f(hf.y) + hi2f(hb.y)) * gelu_tanh(hi2f(gb.y));
      uint2 o;
      o.x = pack2(y0, y1); o.y = pack2(y2, y3);
      *(uint2*)(YM + (size_t)row * 1024 + lane * 4) = o;
    }
#pragma unroll
    for (int hd = 0; hd < 4; ++hd) {
      float v0 = bf2f(gof0[hd]) + bf2f(gob0[hd]);
      float v1 = (lane < 32) ? (bf2f(gof1[hd]) + bf2f(gob1[hd])) : 0.f;
      float ss = wave_sum(v0 * v0 + v1 * v1);
      float rs = rsqrtf(ss * (1.f / 96.f) + 1e-6f);
      YM[(size_t)row * 1024 + 256 + hd * 96 + lane] = f2bf(v0 * rs * gn0 * siluf_(bf2f(gog0[hd])));
      if (lane < 32)
        YM[(size_t)row * 1024 + 256 + hd * 96 + 64 + lane] = f2bf(v1 * rs * gn1 * siluf_(bf2f(gog1[hd])));
    }
#pragma unroll
    for (int j = 0; j < 6; ++j) {
      int idx = j * 64 + lane;
      float y = bf2f(wyf[j]) + bf2f(wyb[j]);
      float r = bf2f(wr[j]), k = bf2f(wk[j]), v = bf2f(wv[j]);
      float af = bf2f(waf[j]), ab = bf2f(wab[j]);
      float mean = wave_sum(y) * (1.f / 64.f);
      float dlt = y - mean;
      float var = wave_sum(dlt * dlt) * (1.f / 64.f);
      float bon = wave_sum(r * k * rkc[j] * (2.f + (af + ab - 2.f) * kac[j]));
      float yn = dlt * rsqrtf(var + 64e-5f) * lwc[j] + lbc[j];
      yn += bon * v;
      YM[(size_t)row * 1024 + 640 + idx] = f2bf(yn * bf2f(wg[j]));
    }
  }
}

constexpr int NPHASES = 2 + 12 * 4;

DEV void run_phase(PTag p, int ph, int rep) {
  float* mod = (float*)(KWS + OFF_MOD);
  char* ws = KWS;
  u16* XN = (u16*)(ws + OFF_XN);
  u16* Yb = (u16*)(ws + OFF_Y);
  u16* U = (u16*)(ws + OFF_AR);
  if (ph == 0) {
    phase_adaln(p);
    __syncthreads();
    conv_ffn(p, 0, 0);
    return;
  }
  if (ph == 1) {
    phase_rows(p, 1, 0, nullptr, nullptr, 0.f, 1, KP(norm_pre) + 0, mod + 0 * 1024, mod + 1 * 1024, NT);
    return;
  }
  int q = ph - 2, l = q / 12, k = q % 12;
  const float* modl = mod + (size_t)l * 9 * 9216;
  const bool last = (l == 3);
  const int Mlate = last ? NLAT : NT;
  switch (k) {
    case 0:
      gemm_phase<1024, EPI_UP>(XN, (const u16*)(ws + OFF_WB + WB_W13T), NT, 5632, U, nullptr);
      break;
    case 1:
      gemm_phase<2816, EPI_Y>(U, (const u16*)(ws + OFF_WB + WB_W2T), NT, 1024, Yb, nullptr);
      break;
    case 2:
      phase_rows(p, 0, 1, KP(norm_post) + (size_t)(l * 3 + 0) * 1024, modl + 2 * 1024, 0.5f, 1,
                 KP(norm_pre) + (size_t)(l * 3 + 1) * 1024, modl + 3 * 1024, modl + 4 * 1024, NT);
      conv_mixer(p, l);
      break;
    case 3:
      gemm_phase<1024, EPI_Z>(XN, (const u16*)(ws + OFF_WB + WB_WINT), NT, PINP, (u16*)(ws + OFF_AR + AR_Z1),
                              (u16*)(ws + OFF_AR + AR_Z2));
      break;
    case 4:
      phase_prep(p, l);
      break;
    case 5:
      phase_scan(p, l, rep == 0 ? 0 : SCAN_PROBE_MODE);
      break;
    case 6:
      phase_post(p, l);
      break;
    case 7:
      gemm_phase<1024, EPI_Y>(XN, (const u16*)(ws + OFF_WB + WB_WOUTT), Mlate, 1024, Yb, nullptr);
      break;
    case 8:
      phase_rows(p, 0, 1, KP(norm_post) + (size_t)(l * 3 + 1) * 1024, modl + 5 * 1024, 1.0f, 1,
                 KP(norm_pre) + (size_t)(l * 3 + 2) * 1024, modl + 6 * 1024, modl + 7 * 1024, Mlate);
      conv_ffn(p, l, 1);
      break;
    case 9:
      gemm_phase<1024, EPI_UP>(XN, (const u16*)(ws + OFF_WB + WB_W13T), Mlate, 5632, U, nullptr);
      break;
    case 10:
      gemm_phase<2816, EPI_Y>(U, (const u16*)(ws + OFF_WB + WB_W2T), Mlate, 1024, Yb, nullptr);
      break;
    case 11:
      if (!last) {
        const float* modn = mod + (size_t)(l + 1) * 9 * 9216;
        phase_rows(p, 0, 1, KP(norm_post) + (size_t)(l * 3 + 2) * 1024, modl + 8 * 1024, 0.5f, 1,
                   KP(norm_pre) + (size_t)((l + 1) * 3 + 0) * 1024, modn + 0 * 1024, modn + 1 * 1024, NT);
        conv_ffn(p, l + 1, 0);
      } else {
        phase_rows(p, 0, 1, KP(norm_post) + (size_t)(l * 3 + 2) * 1024, modl + 8 * 1024, 0.5f, 0, nullptr, nullptr,
                   nullptr, NLAT);
      }
      break;
  }
}

#ifndef REP_SCAN
#define REP_SCAN 1
#endif
#ifndef REP_GEMM
#define REP_GEMM 1
#endif
#ifndef REP_PREP
#define REP_PREP 1
#endif
#ifndef REP_POST
#define REP_POST 1
#endif
DEV int phase_reps(int ph) {
  if (ph < 2) return 1;
  int k = (ph - 2) % 12;
  if (k == 5) return REP_SCAN;
  if (k == 4) return REP_PREP;
  if (k == 6) return REP_POST;
  if (k == 0 || k == 1 || k == 3 || k == 7 || k == 9 || k == 10) return REP_GEMM;
  return 1;
}
__global__ void __launch_bounds__(NTHREADS, 2) mega_kernel(Params params_, int ph_lo, int ph_hi) {
  PTag p;
  cg::grid_group grid = cg::this_grid();
  for (int ph = ph_lo; ph < ph_hi; ++ph) {
    const int reps = phase_reps(ph);
    for (int r = 0; r < reps; ++r) {
      if (ph > ph_lo || r > 0) grid.sync();
      run_phase(p, ph, r);
    }
  }
}

extern "C" void kernel_launch(void* const* d_in, const int* in_sizes, int n_in, void* d_out, int out_size, void* d_ws,
                              size_t ws_size, hipStream_t stream) {
  static int grid_blocks = 0;
  if (!grid_blocks) {
    int dev = 0, cus = 0, per_cu = 0;
    hipGetDevice(&dev);
    hipDeviceGetAttribute(&cus, hipDeviceAttributeMultiprocessorCount, dev);
    hipFuncSetAttribute((const void*)mega_kernel, hipFuncAttributeMaxDynamicSharedMemorySize, (int)SMEM_BYTES);
    hipOccupancyMaxActiveBlocksPerMultiprocessor(&per_cu, mega_kernel, NTHREADS, SMEM_BYTES);
    if (per_cu < 1) per_cu = 1;
    grid_blocks = cus * per_cu;
    if (ws_size < WS_TOTAL) fprintf(stderr, "workspace too small: %zu < %zu\n", ws_size, (size_t)WS_TOTAL);
  }
  Params p{};
  const float** pp = (const float**)&p;
  for (int i = 0; i < 34; ++i) pp[i] = (const float*)d_in[i];
  p.out = (float*)d_out;
  p.ws = (char*)d_ws;
#ifdef MULTI_LAUNCH
  for (int ph = 0; ph < NPHASES; ++ph) {
    hipLaunchKernelGGL(mega_kernel, dim3(grid_blocks), dim3(NTHREADS), SMEM_BYTES, stream, p, ph, ph + 1);
  }
#else
  int lo = 0, hi = NPHASES;
  void* args[] = {&p, &lo, &hi};
  hipError_t e = hipLaunchCooperativeKernel((const void*)mega_kernel, dim3(grid_blocks), dim3(NTHREADS), args,
                                            SMEM_BYTES, stream);
  if (e != hipSuccess) fprintf(stderr, "cooperative launch failed: %s (grid %d)\n", hipGetErrorString(e), grid_blocks);
#endif
}
```

```cpp
#include <hip/hip_runtime.h>
#include <hip/hip_cooperative_groups.h>
#include <cstdio>
namespace cg = cooperative_groups;
#define SCAN_PROBE_MODE 0

typedef unsigned short u16;
using bf16x8 = __attribute__((ext_vector_type(8))) short;
using f32x4 = __attribute__((ext_vector_type(4))) float;

#define DEV __device__ __forceinline__

constexpr int NLAT = 32768, NCTXR = 2048, NT = 34816;
constexpr int DM = 1024, DFF = 2816, PIN = 3232, PINP = 3328;
constexpr int Z1W = 1696, Z2W = 1536;
constexpr int NTHREADS = 512;
constexpr size_t SMEM_BYTES = 131072;

constexpr size_t OFF_MOD = 0;
constexpr size_t SZ_MOD = 4ull * 9 * 9216 * 4;
constexpr size_t OFF_HC = OFF_MOD + SZ_MOD;
constexpr size_t SZ_HC = 2048ull * 1024 * 4;
constexpr size_t OFF_INVN = OFF_HC + SZ_HC;
constexpr size_t SZ_INVN = (size_t)NT * 8 * 4;
constexpr size_t OFF_WB = OFF_INVN + SZ_INVN;
constexpr size_t SZ_WB = 5632ull * 1024 * 2 + 1024ull * 2816 * 2;
constexpr size_t OFF_XN = OFF_WB + SZ_WB;
constexpr size_t SZ_XN = (size_t)NT * 1024 * 2;
constexpr size_t OFF_Y = OFF_XN + SZ_XN;
constexpr size_t SZ_Y = SZ_XN;
constexpr size_t OFF_AR = OFF_Y + SZ_Y;
constexpr size_t SZ_384 = (size_t)NT * 384 * 2;
constexpr size_t SZ_256 = (size_t)NT * 256 * 2;
constexpr size_t SZ_192 = (size_t)NT * 192 * 2;
constexpr size_t AR_Z1 = 0;
constexpr size_t AR_Z2 = AR_Z1 + (size_t)NT * Z1W * 2;
constexpr size_t AR_RWP = AR_Z2 + (size_t)NT * Z2W * 2;
constexpr size_t AR_LA = AR_RWP + 7 * SZ_384;
constexpr size_t SZ_AR = AR_LA + 2 * SZ_192;
constexpr size_t AR_PART = 201326592;
constexpr size_t OFF_BAR = OFF_AR + SZ_AR;
constexpr size_t WS_TOTAL = OFF_BAR + 256;
constexpr size_t WB_W13T = 0;
constexpr size_t WB_W2T = 5632ull * 1024 * 2;
constexpr size_t WB_WINT = 0;
constexpr size_t WB_WOUTT = WB_WINT + 3328ull * 1024 * 2;
constexpr size_t WB_RWW2T = WB_WOUTT + 1024ull * 1024 * 2;
constexpr size_t WB_RWA2T = WB_RWW2T + 2ull * 384 * 64 * 2;
constexpr size_t WB_RWG2T = WB_RWA2T + 2ull * 384 * 64 * 2;
constexpr size_t WB_RGGT = WB_RWG2T + 384ull * 128 * 2;
constexpr size_t WB_GLAT = WB_RGGT + 16ull * 64 * 64 * 2;

struct Params {
  const float *x, *c, *ctx, *c_ctx, *w_mod, *b_mod, *norm_pre, *norm_post, *ffn_w1, *ffn_w3, *ffn_w2, *w_in, *w_out,
      *rg_conv_w, *rg_conv_b, *rg_gate_a_w, *rg_gate_a_b, *rg_gate_x_w, *rg_gate_x_b, *rg_lambda,
      *gla_alpha_w2, *gla_alpha_b, *gla_norm, *rw_mu, *rw_w0, *rw_w2, *rw_a0, *rw_a2, *rw_g2, *rw_k_k, *rw_k_a,
      *rw_r_k, *rw_ln_w, *rw_ln_b;
  float* out;
  char* ws;
};

extern __shared__ __attribute__((aligned(16))) char g_smem[];

DEV const float* kparg(int off) {
  const char __attribute__((address_space(4)))* kp =
      (const char __attribute__((address_space(4)))*)__builtin_amdgcn_kernarg_segment_ptr();
  return *(const float* volatile const __attribute__((address_space(4)))*)(kp + off);
}
#define KP(name) kparg((int)__builtin_offsetof(Params, name))
#define KWS ((char*)kparg((int)__builtin_offsetof(Params, ws)))
#define KOUT ((float*)kparg((int)__builtin_offsetof(Params, out)))
struct PTag {};

DEV int my_tid() {
  int t = threadIdx.x;
  asm volatile("" : "+v"(t));
  return t;
}
DEV int my_bid() {
  int b = blockIdx.x;
  asm volatile("" : "+s"(b));
  return b;
}
DEV float bf2f(u16 u) { return __uint_as_float(((unsigned)u) << 16); }
typedef float v2f_ __attribute__((ext_vector_type(2)));
typedef __bf16 v2bf_ __attribute__((ext_vector_type(2)));
DEV unsigned pack2(float a, float b) {
  v2f_ f = {a, b};
  v2bf_ h = __builtin_convertvector(f, v2bf_);
  return __builtin_bit_cast(unsigned, h);
}
DEV u16 f2bf(float f) { return (u16)(pack2(f, 0.f) & 0xffffu); }
DEV float lo2f(unsigned u) { return __uint_as_float(u << 16); }
DEV float hi2f(unsigned u) { return __uint_as_float(u & 0xffff0000u); }
DEV float wave_sum(float v);
DEV float sigmoidf_(float x) { return __builtin_amdgcn_rcpf(1.f + __expf(-x)); }
DEV float siluf_(float x) { return x * __builtin_amdgcn_rcpf(1.f + __expf(-x)); }
DEV float tanhf_(float x) { return 1.f - 2.f * __builtin_amdgcn_rcpf(1.f + __expf(2.f * x)); }
DEV float log_sigmoidf_(float x) { return fminf(x, 0.f) - __logf(1.f + __expf(-fabsf(x))); }
template <int CTRL>
DEV float dpp_f(float x) {
  return __int_as_float(__builtin_amdgcn_update_dpp(0, __float_as_int(x), CTRL, 0xf, 0xf, true));
}
DEV float quad_sum(float x) {
  x += dpp_f<0xB1>(x);
  x += dpp_f<0x4E>(x);
  return x;
}
DEV float oct_sum(float x) {
  x = quad_sum(x);
  x += dpp_f<0x141>(x);
  return x;
}
DEV float wave_sum(float x) {
  x = quad_sum(x);
  x += dpp_f<0x141>(x);
  x += dpp_f<0x140>(x);
  float r0 = __int_as_float(__builtin_amdgcn_readlane(__float_as_int(x), 0));
  float r1 = __int_as_float(__builtin_amdgcn_readlane(__float_as_int(x), 16));
  float r2 = __int_as_float(__builtin_amdgcn_readlane(__float_as_int(x), 32));
  float r3 = __int_as_float(__builtin_amdgcn_readlane(__float_as_int(x), 48));
  return (r0 + r1) + (r2 + r3);
}
DEV int seq_row(int b, int dir, int s) {
  if (s < 256) {
    int t = dir ? 255 - s : s;
    return NLAT + b * 256 + t;
  }
  int t = s - 256;
  t = dir ? 4095 - t : t;
  return b * 4096 + t;
}

DEV void phase_adaln(PTag p) {
  const int ltid = my_tid();
  const int lbid = my_bid();
  (void)ltid; (void)lbid;
  float* sc = (float*)g_smem;
  float* red = sc + 9 * 1024;
  float* mod = (float*)(KWS + OFF_MOD);
  const int tid = ltid;
  for (int i = tid; i < 9 * 1024; i += NTHREADS) {
    int m = i >> 10, k = i & 1023;
    float v = (m < 8) ? KP(c)[m * 1024 + k] : KP(c_ctx)[k];
    sc[i] = siluf_(v);
  }
  __syncthreads();
  for (int job = lbid; job < 256; job += gridDim.x) {
    int l = job >> 6, j0 = (job & 63) * 144;
    const float* W = KP(w_mod) + (size_t)l * 1024 * 9216;
    int cgp = tid % 36, ig = tid / 36;
    if (tid < 504) {
      float acc[9][4];
#pragma unroll
      for (int m = 0; m < 9; ++m)
#pragma unroll
        for (int q = 0; q < 4; ++q) acc[m][q] = 0.f;
#pragma unroll 4
      for (int i = ig; i < 1024; i += 14) {
        const f32x4 wv_ = __builtin_nontemporal_load((const f32x4*)(W + (size_t)i * 9216 + j0 + cgp * 4));
        float4 w4 = make_float4(wv_[0], wv_[1], wv_[2], wv_[3]);
#pragma unroll
        for (int m = 0; m < 9; ++m) {
          float s = sc[m * 1024 + i];
          acc[m][0] += s * w4.x;
          acc[m][1] += s * w4.y;
          acc[m][2] += s * w4.z;
          acc[m][3] += s * w4.w;
        }
      }
#pragma unroll
      for (int m = 0; m < 9; ++m)
#pragma unroll
        for (int q = 0; q < 4; ++q) red[(ig * 9 + m) * 144 + cgp * 4 + q] = acc[m][q];
    }
    __syncthreads();
    for (int o = tid; o < 9 * 144; o += NTHREADS) {
      int m = o / 144, cc = o % 144;
      float s = KP(b_mod)[l * 9216 + j0 + cc];
#pragma unroll
      for (int g = 0; g < 14; ++g) s += red[(g * 9 + m) * 144 + cc];
      mod[(size_t)(l * 9 + m) * 9216 + j0 + cc] = s;
    }
    __syncthreads();
  }
}

DEV void conv_job(const float* srcA, const float* srcB, int interleave, int ld, int Kvalid, int Nvalid, u16* dst,
                  int Kdst, int Ndst, int& tb) {
  const int ltid = my_tid();
  const int lbid = my_bid();
  (void)ltid; (void)lbid;
  float* tile = (float*)g_smem;
  const int tid = ltid;
  int tk = (Kdst + 63) / 64, nt = (Ndst / 64) * tk;
  int G = gridDim.x;
  int start = (((int)lbid - (tb % G)) % G + G) % G;
  for (int t = start; t < nt; t += G) {
    int nn0 = (t / tk) * 64, k0 = (t % tk) * 64;
    int nl = tid & 63, nn = nn0 + nl;
    const float* src;
    int col;
    bool nv;
    if (interleave) {
      int g = nn >> 5, w = nn & 31;
      col = g * 16 + (w & 15);
      src = (w < 16) ? srcA : srcB;
      nv = true;
    } else {
      col = nn;
      src = srcA;
      nv = nn < Nvalid;
    }
#pragma unroll
    for (int pass = 0; pass < 8; ++pass) {
      int kk = pass * 8 + (tid >> 6);
      int k = k0 + kk;
      float v = (nv && k < Kvalid) ? __builtin_nontemporal_load(src + (size_t)k * ld + col) : 0.f;
      tile[nl * 65 + kk] = v;
    }
    __syncthreads();
    {
      int nl2 = tid >> 3, kc = tid & 7;
      int k = k0 + kc * 8;
      if (k < Kdst) {
        const float* tp = tile + nl2 * 65 + kc * 8;
        uint4 o;
        o.x = pack2(tp[0], tp[1]);
        o.y = pack2(tp[2], tp[3]);
        o.z = pack2(tp[4], tp[5]);
        o.w = pack2(tp[6], tp[7]);
        *(uint4*)(dst + (size_t)(nn0 + nl2) * Kdst + k) = o;
      }
    }
    __syncthreads();
  }
  tb += nt;
}

DEV void conv_ffn(PTag p, int l, int f) {
  int tb = 0;
  u16* wb = (u16*)(KWS + OFF_WB);
  size_t o13 = ((size_t)(l * 2 + f)) * 1024 * 2816;
  conv_job(KP(ffn_w1) + o13, KP(ffn_w3) + o13, 1, 2816, 1024, 5632, (u16*)((char*)wb + WB_W13T), 1024, 5632, tb);
  conv_job(KP(ffn_w2) + o13, nullptr, 0, 1024, 2816, 1024, (u16*)((char*)wb + WB_W2T), 2816, 1024, tb);
}
DEV void conv_mixer(PTag p, int l) {
  int tb = 0;
  char* wb = KWS + OFF_WB;
  conv_job(KP(w_in) + (size_t)l * 1024 * PIN, nullptr, 0, PIN, 1024, PIN, (u16*)(wb + WB_WINT), 1024, PINP, tb);
  conv_job(KP(w_out) + (size_t)l * 1024 * 1024, nullptr, 0, 1024, 1024, 1024, (u16*)(wb + WB_WOUTT), 1024, 1024, tb);
  for (int d = 0; d < 2; ++d) {
    conv_job(KP(rw_w2) + (size_t)(l * 2 + d) * 64 * 384, nullptr, 0, 384, 64, 384, (u16*)(wb + WB_RWW2T) + d * 384 * 64, 64,
             384, tb);
    conv_job(KP(rw_a2) + (size_t)(l * 2 + d) * 64 * 384, nullptr, 0, 384, 64, 384, (u16*)(wb + WB_RWA2T) + d * 384 * 64, 64,
             384, tb);
    conv_job(KP(gla_alpha_w2) + (size_t)(l * 2 + d) * 16 * 192, nullptr, 0, 192, 16, 192, (u16*)(wb + WB_GLAT) + d * 192 * 32,
             32, 192, tb);
    for (int h = 0; h < 4; ++h) {
      conv_job(KP(rg_gate_a_w) + (size_t)((l * 2 + d) * 4 + h) * 4096, nullptr, 0, 64, 64, 64,
               (u16*)(wb + WB_RGGT) + ((d * 2 + 0) * 4 + h) * 4096, 64, 64, tb);
      conv_job(KP(rg_gate_x_w) + (size_t)((l * 2 + d) * 4 + h) * 4096, nullptr, 0, 64, 64, 64,
               (u16*)(wb + WB_RGGT) + ((d * 2 + 1) * 4 + h) * 4096, 64, 64, tb);
    }
  }
  conv_job(KP(rw_g2) + (size_t)l * 128 * 384, nullptr, 0, 384, 128, 384, (u16*)(wb + WB_RWG2T), 128, 384, tb);
}

template <bool SPLITY, int NR>
DEV void phase_rows_t(PTag p, int init, int has_y, const float* gpost, const float* mod_gate, float coef,
                      int has_next, const float* gpre, const float* mod_shift, const float* mod_scale, int rbeg,
                      int rend) {
  const int ltid = my_tid();
  const int lbid = my_bid();
  const int lane = ltid & 63;
  const int gw = lbid * 8 + (ltid >> 6), nw = gridDim.x * 8;
  float* hc = (float*)(KWS + OFF_HC);
  const u16* Y = (const u16*)(KWS + OFF_Y);
  u16* XN = (u16*)(KWS + OFF_XN);
  float* outp = KOUT;
  const float* xin = KP(x);
  const float* cin = KP(ctx);
  float4 gpo[4], gpr[4];
#pragma unroll
  for (int i = 0; i < 4; ++i) {
    gpo[i] = has_y ? ((const float4*)gpost)[lane + 64 * i] : make_float4(0.f, 0.f, 0.f, 0.f);
    gpr[i] = has_next ? ((const float4*)gpre)[lane + 64 * i] : make_float4(0.f, 0.f, 0.f, 0.f);
  }
  for (int row0 = rbeg + gw; row0 < rend; row0 += NR * nw) {
    float4 h[NR][4], g[NR][4], sh[NR][4], sc[NR][4], y[NR][4];
    uint2 yr[NR][4];
    bool valid[NR];
    float* hp[NR];
    int rows[NR];
#pragma unroll
    for (int r = 0; r < NR; ++r) {
      int row = row0 + r * nw;
      valid[r] = row < rend;
      if (!valid[r]) row = row0;
      rows[r] = row;
      int m = row < NLAT ? (row >> 12) : 8;
      hp[r] = row < NLAT ? outp + (size_t)row * 1024 : hc + (size_t)(row - NLAT) * 1024;
      const float* src = hp[r];
      if (init) src = row < NLAT ? xin + (size_t)row * 1024 : cin + (size_t)(row - NLAT) * 1024;
#pragma unroll
      for (int i = 0; i < 4; ++i) {
        const f32x4 hv = __builtin_nontemporal_load((const f32x4*)src + lane + 64 * i);
        h[r][i] = make_float4(hv[0], hv[1], hv[2], hv[3]);
      }
      if (has_y) {
        if (SPLITY) {
          const float4* pr = (const float4*)((const float*)(KWS + OFF_AR + AR_PART) + (size_t)(row - NLAT) * 1024);
#pragma unroll
          for (int i = 0; i < 4; ++i) {
            float4 a = pr[lane + 64 * i], b = pr[(size_t)NCTXR * 256 + lane + 64 * i];
            float4 c = pr[(size_t)2 * NCTXR * 256 + lane + 64 * i], d = pr[(size_t)3 * NCTXR * 256 + lane + 64 * i];
            y[r][i].x = (a.x + b.x) + (c.x + d.x); y[r][i].y = (a.y + b.y) + (c.y + d.y);
            y[r][i].z = (a.z + b.z) + (c.z + d.z); y[r][i].w = (a.w + b.w) + (c.w + d.w);
          }
        } else {
#pragma unroll
          for (int i = 0; i < 4; ++i) yr[r][i] = ((const uint2*)(Y + (size_t)row * 1024))[lane + 64 * i];
        }
#pragma unroll
        for (int i = 0; i < 4; ++i) g[r][i] = ((const float4*)(mod_gate + (size_t)m * 9216))[lane + 64 * i];
      }
      if (has_next) {
#pragma unroll
        for (int i = 0; i < 4; ++i) {
          sh[r][i] = ((const float4*)(mod_shift + (size_t)m * 9216))[lane + 64 * i];
          sc[r][i] = ((const float4*)(mod_scale + (size_t)m * 9216))[lane + 64 * i];
        }
      }
    }
#pragma unroll
    for (int r = 0; r < NR; ++r) {
      if (has_y) {
        float ss = 0.f;
#pragma unroll
        for (int i = 0; i < 4; ++i) {
          if (!SPLITY) {
            uint2 u = yr[r][i];
            y[r][i].x = lo2f(u.x); y[r][i].y = hi2f(u.x); y[r][i].z = lo2f(u.y); y[r][i].w = hi2f(u.y);
          }
          ss += y[r][i].x * y[r][i].x + y[r][i].y * y[r][i].y + y[r][i].z * y[r][i].z + y[r][i].w * y[r][i].w;
        }
        ss = wave_sum(ss);
        float rs = rsqrtf(ss * (1.f / 1024.f) + 1e-6f) * coef;
#pragma unroll
        for (int i = 0; i < 4; ++i) {
          h[r][i].x += g[r][i].x * (y[r][i].x * rs * gpo[i].x);
          h[r][i].y += g[r][i].y * (y[r][i].y * rs * gpo[i].y);
          h[r][i].z += g[r][i].z * (y[r][i].z * rs * gpo[i].z);
          h[r][i].w += g[r][i].w * (y[r][i].w * rs * gpo[i].w);
        }
      }
    }
#pragma unroll
    for (int r = 0; r < NR; ++r) {
      if ((init || has_y) && valid[r]) {
#pragma unroll
        for (int i = 0; i < 4; ++i)
          __builtin_nontemporal_store(f32x4{h[r][i].x, h[r][i].y, h[r][i].z, h[r][i].w}, (f32x4*)hp[r] + lane + 64 * i);
      }
      if (has_next) {
        float ss = 0.f;
#pragma unroll
        for (int i = 0; i < 4; ++i)
          ss += h[r][i].x * h[r][i].x + h[r][i].y * h[r][i].y + h[r][i].z * h[r][i].z + h[r][i].w * h[r][i].w;
        ss = wave_sum(ss);
        float rs = rsqrtf(ss * (1.f / 1024.f) + 1e-6f);
        if (valid[r]) {
#pragma unroll
          for (int i = 0; i < 4; ++i) {
            float a = (h[r][i].x * rs * gpr[i].x) * (1.f + sc[r][i].x) + sh[r][i].x;
            float b = (h[r][i].y * rs * gpr[i].y) * (1.f + sc[r][i].y) + sh[r][i].y;
            float c = (h[r][i].z * rs * gpr[i].z) * (1.f + sc[r][i].z) + sh[r][i].z;
            float d = (h[r][i].w * rs * gpr[i].w) * (1.f + sc[r][i].w) + sh[r][i].w;
            uint2 o;
            o.x = pack2(a, b);
            o.y = pack2(c, d);
            ((uint2*)(XN + (size_t)rows[r] * 1024))[lane + 64 * i] = o;
          }
        }
      }
    }
  }
}
DEV void phase_rows(PTag p, int init, int has_y, const float* gpost, const float* mod_gate, float coef,
                    int has_next, const float* gpre, const float* mod_shift, const float* mod_scale, int Mrows,
                    int ysplit = 0) {
  if (ysplit && Mrows > NLAT) {
    phase_rows_t<false, 2>(p, init, has_y, gpost, mod_gate, coef, has_next, gpre, mod_shift, mod_scale, 0, NLAT);
    phase_rows_t<true, 1>(p, init, has_y, gpost, mod_gate, coef, has_next, gpre, mod_shift, mod_scale, NLAT, Mrows);
  } else {
    phase_rows_t<false, 2>(p, init, has_y, gpost, mod_gate, coef, has_next, gpre, mod_shift, mod_scale, 0, Mrows);
  }
}

constexpr int BM = 256, BK = 64, HALF = 128, HT = HALF * BK;
DEV int lds_byte(int r, int c) {
  int st = (r >> 4) * 2 + (c >> 5), rr = r & 15, cc = c & 31, ob = rr * 64 + cc * 2;
  return st * 1024 + (ob ^ (((ob >> 9) & 1) << 5));
}
DEV void stage_rc(int b, int& R, int& C) {
  int st = b / 1024, sb = b % 1024, swz = sb ^ (((sb >> 9) & 1) << 5);
  R = (st >> 1) * 16 + swz / 64;
  C = (st & 1) * 32 + (swz % 64) / 2;
}
enum { EPI_UP = 0, EPI_Y = 1, EPI_Z = 2 };

template <int K, int EPI, bool SPLIT = false>
DEV void gemm_phase(const u16* __restrict__ A, const u16* __restrict__ Bt, int M, int N, u16* __restrict__ O0,
                    u16* __restrict__ O1, int nsplit_rowtiles = 0, float* __restrict__ Pp = nullptr) {
  const int ltid = my_tid();
  const int lbid = my_bid();
  (void)ltid; (void)lbid;
  u16* shm = (u16*)g_smem;
#define SA(b, h) (shm + ((b) * 2 + (h)) * HT)
#define SB(b, h) (shm + (4 + (b) * 2 + (h)) * HT)
#define STAGE(P, GB, kc)                                                                                        \
  do {                                                                                                           \
    __builtin_amdgcn_global_load_lds((const unsigned*)((const char*)(GB) + vb0 + (kc) * (BK * 2)),              \
                                     (unsigned*)((char*)(P) + wbase), 16, 0, 0);                                 \
    __builtin_amdgcn_global_load_lds((const unsigned*)((const char*)(GB) + vb1 + (kc) * (BK * 2)),              \
                                     (unsigned*)((char*)(P) + wbase + 8192), 16, 0, 0);                          \
  } while (0)
#define LDA(dst, b, h)                                                                                 \
  for (int m = 0; m < 4; ++m)                                                                          \
    for (int k = 0; k < 2; ++k)                                                                        \
  dst[m][k] = *reinterpret_cast<const bf16x8*>(aBase + (((b) * 2 + (h)) * 16384 + m * 2048 + k * 1024))
#define LDB(dst, b, h)                                                                                 \
  for (int n = 0; n < 2; ++n)                                                                          \
    for (int k = 0; k < 2; ++k)                                                                        \
  dst[n][k] = *reinterpret_cast<const bf16x8*>(bBase + (((b) * 2 + (h)) * 16384 + n * 2048 + k * 1024))
#define MMA(ai, bj, At_, Bt_)                                                                          \
  do {                                                                                                 \
    __builtin_amdgcn_s_setprio(1);                                                                     \
    for (int m = 0; m < 4; ++m)                                                                        \
      for (int n = 0; n < 2; ++n)                                                                      \
        for (int k = 0; k < 2; ++k)                                                                    \
          acc[ai][bj][m][n] =                                                                          \
              __builtin_amdgcn_mfma_f32_16x16x32_bf16(At_[m][k], Bt_[n][k], acc[ai][bj][m][n], 0, 0, 0); \
    __builtin_amdgcn_s_setprio(0);                                                                     \
  } while (0)
#define WAIT_V(n) asm volatile("s_waitcnt vmcnt(" #n ")" ::: "memory")
#define WAIT_L(n) asm volatile("s_waitcnt lgkmcnt(" #n ")" ::: "memory")
#define BAR __builtin_amdgcn_s_barrier()
#define SCHED __builtin_amdgcn_sched_barrier(0)

  const int tid = ltid;
  const int tid16 = tid * 16;
  unsigned off0, off1;
  {
    int r, c;
    stage_rc(tid16, r, c);
    off0 = (unsigned)(r * K + c) * 2u;
    stage_rc(tid16 + 8192, r, c);
    off1 = (unsigned)(r * K + c) * 2u;
  }
  const int wbase = __builtin_amdgcn_readfirstlane(tid >> 6) * 1024;
  const int wid = tid >> 6, lane = tid & 63, wr = wid >> 2, wc = wid & 3, fr = lane & 15, fq = lane >> 4;
  const int nM = M / BM, nN = N / BM, nwg = nM * nN;
  const int lo_ = lds_byte(fr, fq * 8);
  const char* aBase = (const char*)g_smem + wr * 8192 + lo_;
  const char* bBase = (const char*)g_smem + 65536 + wc * 4096 + lo_;
  constexpr int WGM = 8;
  const int nitems = SPLIT ? nsplit_rowtiles * nN * 4 : nwg;
  const int lb2 = SPLIT ? (lbid + 128) % (int)gridDim.x : lbid;
  for (int tix = lb2; tix < nitems; tix += gridDim.x) {
    int brow, bcol, nt, kbeg, schunk;
    if (!SPLIT) {
      int wgid = tix;
      {
        int q = nwg / 8, r = nwg % 8, xcd = wgid % 8, off = wgid / 8;
        wgid = (xcd < r ? xcd * (q + 1) : r * (q + 1) + (xcd - r) * q) + off;
      }
      int nig = WGM * nN, gid = wgid / nig, fm = gid * WGM, gsz = min(nM - fm, WGM);
      int pm = fm + ((wgid % nig) % gsz), pn = (wgid % nig) / gsz;
      brow = pm * BM;
      bcol = pn * BM;
      nt = K / BK;
      kbeg = 0;
      schunk = -1;
    } else {
      schunk = tix & 3;
      int ct = tix >> 2;
      brow = M + (ct / nN) * BM;
      bcol = (ct % nN) * BM;
      constexpr int q4 = ((K / BK) / 8) * 2;
      kbeg = (schunk < 2) ? schunk * q4 : 2 * q4 + (schunk - 2) * ((K / BK - 2 * q4) / 2);
      nt = (schunk < 2) ? q4 : (K / BK - 2 * q4) / 2;
    }
    f32x4 acc[2][2][4][2];
#pragma unroll
    for (int a = 0; a < 2; ++a)
#pragma unroll
      for (int b = 0; b < 2; ++b)
#pragma unroll
        for (int m = 0; m < 4; ++m)
#pragma unroll
          for (int n = 0; n < 2; ++n) acc[a][b][m][n] = f32x4{0.f, 0.f, 0.f, 0.f};
    bf16x8 At[4][2], B0[2][2], B1[2][2];
    const u16* gA0 = A + (size_t)brow * K + kbeg * BK;
    const u16* gA1 = gA0 + (size_t)HALF * K;
    const u16* gB0 = Bt + (size_t)bcol * K + kbeg * BK;
    const u16* gB1 = gB0 + (size_t)HALF * K;
    unsigned vb0 = off0, vb1 = off1;
    STAGE(SB(0, 0), gB0, 0);
    STAGE(SA(0, 0), gA0, 0);
    STAGE(SB(0, 1), gB1, 0);
    STAGE(SA(0, 1), gA1, 0);
    if (wr == 1) BAR;
    WAIT_V(4);
    BAR;
    STAGE(SB(1, 0), gB0, 1);
    STAGE(SA(1, 0), gA0, 1);
    STAGE(SB(1, 1), gB1, 1);
    WAIT_V(6);
    BAR;
#pragma unroll 1
    for (int t = 0; t < nt - 2; t += 2, vb0 += 2 * BK * 2, vb1 += 2 * BK * 2) {
      LDB(B0, 0, 0); SCHED; LDA(At, 0, 0); STAGE(SA(1, 1), gA1, 1);
      WAIT_L(8); BAR; WAIT_L(0); MMA(0, 0, At, B0); BAR; SCHED;
      LDB(B1, 0, 1); STAGE(SB(0, 0), gB0, 2);
      BAR; WAIT_L(0); MMA(0, 1, At, B1); BAR;
      LDA(At, 0, 1); STAGE(SA(0, 0), gA0, 2);
      BAR; WAIT_L(0); MMA(1, 0, At, B0); BAR; SCHED;
      STAGE(SB(0, 1), gB1, 2);
      WAIT_V(6); BAR; MMA(1, 1, At, B1); BAR;
      LDB(B0, 1, 0); SCHED; LDA(At, 1, 0); STAGE(SA(0, 1), gA1, 2);
      WAIT_L(8); BAR; WAIT_L(0); MMA(0, 0, At, B0); BAR; SCHED;
      LDB(B1, 1, 1); STAGE(SB(1, 0), gB0, 3);
      BAR; WAIT_L(0); MMA(0, 1, At, B1); BAR;
      LDA(At, 1, 1); STAGE(SA(1, 0), gA0, 3);
      BAR; WAIT_L(0); MMA(1, 0, At, B0); BAR; SCHED;
      STAGE(SB(1, 1), gB1, 3);
      WAIT_V(6); BAR; MMA(1, 1, At, B1); BAR;
    }
    {
      LDB(B0, 0, 0); LDA(At, 0, 0); STAGE(SA(1, 1), gA1, 1);
      BAR; WAIT_L(0); MMA(0, 0, At, B0); BAR;
      LDB(B1, 0, 1); BAR; WAIT_L(0); MMA(0, 1, At, B1); BAR;
      LDA(At, 0, 1); WAIT_V(4); BAR; WAIT_L(0); MMA(1, 0, At, B0); MMA(1, 1, At, B1); BAR;
    }
    {
      LDB(B0, 1, 0); LDA(At, 1, 0); WAIT_V(2); BAR; WAIT_L(0); MMA(0, 0, At, B0); BAR;
      LDB(B1, 1, 1); WAIT_V(0); BAR; WAIT_L(0); MMA(0, 1, At, B1); BAR;
      LDA(At, 1, 1); BAR; WAIT_L(0); MMA(1, 0, At, B0); MMA(1, 1, At, B1); BAR;
    }
    if (wr == 0) BAR;
#pragma unroll
    for (int ai = 0; ai < 2; ++ai)
#pragma unroll
      for (int bj = 0; bj < 2; ++bj)
#pragma unroll
        for (int m = 0; m < 4; ++m) {
          int rowb = brow + ai * HALF + wr * 64 + m * 16 + fq * 4;
          if (EPI == EPI_UP) {
            int hcol = ((bcol + bj * HALF + wc * 32) >> 1) + fr;
#pragma unroll
            for (int j = 0; j < 4; ++j) {
              float a = acc[ai][bj][m][0][j], b = acc[ai][bj][m][1][j];
              __builtin_nontemporal_store(f2bf(siluf_(a) * b), O0 + (size_t)(rowb + j) * DFF + hcol);
            }
          } else {
#pragma unroll
            for (int n = 0; n < 2; ++n) {
              int col = bcol + bj * HALF + wc * 32 + n * 16 + fr;
#pragma unroll
              for (int j = 0; j < 4; ++j) {
                float v = acc[ai][bj][m][n][j];
                if (EPI == EPI_Y) {
                  if (!SPLIT) O0[(size_t)(rowb + j) * DM + col] = f2bf(v);
                  else Pp[((size_t)schunk * NCTXR + (size_t)(rowb + j - M)) * DM + col] = v;
                } else {
                  if (col < Z1W) O0[(size_t)(rowb + j) * Z1W + col] = f2bf(v);
                  else if (col < PIN) O1[(size_t)(rowb + j) * Z2W + (col - Z1W)] = f2bf(v);
                }
              }
            }
          }
        }
  }
#undef SA
#undef SB
#undef STAGE
#undef LDA
#undef LDB
#undef MMA
}

DEV bf16x8 ld_frag_g(const u16* p) { return *reinterpret_cast<const bf16x8*>(p); }
DEV bf16x8 ld_frag_s(const u16* p) { return *reinterpret_cast<const bf16x8*>(p); }

constexpr int ALD = 392;
constexpr int XLD = 264;
constexpr int GLD = 40;

DEV void phase_prep(PTag p, int l) {
  const int ltid = my_tid();
  const int lbid = my_bid();
  (void)ltid; (void)lbid;
  const int tid = ltid, lane = tid & 63, wid = tid >> 6;
  const int fr = lane & 15, fq = lane >> 4;
  char* ar = KWS + OFF_AR;
  const u16* Z1 = (const u16*)(ar + AR_Z1);
  const u16* Z2 = (const u16*)(ar + AR_Z2);
  u16* RWP = (u16*)(ar + AR_RWP);
  u16* LA = (u16*)(ar + AR_LA);
  float* invn = (float*)(KWS + OFF_INVN);
  u16* Gout = (u16*)(KWS + OFF_Y);
  u16* RGP = (u16*)(KWS + OFF_XN);
  const char* wb = KWS + OFF_WB;
  u16* A_lds = (u16*)g_smem;
  u16* X_lds = (u16*)(g_smem + 50176);
  u16* Gl_lds = (u16*)(g_smem + 50176 + 33792);
  const float* mu = KP(rw_mu) + (size_t)l * 1536;
  const float* k_k = KP(rw_k_k) + (size_t)l * 384;

  for (int tile = lbid; tile < NLAT / 64 + NCTXR / 32; tile += gridDim.x) {
    const int nrows = tile < NLAT / 64 ? 64 : 32;
    const int r0 = tile < NLAT / 64 ? tile * 64 : NLAT + (tile - NLAT / 64) * 32;
    const int nmt = nrows >> 4;
    const bool lat = r0 < NLAT;
    const int tpos0 = lat ? (r0 & 4095) : ((r0 - NLAT) & 255);
    const int seglen = lat ? 4096 : 256;
    for (int it0 = 0; it0 < (nrows * 192) / NTHREADS; it0 += 4) {
      uint4 own[4], n0[4], n1[4], n2[4], n3[4];
#pragma unroll
      for (int b4 = 0; b4 < 4; ++b4) {
        int q = (it0 + b4) * NTHREADS + tid;
        int i = q / 192, cc = q % 192, c0 = cc * 8;
        int row = r0 + i, tpos = tpos0 + i;
        const u16* zr = Z2 + (size_t)row * Z2W + c0;
        uint4 z4 = {0u, 0u, 0u, 0u};
        own[b4] = *(const uint4*)zr;
        n0[b4] = z4; n1[b4] = z4; n2[b4] = z4; n3[b4] = z4;
        if (lat) {
          int gcol = tpos & 63, grow = tpos >> 6;
          if (gcol > 0) n0[b4] = *(const uint4*)(zr - Z2W);
          if (gcol < 63) n1[b4] = *(const uint4*)(zr + Z2W);
          if (grow > 0) n2[b4] = *(const uint4*)(zr - 64 * Z2W);
          if (grow < 63) n3[b4] = *(const uint4*)(zr + 64 * Z2W);
        } else {
          if (tpos > 0) n0[b4] = *(const uint4*)(zr - Z2W);
          if (tpos < 255) n1[b4] = *(const uint4*)(zr + Z2W);
          n2[b4] = n0[b4];
          n3[b4] = n1[b4];
        }
      }
#pragma unroll
      for (int b4 = 0; b4 < 4; ++b4) {
        int q = (it0 + b4) * NTHREADS + tid;
        int i = q / 192, cc = q % 192, c0 = cc * 8;
        int row = r0 + i;
        float4 mu0 = *(const float4*)(mu + c0), mu1 = *(const float4*)(mu + c0 + 4);
        float f[8];
        {
          float o0 = lo2f(own[b4].x), o1 = hi2f(own[b4].x), o2 = lo2f(own[b4].y), o3 = hi2f(own[b4].y);
          float o4 = lo2f(own[b4].z), o5 = hi2f(own[b4].z), o6 = lo2f(own[b4].w), o7 = hi2f(own[b4].w);
          float s0 = lo2f(n0[b4].x), s1 = hi2f(n1[b4].x), s2 = lo2f(n2[b4].y), s3 = hi2f(n3[b4].y);
          float s4 = lo2f(n0[b4].z), s5 = hi2f(n1[b4].z), s6 = lo2f(n2[b4].w), s7 = hi2f(n3[b4].w);
          f[0] = o0 + mu0.x * (s0 - o0);
          f[1] = o1 + mu0.y * (s1 - o1);
          f[2] = o2 + mu0.z * (s2 - o2);
          f[3] = o3 + mu0.w * (s3 - o3);
          f[4] = o4 + mu1.x * (s4 - o4);
          f[5] = o5 + mu1.y * (s5 - o5);
          f[6] = o6 + mu1.z * (s6 - o6);
          f[7] = o7 + mu1.w * (s7 - o7);
        }
        if (c0 < 1152) {
          int arr = c0 / 384, cin = c0 % 384;
          uint4 o;
          o.x = pack2(f[0], f[1]); o.y = pack2(f[2], f[3]); o.z = pack2(f[4], f[5]); o.w = pack2(f[6], f[7]);
          *(uint4*)(RWP + (size_t)arr * NT * 384 + (size_t)row * 384 + cin) = o;
          if (arr == 1) {
            float4 kk0 = *(const float4*)(k_k + cin), kk1 = *(const float4*)(k_k + cin + 4);
            float a0 = f[0] * kk0.x, a1 = f[1] * kk0.y, a2 = f[2] * kk0.z, a3 = f[3] * kk0.w;
            float a4 = f[4] * kk1.x, a5 = f[5] * kk1.y, a6 = f[6] * kk1.z, a7 = f[7] * kk1.w;
            float ss = a0 * a0 + a1 * a1 + a2 * a2 + a3 * a3 + a4 * a4 + a5 * a5 + a6 * a6 + a7 * a7;
            ss = oct_sum(ss);
            if ((lane & 7) == 0) invn[(size_t)row * 8 + (cin >> 6)] = 1.f / fmaxf(sqrtf(ss), 1e-12f);
          }
        } else {
          int cl = c0 - 1152;
          if (cl < 128) {
#pragma unroll
            for (int e = 0; e < 8; ++e) f[e] = tanhf_(f[e]);
          } else if (cl >= 256) {
#pragma unroll
            for (int e = 0; e < 8; ++e) f[e] = sigmoidf_(f[e]);
          }
          uint4 o;
          o.x = pack2(f[0], f[1]); o.y = pack2(f[2], f[3]); o.z = pack2(f[4], f[5]); o.w = pack2(f[6], f[7]);
          *(uint4*)(A_lds + i * ALD + cl) = o;
        }
      }
    }
    {
      const float* cw = KP(rg_conv_w) + (size_t)l * 4 * 256;
      const float* cb = KP(rg_conv_b) + (size_t)l * 256;
      for (int it = 0; it < nrows / 16; ++it) {
        int q = it * NTHREADS + tid;
        int i = q >> 5, c0 = (q & 31) * 8;
        int row = r0 + i, tpos = tpos0 + i;
        float accv[8];
        {
          float4 b0 = *(const float4*)(cb + c0), b1 = *(const float4*)(cb + c0 + 4);
          accv[0] = b0.x; accv[1] = b0.y; accv[2] = b0.z; accv[3] = b0.w;
          accv[4] = b1.x; accv[5] = b1.y; accv[6] = b1.z; accv[7] = b1.w;
        }
#pragma unroll
        for (int j = 0; j < 4; ++j) {
          int tt = tpos + j - 2;
          if (tt >= 0 && tt < seglen) {
            uint4 xv = *(const uint4*)(Z1 + (size_t)(row + j - 2) * Z1W + c0);
            float4 w0 = *(const float4*)(cw + j * 256 + c0), w1 = *(const float4*)(cw + j * 256 + c0 + 4);
            accv[0] += w0.x * lo2f(xv.x); accv[1] += w0.y * hi2f(xv.x);
            accv[2] += w0.z * lo2f(xv.y); accv[3] += w0.w * hi2f(xv.y);
            accv[4] += w1.x * lo2f(xv.z); accv[5] += w1.y * hi2f(xv.z);
            accv[6] += w1.z * lo2f(xv.w); accv[7] += w1.w * hi2f(xv.w);
          }
        }
        uint4 o;
        o.x = pack2(accv[0], accv[1]); o.y = pack2(accv[2], accv[3]);
        o.z = pack2(accv[4], accv[5]); o.w = pack2(accv[6], accv[7]);
        *(uint4*)(X_lds + i * XLD + c0) = o;
      }
      {
        int q = tid;
        int i = q >> 3, d = (q >> 2) & 1, ch = q & 3;
        uint4 o = {0u, 0u, 0u, 0u};
        if (ch < 2 && i < nrows) o = *(const uint4*)(Z1 + (size_t)(r0 + i) * Z1W + 1664 + d * 16 + ch * 8);
        *(uint4*)(Gl_lds + (d * 64 + i) * GLD + ch * 8) = o;
      }
    }
    __syncthreads();
    for (int u = wid; u < 120; u += 8) {
      int g = u / 24, ntile = u % 24, n0 = ntile * 16;
      int n = n0 + fr;
      int nc = n0 + fq * 4;
      f32x4 acc[4];
#pragma unroll
      for (int m = 0; m < 4; ++m) acc[m] = f32x4{0.f, 0.f, 0.f, 0.f};
      if (g < 4) {
        const u16* Bt = (const u16*)(wb + ((g < 2) ? WB_RWW2T : WB_RWA2T)) + (size_t)(g & 1) * 384 * 64;
        bf16x8 b0 = ld_frag_g(Bt + (size_t)n * 64 + fq * 8), b1 = ld_frag_g(Bt + (size_t)n * 64 + 32 + fq * 8);
#pragma unroll
        for (int m = 0; m < 4; ++m) if (m < nmt) {
          const u16* ap = A_lds + (m * 16 + fr) * ALD + g * 64 + fq * 8;
          acc[m] = __builtin_amdgcn_mfma_f32_16x16x32_bf16(b0, ld_frag_s(ap), acc[m], 0, 0, 0);
          acc[m] = __builtin_amdgcn_mfma_f32_16x16x32_bf16(b1, ld_frag_s(ap + 32), acc[m], 0, 0, 0);
        }
      } else {
        const u16* Bt = (const u16*)(wb + WB_RWG2T);
        bf16x8 b[4];
#pragma unroll
        for (int k = 0; k < 4; ++k) b[k] = ld_frag_g(Bt + (size_t)n * 128 + k * 32 + fq * 8);
#pragma unroll
        for (int m = 0; m < 4; ++m) if (m < nmt) {
          const u16* ap = A_lds + (m * 16 + fr) * ALD + 256 + fq * 8;
#pragma unroll
          for (int k = 0; k < 4; ++k)
            acc[m] = __builtin_amdgcn_mfma_f32_16x16x32_bf16(b[k], ld_frag_s(ap + k * 32), acc[m], 0, 0, 0);
        }
      }
      if (g < 2) {
        float4 w0v = *(const float4*)(KP(rw_w0) + (size_t)(l * 2 + g) * 384 + nc);
        u16* dst = RWP + (size_t)(3 + g) * NT * 384;
#pragma unroll
        for (int m = 0; m < 4; ++m) if (m < nmt) {
          int row = r0 + m * 16 + fr;
          uint2 o;
          o.x = pack2(sigmoidf_(w0v.x + acc[m][0]) * 0.60653066f, sigmoidf_(w0v.y + acc[m][1]) * 0.60653066f);
          o.y = pack2(sigmoidf_(w0v.z + acc[m][2]) * 0.60653066f, sigmoidf_(w0v.w + acc[m][3]) * 0.60653066f);
          *(uint2*)(dst + (size_t)row * 384 + nc) = o;
        }
      } else if (g < 4) {
        float4 a0v = *(const float4*)(KP(rw_a0) + (size_t)(l * 2 + (g - 2)) * 384 + nc);
        u16* dst = RWP + (size_t)(5 + (g - 2)) * NT * 384;
#pragma unroll
        for (int m = 0; m < 4; ++m) if (m < nmt) {
          int row = r0 + m * 16 + fr;
          uint2 o;
          o.x = pack2(sigmoidf_(a0v.x + acc[m][0]), sigmoidf_(a0v.y + acc[m][1]));
          o.y = pack2(sigmoidf_(a0v.z + acc[m][2]), sigmoidf_(a0v.w + acc[m][3]));
          *(uint2*)(dst + (size_t)row * 384 + nc) = o;
        }
      } else {
#pragma unroll
        for (int m = 0; m < 4; ++m) if (m < nmt) {
          int row = r0 + m * 16 + fr;
          uint2 o;
          o.x = pack2(acc[m][0], acc[m][1]);
          o.y = pack2(acc[m][2], acc[m][3]);
          *(uint2*)(Gout + (size_t)row * 384 + nc) = o;
        }
      }
    }
    for (int u = wid; u < 32; u += 8) {
      int d = u >> 4, hd = (u >> 2) & 3, ntile = u & 3;
      int nl = ntile * 16 + fr;
      int chc = hd * 64 + ntile * 16 + fq * 4;
      const u16* Ba = (const u16*)(wb + WB_RGGT) + (size_t)((d * 2 + 0) * 4 + hd) * 4096 + nl * 64;
      const u16* Bx = (const u16*)(wb + WB_RGGT) + (size_t)((d * 2 + 1) * 4 + hd) * 4096 + nl * 64;
      bf16x8 ba0 = ld_frag_g(Ba + fq * 8), ba1 = ld_frag_g(Ba + 32 + fq * 8);
      bf16x8 bx0 = ld_frag_g(Bx + fq * 8), bx1 = ld_frag_g(Bx + 32 + fq * 8);
      float4 gab = *(const float4*)(KP(rg_gate_a_b) + (size_t)(l * 2 + d) * 256 + chc);
      float4 gxb = *(const float4*)(KP(rg_gate_x_b) + (size_t)(l * 2 + d) * 256 + chc);
      float4 lam = *(const float4*)(KP(rg_lambda) + (size_t)(l * 2 + d) * 256 + chc);
      float spl[4] = {__logf(1.f + __expf(-lam.x)) * 8.f, __logf(1.f + __expf(-lam.y)) * 8.f,
                      __logf(1.f + __expf(-lam.z)) * 8.f, __logf(1.f + __expf(-lam.w)) * 8.f};
      float gabv[4] = {gab.x, gab.y, gab.z, gab.w}, gxbv[4] = {gxb.x, gxb.y, gxb.z, gxb.w};
      u16* dla = RGP + (size_t)(d * 2 + 0) * NT * 256;
      u16* dbx = RGP + (size_t)(d * 2 + 1) * NT * 256;
#pragma unroll
      for (int m = 0; m < 4; ++m) if (m < nmt) {
        const u16* ap = X_lds + (m * 16 + fr) * XLD + hd * 64 + fq * 8;
        bf16x8 a0 = ld_frag_s(ap), a1 = ld_frag_s(ap + 32);
        f32x4 ca = f32x4{0.f, 0.f, 0.f, 0.f}, cx = ca;
        ca = __builtin_amdgcn_mfma_f32_16x16x32_bf16(ba0, a0, ca, 0, 0, 0);
        ca = __builtin_amdgcn_mfma_f32_16x16x32_bf16(ba1, a1, ca, 0, 0, 0);
        cx = __builtin_amdgcn_mfma_f32_16x16x32_bf16(bx0, a0, cx, 0, 0, 0);
        cx = __builtin_amdgcn_mfma_f32_16x16x32_bf16(bx1, a1, cx, 0, 0, 0);
        int il = m * 16 + fr;
        int row = r0 + il;
        uint2 xcv = *(const uint2*)(X_lds + il * XLD + chc);
        float xc[4] = {lo2f(xcv.x), hi2f(xcv.x), lo2f(xcv.y), hi2f(xcv.y)};
        float la[4], bx[4];
#pragma unroll
        for (int j = 0; j < 4; ++j) {
          float r = sigmoidf_(ca[j] + gabv[j]), ig = sigmoidf_(cx[j] + gxbv[j]);
          float loga = -r * spl[j];
          float mult = __builtin_amdgcn_sqrtf(fmaxf(1.f - __expf(2.f * loga), 0.f));
          la[j] = loga;
          bx[j] = mult * ig * xc[j];
        }
        uint2 o;
        o.x = pack2(la[0], la[1]); o.y = pack2(la[2], la[3]);
        *(uint2*)(dla + (size_t)row * 256 + chc) = o;
        o.x = pack2(bx[0], bx[1]); o.y = pack2(bx[2], bx[3]);
        *(uint2*)(dbx + (size_t)row * 256 + chc) = o;
      }
    }
    for (int u = wid; u < 24; u += 8) {
      int d = u / 12, ntile = u % 12;
      int n = ntile * 16 + fr;
      int nc = ntile * 16 + fq * 4;
      const u16* Bt = (const u16*)(wb + WB_GLAT) + (size_t)d * 192 * 32;
      bf16x8 b0 = ld_frag_g(Bt + (size_t)n * 32 + fq * 8);
      float4 bb = *(const float4*)(KP(gla_alpha_b) + (size_t)(l * 2 + d) * 192 + nc);
      u16* dst = LA + (size_t)d * NT * 192;
#pragma unroll
      for (int m = 0; m < 4; ++m) if (m < nmt) {
        const u16* ap = Gl_lds + (d * 64 + m * 16 + fr) * GLD + fq * 8;
        f32x4 cacc = f32x4{0.f, 0.f, 0.f, 0.f};
        cacc = __builtin_amdgcn_mfma_f32_16x16x32_bf16(b0, ld_frag_s(ap), cacc, 0, 0, 0);
        int row = r0 + m * 16 + fr;
        uint2 o;
        o.x = pack2(log_sigmoidf_(cacc[0] + bb.x) * (1.f / 16.f), log_sigmoidf_(cacc[1] + bb.y) * (1.f / 16.f));
        o.y = pack2(log_sigmoidf_(cacc[2] + bb.z) * (1.f / 16.f), log_sigmoidf_(cacc[3] + bb.w) * (1.f / 16.f));
        *(uint2*)(dst + (size_t)row * 192 + nc) = o;
      }
    }
    __syncthreads();
  }
}

constexpr int TC = 32;
constexpr int NSTEP = 4352;
typedef float v2f __attribute__((ext_vector_type(2)));
DEV v2f pkfma(v2f a, v2f b, v2f c) { return __builtin_elementwise_fma(a, b, c); }
DEV float hex_sum(float x) {
  x = quad_sum(x);
  x += dpp_f<0x141>(x);
  x += dpp_f<0x140>(x);
  return x;
}
#define DPPADD(r, ctrl) "v_add_f32_dpp " r ", " r ", " r " " ctrl " row_mask:0xf bank_mask:0xf bound_ctrl:1\n\t"
DEV void hex_sum2(float& x, float& y) {
  asm volatile("s_nop 1\n\t"
               DPPADD("%0", "quad_perm:[1,0,3,2]") DPPADD("%1", "quad_perm:[1,0,3,2]") "s_nop 0\n\t"
               DPPADD("%0", "quad_perm:[2,3,0,1]") DPPADD("%1", "quad_perm:[2,3,0,1]") "s_nop 0\n\t"
               DPPADD("%0", "row_half_mirror") DPPADD("%1", "row_half_mirror") "s_nop 0\n\t"
               DPPADD("%0", "row_mirror") DPPADD("%1", "row_mirror")
               : "+v"(x), "+v"(y));
}
DEV void hex_sum4(float& a, float& b, float& c, float& d) {
  asm volatile("s_nop 1\n\t"
               DPPADD("%0", "quad_perm:[1,0,3,2]") DPPADD("%1", "quad_perm:[1,0,3,2]")
               DPPADD("%2", "quad_perm:[1,0,3,2]") DPPADD("%3", "quad_perm:[1,0,3,2]")
               DPPADD("%0", "quad_perm:[2,3,0,1]") DPPADD("%1", "quad_perm:[2,3,0,1]")
               DPPADD("%2", "quad_perm:[2,3,0,1]") DPPADD("%3", "quad_perm:[2,3,0,1]")
               DPPADD("%0", "row_half_mirror") DPPADD("%1", "row_half_mirror")
               DPPADD("%2", "row_half_mirror") DPPADD("%3", "row_half_mirror")
               DPPADD("%0", "row_mirror") DPPADD("%1", "row_mirror")
               DPPADD("%2", "row_mirror") DPPADD("%3", "row_mirror")
               : "+v"(a), "+v"(b), "+v"(c), "+v"(d));
}
DEV void oct_sum2(float& x, float& y) {
  asm volatile("s_nop 1\n\t"
               DPPADD("%0", "quad_perm:[1,0,3,2]") DPPADD("%1", "quad_perm:[1,0,3,2]") "s_nop 0\n\t"
               DPPADD("%0", "quad_perm:[2,3,0,1]") DPPADD("%1", "quad_perm:[2,3,0,1]") "s_nop 0\n\t"
               DPPADD("%0", "row_half_mirror") DPPADD("%1", "row_half_mirror")
               : "+v"(x), "+v"(y));
}
DEV void oct_sum3(float& a, float& b, float& c) {
  asm volatile("s_nop 1\n\t"
               DPPADD("%0", "quad_perm:[1,0,3,2]") DPPADD("%1", "quad_perm:[1,0,3,2]") DPPADD("%2", "quad_perm:[1,0,3,2]")
               DPPADD("%0", "quad_perm:[2,3,0,1]") DPPADD("%1", "quad_perm:[2,3,0,1]") DPPADD("%2", "quad_perm:[2,3,0,1]")
               DPPADD("%0", "row_half_mirror") DPPADD("%1", "row_half_mirror") DPPADD("%2", "row_half_mirror")
               : "+v"(a), "+v"(b), "+v"(c));
}

constexpr int RST = 392;
struct RwOps { float4 w, k, a, b, wr; float2 vv; float2 sc; };
struct RwOps8 { float4 w0, w1, k0, k1, a0, a1, b0, b1, r0, r1; float vv; float2 sc; };
DEV void scan_rwkv(PTag p, int l, int task) {
  const int ltid = my_tid();
  const int tid = ltid, lane = tid & 63, w = tid >> 6;
  const int half = task & 1, sc = task >> 1;
  const int b = sc / 12, h = (sc % 12) >> 1, dir = sc & 1;
  char* ar = KWS + OFF_AR;
  const u16* RWP = (const u16*)(ar + AR_RWP);
  const u16* Rg = RWP, *Kg = RWP + (size_t)NT * 384, *Vg = RWP + (size_t)2 * NT * 384;
  const u16* Ug = RWP + (size_t)(3 + dir) * NT * 384, *Ag = RWP + (size_t)(5 + dir) * NT * 384;
  const float* invn = (const float*)(KWS + OFF_INVN);
  u16* Yd = (u16*)(ar + AR_Z2) + (size_t)dir * NT * 384;
  float* buf = (float*)g_smem;
  float* ybuf = buf + 2 * TC * RST;
  const int rl = lane >> 3, kg = lane & 7;
  const int lrow = w * 8 + rl;
  const int lstep = tid >> 4, lq = tid & 15;
  const int ce = h * 64 + lq * 4;
  float4 kkc = *(const float4*)(KP(rw_k_k) + (size_t)l * 384 + ce);
  float4 kac = *(const float4*)(KP(rw_k_a) + (size_t)l * 384 + ce);
  v2f S0 = {0.f, 0.f}, S1 = {0.f, 0.f}, S2 = {0.f, 0.f}, S3 = {0.f, 0.f};

  uint2 gr, gk, gv, gu, ga;
  float gin;
  auto issue = [&](int c) {
    int row = seq_row(b, dir, c * TC + lstep);
    size_t o = (size_t)row * 384 + ce;
    gr = *(const uint2*)(Rg + o);
    gk = *(const uint2*)(Kg + o);
    gv = *(const uint2*)(Vg + o);
    gu = *(const uint2*)(Ug + o);
    ga = *(const uint2*)(Ag + o);
    gin = invn[(size_t)row * 8 + h];
  };
  auto commit = [&](int c, int) {
    float* d = buf + (size_t)((c & 1) * TC + lstep) * RST;
    float r0 = lo2f(gr.x), r1 = hi2f(gr.x), r2 = lo2f(gr.y), r3 = hi2f(gr.y);
    float k0 = lo2f(gk.x), k1 = hi2f(gk.x), k2 = lo2f(gk.y), k3 = hi2f(gk.y);
    float v0 = lo2f(gv.x), v1 = hi2f(gv.x), v2 = lo2f(gv.y), v3 = hi2f(gv.y);
    float u0 = lo2f(gu.x), u1 = hi2f(gu.x), u2 = lo2f(gu.y), u3 = hi2f(gu.y);
    float a0 = lo2f(ga.x), a1 = hi2f(ga.x), a2 = lo2f(ga.y), a3 = hi2f(ga.y);
    float w0 = __expf(-u0), w1 = __expf(-u1), w2 = __expf(-u2), w3 = __expf(-u3);
    float d0 = k0 * (1.f + (a0 - 1.f) * kac.x), d1 = k1 * (1.f + (a1 - 1.f) * kac.y);
    float d2 = k2 * (1.f + (a2 - 1.f) * kac.z), d3 = k3 * (1.f + (a3 - 1.f) * kac.w);
    float q0 = k0 * kkc.x * gin, q1 = k1 * kkc.y * gin, q2 = k2 * kkc.z * gin, q3 = k3 * kkc.w * gin;
    float b0 = q0 * a0, b1 = q1 * a1, b2 = q2 * a2, b3 = q3 * a3;
    *(float4*)(d + lq * 4) = make_float4(w0, w1, w2, w3);
    *(float4*)(d + 64 + lq * 4) = make_float4(d0, d1, d2, d3);
    *(float4*)(d + 128 + lq * 4) = make_float4(-q0, -q1, -q2, -q3);
    *(float4*)(d + 192 + lq * 4) = make_float4(b0, b1, b2, b3);
    *(float4*)(d + 256 + lq * 4) = make_float4(w0 * r0, w1 * r1, w2 * r2, w3 * r3);
    *(float4*)(d + 320 + lq * 4) = make_float4(v0, v1, v2, v3);
    float br = b0 * r0 + b1 * r1 + b2 * r2 + b3 * r3;
    float kr = d0 * r0 + d1 * r1 + d2 * r2 + d3 * r3;
    hex_sum2(br, kr);
    if (lq == 0) *(float2*)(d + 384) = make_float2(br, kr);
  };
  issue(0);
  commit(0, 0);
  __syncthreads();
  constexpr int NCH = NSTEP / TC;
#pragma unroll 1
  for (int c = 0; c < NCH; ++c) {
    const int cn = (c + 1 < NCH) ? c + 1 : c;
    issue(cn);
    const float* cb = buf + (size_t)(c & 1) * TC * RST;
    float* yb = ybuf + (c & 1) * TC * 32;
    if (w < 4) {
      auto ld = [&](int s) {
        RwOps8 o;
        const float* sb = cb + s * RST + kg * 8;
        o.w0 = *(const float4*)(sb);        o.w1 = *(const float4*)(sb + 4);
        o.k0 = *(const float4*)(sb + 64);   o.k1 = *(const float4*)(sb + 68);
        o.a0 = *(const float4*)(sb + 128);  o.a1 = *(const float4*)(sb + 132);
        o.b0 = *(const float4*)(sb + 192);  o.b1 = *(const float4*)(sb + 196);
        o.r0 = *(const float4*)(sb + 256);  o.r1 = *(const float4*)(sb + 260);
        o.vv = cb[s * RST + 320 + half * 32 + lrow];
        o.sc = *(const float2*)(cb + s * RST + 384);
        return o;
      };
      RwOps8 cur = ld(0);
#pragma unroll 8
      for (int s = 0; s < TC; ++s) {
        RwOps8 nxt = ld((s + 1) & (TC - 1));
        v2f t1 = S0 * v2f{cur.a0.x, cur.a0.y}, t2 = S0 * v2f{cur.r0.x, cur.r0.y};
        t1 = pkfma(S1, v2f{cur.a0.z, cur.a0.w}, t1);
        t2 = pkfma(S1, v2f{cur.r0.z, cur.r0.w}, t2);
        t1 = pkfma(S2, v2f{cur.a1.x, cur.a1.y}, t1);
        t2 = pkfma(S2, v2f{cur.r1.x, cur.r1.y}, t2);
        t1 = pkfma(S3, v2f{cur.a1.z, cur.a1.w}, t1);
        t2 = pkfma(S3, v2f{cur.r1.z, cur.r1.w}, t2);
        float sa = t1.x + t1.y, yy = t2.x + t2.y;
        oct_sum2(sa, yy);
        v2f sa2 = {sa, sa}, va2 = {cur.vv, cur.vv};
        S0 = pkfma(S0, v2f{cur.w0.x, cur.w0.y}, pkfma(sa2, v2f{cur.b0.x, cur.b0.y}, va2 * v2f{cur.k0.x, cur.k0.y}));
        S1 = pkfma(S1, v2f{cur.w0.z, cur.w0.w}, pkfma(sa2, v2f{cur.b0.z, cur.b0.w}, va2 * v2f{cur.k0.z, cur.k0.w}));
        S2 = pkfma(S2, v2f{cur.w1.x, cur.w1.y}, pkfma(sa2, v2f{cur.b1.x, cur.b1.y}, va2 * v2f{cur.k1.x, cur.k1.y}));
        S3 = pkfma(S3, v2f{cur.w1.z, cur.w1.w}, pkfma(sa2, v2f{cur.b1.z, cur.b1.w}, va2 * v2f{cur.k1.z, cur.k1.w}));
        yy = fmaf(sa, cur.sc.x, fmaf(cur.vv, cur.sc.y, yy));
        yb[s * 32 + lrow] = yy;
        cur = nxt;
      }
    }
    commit(c + 1, cn);
    __syncthreads();
    if (lq < 8) {
      int row = seq_row(b, dir, c * TC + lstep);
      float4 yv = *(const float4*)(yb + lstep * 32 + lq * 4);
      uint2 o;
      o.x = pack2(yv.x, yv.y);
      o.y = pack2(yv.z, yv.w);
      *(uint2*)(Yd + (size_t)row * 384 + h * 64 + half * 32 + lq * 4) = o;
    }
  }
  __syncthreads();
}

constexpr int GST = 288;
struct GlOps { float4 a03, k03, q03; float2 a45, k45, q45; float v0, v1, v2; };
DEV void scan_gla_rg(PTag p, int l, int task) {
  const int ltid = my_tid();
  const int tid = ltid, lane = tid & 63, w = tid >> 6;
  const int b = task >> 3, hd = (task >> 1) & 3, dir = task & 1;
  char* ar = KWS + OFF_AR;
  const u16* Z1 = (const u16*)(ar + AR_Z1);
  const u16* LAg = (const u16*)(ar + AR_LA) + (size_t)dir * NT * 192;
  u16* Od = (u16*)(ar + AR_Z2) + (size_t)(2 + dir) * NT * 384;
  const u16* RGP = (const u16*)(KWS + OFF_XN);
  const u16* RLA = RGP + (size_t)(dir * 2 + 0) * NT * 256;
  const u16* RBX = RGP + (size_t)(dir * 2 + 1) * NT * 256;
  u16* Hd = (u16*)(KWS + OFF_Y) + (size_t)NT * 384 + (size_t)dir * NT * 256;
  float* buf = (float*)g_smem;
  float* obuf = buf + 2 * TC * GST;
  unsigned* rgbuf = (unsigned*)(obuf + 2 * TC * 128);
  u16* hbuf = (u16*)(rgbuf + 2 * TC * 64);
  const int el = lane >> 3, dg = lane & 7;
  const int c0 = w * 24 + el;
  const int lstep = tid >> 4, lq = tid & 15;
  v2f S[3][3];
#pragma unroll
  for (int c = 0; c < 3; ++c)
#pragma unroll
    for (int j = 0; j < 3; ++j) S[c][j] = v2f{0.f, 0.f};
  float hst = 0.f;
  uint2 gq, gk, gl_, gv0, gv1, rla, rbx;
  auto issue = [&](int c) {
    int row = seq_row(b, dir, c * TC + lstep);
    const u16* zr = Z1 + (size_t)row * Z1W;
    uint2 z = {0u, 0u};
    gq = z; gk = z; gl_ = z; gv1 = z;
    if (lq < 12) {
      gq = *(const uint2*)(zr + 512 + hd * 48 + lq * 4);
      gk = *(const uint2*)(zr + 704 + hd * 48 + lq * 4);
      gl_ = *(const uint2*)(LAg + (size_t)row * 192 + hd * 48 + lq * 4);
    }
    gv0 = *(const uint2*)(zr + 896 + hd * 96 + lq * 4);
    if (lq < 8) gv1 = *(const uint2*)(zr + 896 + hd * 96 + 64 + lq * 4);
    rla = *(const uint2*)(RLA + (size_t)row * 256 + hd * 64 + lq * 4);
    rbx = *(const uint2*)(RBX + (size_t)row * 256 + hd * 64 + lq * 4);
  };
  auto commit = [&](int c, int) {
    float* d = buf + (size_t)((c & 1) * TC + lstep) * GST;
    const float qs = 0.14433756729740643f;
    if (lq < 12) {
      float av[4] = {__expf(lo2f(gl_.x)), __expf(hi2f(gl_.x)), __expf(lo2f(gl_.y)), __expf(hi2f(gl_.y))};
      float kv[4] = {lo2f(gk.x), hi2f(gk.x), lo2f(gk.y), hi2f(gk.y)};
      float qv[4] = {lo2f(gq.x) * qs, hi2f(gq.x) * qs, lo2f(gq.y) * qs, hi2f(gq.y) * qs};
#pragma unroll
      for (int e = 0; e < 4; ++e) {
        int dd = lq * 4 + e;
        int pos = (dd / 6) * 20 + (dd % 6);
        d[pos] = av[e];
        d[6 + pos] = kv[e];
        d[12 + pos] = qv[e];
      }
    }
    {
      float vv0[4] = {lo2f(gv0.x), hi2f(gv0.x), lo2f(gv0.y), hi2f(gv0.y)};
      float vv1[4] = {lo2f(gv1.x), hi2f(gv1.x), lo2f(gv1.y), hi2f(gv1.y)};
#pragma unroll
      for (int e = 0; e < 4; ++e) {
        int c = lq * 4 + e, r = c % 24;
        d[160 + (c / 24) * 32 + (r % 8) * 4 + (r / 8)] = vv0[e];
        if (lq < 8) {
          int c2 = 64 + lq * 4 + e, r2 = c2 % 24;
          d[160 + (c2 / 24) * 32 + (r2 % 8) * 4 + (r2 / 8)] = vv1[e];
        }
      }
    }
    unsigned* rd = rgbuf + (size_t)((c & 1) * TC + lstep) * 64 + lq * 4;
    uint4 ro;
    ro.x = (rla.x & 0xffffu) | (rbx.x << 16);
    ro.y = (rla.x >> 16) | (rbx.x & 0xffff0000u);
    ro.z = (rla.y & 0xffffu) | (rbx.y << 16);
    ro.w = (rla.y >> 16) | (rbx.y & 0xffff0000u);
    *(uint4*)rd = ro;
  };
  issue(0);
  commit(0, 0);
  __syncthreads();
  constexpr int NCH = NSTEP / TC;
#pragma unroll 1
  for (int c = 0; c < NCH; ++c) {
    const int cn = (c + 1 < NCH) ? c + 1 : c;
    issue(cn);
    const float* cb = buf + (size_t)(c & 1) * TC * GST;
    float* ob = obuf + (c & 1) * TC * 128;
    if (w < 4) {
      auto ld = [&](int s) {
        GlOps o;
        const float* sb = cb + s * GST + dg * 20;
        float4 r0 = *(const float4*)(sb), r1 = *(const float4*)(sb + 4), r2 = *(const float4*)(sb + 8);
        float4 r3 = *(const float4*)(sb + 12);
        float2 r4 = *(const float2*)(sb + 16);
        o.a03 = r0;
        o.a45 = make_float2(r1.x, r1.y);
        o.k03 = make_float4(r1.z, r1.w, r2.x, r2.y);
        o.k45 = make_float2(r2.z, r2.w);
        o.q03 = r3;
        o.q45 = r4;
        float4 vq = *(const float4*)(cb + s * GST + 160 + w * 32 + el * 4);
        o.v0 = vq.x; o.v1 = vq.y; o.v2 = vq.z;
        return o;
      };
      GlOps cur = ld(0);
#pragma unroll 8
      for (int s = 0; s < TC; ++s) {
        GlOps nxt = ld((s + 1) & (TC - 1));
        v2f al[3] = {v2f{cur.a03.x, cur.a03.y}, v2f{cur.a03.z, cur.a03.w}, v2f{cur.a45.x, cur.a45.y}};
        v2f kk[3] = {v2f{cur.k03.x, cur.k03.y}, v2f{cur.k03.z, cur.k03.w}, v2f{cur.k45.x, cur.k45.y}};
        v2f qq[3] = {v2f{cur.q03.x, cur.q03.y}, v2f{cur.q03.z, cur.q03.w}, v2f{cur.q45.x, cur.q45.y}};
        v2f vv[3] = {v2f{cur.v0, cur.v0}, v2f{cur.v1, cur.v1}, v2f{cur.v2, cur.v2}};
        float r[3];
#pragma unroll
        for (int ci = 0; ci < 3; ++ci) {
#pragma unroll
          for (int j = 0; j < 3; ++j) S[ci][j] = pkfma(al[j], S[ci][j], kk[j] * vv[ci]);
          v2f o = qq[0] * S[ci][0];
          o = pkfma(qq[1], S[ci][1], o);
          o = pkfma(qq[2], S[ci][2], o);
          r[ci] = o.x + o.y;
        }
        oct_sum3(r[0], r[1], r[2]);
        typedef float v3f __attribute__((ext_vector_type(3)));
        *(v3f*)(ob + s * 128 + w * 32 + el * 4) = v3f{r[0], r[1], r[2]};
        cur = nxt;
      }
    } else if (w == 4) {
      const unsigned* rb = rgbuf + (size_t)(c & 1) * TC * 64 + lane;
      u16* hb = hbuf + (size_t)(c & 1) * TC * 64 + lane;
      unsigned uu[TC];
#pragma unroll
      for (int s = 0; s < TC; ++s) uu[s] = rb[s * 64];
#pragma unroll
      for (int s = 0; s < TC; ++s) {
        float a = __expf(lo2f(uu[s]));
        hst = fmaf(a, hst, hi2f(uu[s]));
        hb[s * 64] = f2bf(hst);
      }
    }
    commit(c + 1, cn);
    __syncthreads();
    {
      int row = seq_row(b, dir, c * TC + lstep);
      u16* orow = Od + (size_t)row * 384 + hd * 96;
      const float* orow_l = ob + lstep * 128;
      float x0[4], x1[4];
#pragma unroll
      for (int e = 0; e < 4; ++e) {
        int c = lq * 4 + e, r = c % 24;
        x0[e] = orow_l[(c / 24) * 32 + (r % 8) * 4 + (r / 8)];
        int c2 = 64 + (lq & 7) * 4 + e, r2 = c2 % 24;
        x1[e] = orow_l[(c2 / 24) * 32 + (r2 % 8) * 4 + (r2 / 8)];
      }
      uint2 o;
      o.x = pack2(x0[0], x0[1]); o.y = pack2(x0[2], x0[3]);
      *(uint2*)(orow + lq * 4) = o;
      if (lq < 8) {
        o.x = pack2(x1[0], x1[1]); o.y = pack2(x1[2], x1[3]);
        *(uint2*)(orow + 64 + lq * 4) = o;
      }
      uint2 hv = *(const uint2*)(hbuf + (size_t)((c & 1) * TC + lstep) * 64 + lq * 4);
      *(uint2*)(Hd + (size_t)row * 256 + hd * 64 + lq * 4) = hv;
    }
  }
  __syncthreads();
}

DEV void phase_scan(PTag p, int l, int mode) {
  const int lbid = my_bid();
  for (int task = lbid; task < 256; task += gridDim.x) {
    if (task < 192) { if (mode != 2) scan_rwkv(p, l, task); }
    else { if (mode != 1) scan_gla_rg(p, l, task - 192); }
  }
}

DEV float gelu_tanh(float x) {
  float u = 0.7978845608028654f * (x + 0.044715f * x * x * x);
  return 0.5f * x * (1.f + tanhf_(u));
}
DEV void phase_post(PTag p, int l) {
  const int ltid = my_tid();
  const int lbid = my_bid();
  const int lane = ltid & 63;
  const int gw = lbid * 8 + (ltid >> 6), nw = gridDim.x * 8;
  char* ar = KWS + OFF_AR;
  const u16* Z1 = (const u16*)(ar + AR_Z1);
  const u16* RWP = (const u16*)(ar + AR_RWP);
  const u16* RWY = (const u16*)(ar + AR_Z2);
  const u16* Gg = (const u16*)(KWS + OFF_Y);
  const u16* RGH = Gg + (size_t)NT * 384;
  u16* YM = (u16*)(KWS + OFF_XN);
  const float* gnorm = KP(gla_norm) + (size_t)l * 96;
  const float* r_k = KP(rw_r_k) + (size_t)l * 384;
  const float* k_a = KP(rw_k_a) + (size_t)l * 384;
  const float* ln_w = KP(rw_ln_w) + (size_t)l * 384;
  const float* ln_b = KP(rw_ln_b) + (size_t)l * 384;
  float gn0 = gnorm[lane], gn1 = (lane < 32) ? gnorm[64 + lane] : 0.f;
  float rkc[6], kac[6], lwc[6], lbc[6];
#pragma unroll
  for (int j = 0; j < 6; ++j) {
    rkc[j] = r_k[j * 64 + lane]; kac[j] = k_a[j * 64 + lane];
    lwc[j] = ln_w[j * 64 + lane]; lbc[j] = ln_b[j * 64 + lane];
  }
  const int l32 = lane < 32 ? lane : 0;
  for (int row = gw; row < NT; row += nw) {
    uint2 hf = *(const uint2*)(RGH + (size_t)row * 256 + lane * 4);
    uint2 hb = *(const uint2*)(RGH + (size_t)NT * 256 + (size_t)row * 256 + lane * 4);
    uint2 gb = *(const uint2*)(Z1 + (size_t)row * Z1W + 256 + lane * 4);
    const u16* of = RWY + (size_t)2 * NT * 384 + (size_t)row * 384;
    const u16* ob = RWY + (size_t)3 * NT * 384 + (size_t)row * 384;
    const u16* og = Z1 + (size_t)row * Z1W + 1280;
    u16 gof0[4], gob0[4], gog0[4], gof1[4], gob1[4], gog1[4];
#pragma unroll
    for (int hd = 0; hd < 4; ++hd) {
      gof0[hd] = of[hd * 96 + lane]; gob0[hd] = ob[hd * 96 + lane]; gog0[hd] = og[hd * 96 + lane];
      gof1[hd] = of[hd * 96 + 64 + l32]; gob1[hd] = ob[hd * 96 + 64 + l32]; gog1[hd] = og[hd * 96 + 64 + l32];
    }
    size_t ro = (size_t)row * 384;
    u16 wyf[6], wyb[6], wr[6], wk[6], wv[6], waf[6], wab[6], wg[6];
#pragma unroll
    for (int j = 0; j < 6; ++j) {
      int idx = j * 64 + lane;
      wyf[j] = RWY[ro + idx]; wyb[j] = RWY[(size_t)NT * 384 + ro + idx];
      wr[j] = RWP[ro + idx]; wk[j] = RWP[(size_t)NT * 384 + ro + idx]; wv[j] = RWP[(size_t)2 * NT * 384 + ro + idx];
      waf[j] = RWP[(size_t)5 * NT * 384 + ro + idx]; wab[j] = RWP[(size_t)6 * NT * 384 + ro + idx];
      wg[j] = Gg[ro + idx];
    }
    {
      float y0 = (lo2f(hf.x) + lo2f(hb.x)) * gelu_tanh(lo2f(gb.x));
      float y1 = (hi2f(hf.x) + hi2f(hb.x)) * gelu_tanh(hi2f(gb.x));
      float y2 = (lo2f(hf.y) + lo2f(hb.y)) * gelu_tanh(lo2f(gb.y));
      float y3 = (hi2f(hf.y) + hi2f(hb.y)) * gelu_tanh(hi2f(gb.y));
      uint2 o;
      o.x = pack2(y0, y1); o.y = pack2(y2, y3);
      *(uint2*)(YM + (size_t)row * 1024 + lane * 4) = o;
    }
#pragma unroll
    for (int hd = 0; hd < 4; ++hd) {
      float v0 = bf2f(gof0[hd]) + bf2f(gob0[hd]);
      float v1 = (lane < 32) ? (bf2f(gof1[hd]) + bf2f(gob1[hd])) : 0.f;
      float ss = wave_sum(v0 * v0 + v1 * v1);
      float rs = rsqrtf(ss * (1.f / 96.f) + 1e-6f);
      YM[(size_t)row * 1024 + 256 + hd * 96 + lane] = f2bf(v0 * rs * gn0 * siluf_(bf2f(gog0[hd])));
      if (lane < 32)
        YM[(size_t)row * 1024 + 256 + hd * 96 + 64 + lane] = f2bf(v1 * rs * gn1 * siluf_(bf2f(gog1[hd])));
    }
#pragma unroll
    for (int j = 0; j < 6; ++j) {
      int idx = j * 64 + lane;
      float y = bf2f(wyf[j]) + bf2f(wyb[j]);
      float r = bf2f(wr[j]), k = bf2f(wk[j]), v = bf2f(wv[j]);
      float af = bf2f(waf[j]), ab = bf2f(wab[j]);
      float mean = wave_sum(y) * (1.f / 64.f);
      float dlt = y - mean;
      float var = wave_sum(dlt * dlt) * (1.f / 64.f);
      float bon = wave_sum(r * k * rkc[j] * (2.f + (af + ab - 2.f) * kac[j]));
      float yn = dlt * rsqrtf(var + 64e-5f) * lwc[j] + lbc[j];
      yn += bon * v;
      YM[(size_t)row * 1024 + 640 + idx] = f2bf(yn * bf2f(wg[j]));
    }
  }
}

constexpr int NPHASES = 2 + 12 * 4;

DEV void run_phase(PTag p, int ph, int rep) {
  float* mod = (float*)(KWS + OFF_MOD);
  char* ws = KWS;
  u16* XN = (u16*)(ws + OFF_XN);
  u16* Yb = (u16*)(ws + OFF_Y);
  u16* U = (u16*)(ws + OFF_AR);
  if (ph == 0) {
    phase_adaln(p);
    __syncthreads();
    conv_ffn(p, 0, 0);
    return;
  }
  if (ph == 1) {
    phase_rows(p, 1, 0, nullptr, nullptr, 0.f, 1, KP(norm_pre) + 0, mod + 0 * 1024, mod + 1 * 1024, NT);
    return;
  }
  int q = ph - 2, l = q / 12, k = q % 12;
  const float* modl = mod + (size_t)l * 9 * 9216;
  const bool last = (l == 3);
  const int Mlate = last ? NLAT : NT;
  switch (k) {
    case 0:
      gemm_phase<1024, EPI_UP>(XN, (const u16*)(ws + OFF_WB + WB_W13T), NT, 5632, U, nullptr);
      break;
    case 1:
      gemm_phase<2816, EPI_Y>(U, (const u16*)(ws + OFF_WB + WB_W2T), NLAT, 1024, Yb, nullptr);
      gemm_phase<2816, EPI_Y, true>(U, (const u16*)(ws + OFF_WB + WB_W2T), NLAT, 1024, Yb, nullptr, NCTXR / BM,
                                    (float*)(ws + OFF_AR + AR_PART));
      break;
    case 2:
      phase_rows(p, 0, 1, KP(norm_post) + (size_t)(l * 3 + 0) * 1024, modl + 2 * 1024, 0.5f, 1,
                 KP(norm_pre) + (size_t)(l * 3 + 1) * 1024, modl + 3 * 1024, modl + 4 * 1024, NT, 1);
      conv_mixer(p, l);
      break;
    case 3:
      gemm_phase<1024, EPI_Z>(XN, (const u16*)(ws + OFF_WB + WB_WINT), NT, PINP, (u16*)(ws + OFF_AR + AR_Z1),
                              (u16*)(ws + OFF_AR + AR_Z2));
      break;
    case 4:
      phase_prep(p, l);
      break;
    case 5:
      phase_scan(p, l, rep == 0 ? 0 : SCAN_PROBE_MODE);
      break;
    case 6:
      phase_post(p, l);
      break;
    case 7:
      gemm_phase<1024, EPI_Y>(XN, (const u16*)(ws + OFF_WB + WB_WOUTT), NLAT, 1024, Yb, nullptr);
      if (!last)
        gemm_phase<1024, EPI_Y, true>(XN, (const u16*)(ws + OFF_WB + WB_WOUTT), NLAT, 1024, Yb, nullptr, NCTXR / BM,
                                      (float*)(ws + OFF_AR + AR_PART));
      break;
    case 8:
      phase_rows(p, 0, 1, KP(norm_post) + (size_t)(l * 3 + 1) * 1024, modl + 5 * 1024, 1.0f, 1,
                 KP(norm_pre) + (size_t)(l * 3 + 2) * 1024, modl + 6 * 1024, modl + 7 * 1024, Mlate, 1);
      conv_ffn(p, l, 1);
      break;
    case 9:
      gemm_phase<1024, EPI_UP>(XN, (const u16*)(ws + OFF_WB + WB_W13T), Mlate, 5632, U, nullptr);
      break;
    case 10:
      gemm_phase<2816, EPI_Y>(U, (const u16*)(ws + OFF_WB + WB_W2T), NLAT, 1024, Yb, nullptr);
      if (!last)
        gemm_phase<2816, EPI_Y, true>(U, (const u16*)(ws + OFF_WB + WB_W2T), NLAT, 1024, Yb, nullptr, NCTXR / BM,
                                      (float*)(ws + OFF_AR + AR_PART));
      break;
    case 11:
      if (!last) {
        const float* modn = mod + (size_t)(l + 1) * 9 * 9216;
        phase_rows(p, 0, 1, KP(norm_post) + (size_t)(l * 3 + 2) * 1024, modl + 8 * 1024, 0.5f, 1,
                   KP(norm_pre) + (size_t)((l + 1) * 3 + 0) * 1024, modn + 0 * 1024, modn + 1 * 1024, NT, 1);
        conv_ffn(p, l + 1, 0);
      } else {
        phase_rows(p, 0, 1, KP(norm_post) + (size_t)(l * 3 + 2) * 1024, modl + 8 * 1024, 0.5f, 0, nullptr, nullptr,
                   nullptr, NLAT);
      }
      break;
  }
}

#ifndef REP_SCAN
#define REP_SCAN 1
#endif
#ifndef REP_GEMM
#define REP_GEMM 1
#endif
#ifndef REP_PREP
#define REP_PREP 1
#endif
#ifndef REP_POST
#define REP_POST 1
#endif
DEV int phase_reps(int ph) {
  if (ph < 2) return 1;
  int k = (ph - 2) % 12;
  if (k == 5) return REP_SCAN;
  if (k == 4) return REP_PREP;
  if (k == 6) return REP_POST;
  if (k == 0 || k == 1 || k == 3 || k == 7 || k == 9 || k == 10) return REP_GEMM;
  return 1;
}
DEV void grid_barrier(unsigned* ctr, unsigned target) {
  asm volatile("s_waitcnt vmcnt(0)" ::: "memory");
  __syncthreads();
  if (threadIdx.x == 0) {
    __builtin_amdgcn_fence(__ATOMIC_RELEASE, "agent");
    asm volatile("s_waitcnt vmcnt(0)" ::: "memory");
    __hip_atomic_fetch_add(ctr, 1u, __ATOMIC_RELAXED, __HIP_MEMORY_SCOPE_AGENT);
    while (__hip_atomic_load(ctr, __ATOMIC_RELAXED, __HIP_MEMORY_SCOPE_AGENT) < target) __builtin_amdgcn_s_sleep(1);
    __builtin_amdgcn_fence(__ATOMIC_ACQUIRE, "agent");
    asm volatile("s_waitcnt vmcnt(0)" ::: "memory");
  }
  __syncthreads();
}

__global__ void __launch_bounds__(NTHREADS, 2) mega_kernel(Params params_, int ph_lo, int ph_hi) {
  PTag p;
  cg::grid_group grid = cg::this_grid();
  unsigned* bar = (unsigned*)(KWS + OFF_BAR);
  if (blockIdx.x == 0 && threadIdx.x == 0) __hip_atomic_store(bar, 0u, __ATOMIC_RELAXED, __HIP_MEMORY_SCOPE_AGENT);
  unsigned nsync = 0;
  for (int ph = ph_lo; ph < ph_hi; ++ph) {
    const int reps = phase_reps(ph);
    for (int r = 0; r < reps; ++r) {
      if (ph > ph_lo || r > 0) {
        if (nsync == 0) grid.sync();
        else grid_barrier(bar, nsync * gridDim.x);
        ++nsync;
      }
      run_phase(p, ph, r);
    }
  }
}

extern "C" void kernel_launch(void* const* d_in, const int* in_sizes, int n_in, void* d_out, int out_size, void* d_ws,
                              size_t ws_size, hipStream_t stream) {
  static int grid_blocks = 0;
  if (!grid_blocks) {
    int dev = 0, cus = 0, per_cu = 0;
    hipGetDevice(&dev);
    hipDeviceGetAttribute(&cus, hipDeviceAttributeMultiprocessorCount, dev);
    hipFuncSetAttribute((const void*)mega_kernel, hipFuncAttributeMaxDynamicSharedMemorySize, (int)SMEM_BYTES);
    hipOccupancyMaxActiveBlocksPerMultiprocessor(&per_cu, mega_kernel, NTHREADS, SMEM_BYTES);
    if (per_cu < 1) per_cu = 1;
    grid_blocks = cus * per_cu;
    if (ws_size < WS_TOTAL) fprintf(stderr, "workspace too small: %zu < %zu\n", ws_size, (size_t)WS_TOTAL);
  }
  Params p{};
  const float** pp = (const float**)&p;
  for (int i = 0; i < 34; ++i) pp[i] = (const float*)d_in[i];
  p.out = (float*)d_out;
  p.ws = (char*)d_ws;
#ifdef MULTI_LAUNCH
  for (int ph = 0; ph < NPHASES; ++ph) {
    hipLaunchKernelGGL(mega_kernel, dim3(grid_blocks), dim3(NTHREADS), SMEM_BYTES, stream, p, ph, ph + 1);
  }
#else
  int lo = 0, hi = NPHASES;
  void* args[] = {&p, &lo, &hi};
  hipError_t e = hipLaunchCooperativeKernel((const void*)mega_kernel, dim3(grid_blocks), dim3(NTHREADS), args,
                                            SMEM_BYTES, stream);
  if (e != hipSuccess) fprintf(stderr, "cooperative launch failed: %s (grid %d)\n", hipGetErrorString(e), grid_blocks);
#endif
}
```

```cpp
#include <hip/hip_runtime.h>
#include <hip/hip_cooperative_groups.h>
#include <cstdio>
namespace cg = cooperative_groups;
#define SCAN_PROBE_MODE 0

typedef unsigned short u16;
using bf16x8 = __attribute__((ext_vector_type(8))) short;
using f32x4 = __attribute__((ext_vector_type(4))) float;

#define DEV __device__ __forceinline__

constexpr int NLAT = 32768, NCTXR = 2048, NT = 34816;
constexpr int DM = 1024, DFF = 2816, PIN = 3232, PINP = 3328;
constexpr int Z1W = 1696, Z2W = 1536;
constexpr int NTHREADS = 512;
constexpr size_t SMEM_BYTES = 131072;

constexpr size_t OFF_MOD = 0;
constexpr size_t SZ_MOD = 4ull * 9 * 9216 * 4;
constexpr size_t OFF_HC = OFF_MOD + SZ_MOD;
constexpr size_t SZ_HC = 2048ull * 1024 * 4;
constexpr size_t OFF_INVN = OFF_HC + SZ_HC;
constexpr size_t SZ_INVN = (size_t)NT * 8 * 4;
constexpr size_t OFF_WB = OFF_INVN + SZ_INVN;
constexpr size_t SZ_WB = 5632ull * 1024 * 2 + 1024ull * 2816 * 2;
constexpr size_t OFF_XN = OFF_WB + SZ_WB;
constexpr size_t SZ_XN = (size_t)NT * 1024 * 2;
constexpr size_t OFF_Y = OFF_XN + SZ_XN;
constexpr size_t SZ_Y = SZ_XN;
constexpr size_t OFF_AR = OFF_Y + SZ_Y;
constexpr size_t SZ_384 = (size_t)NT * 384 * 2;
constexpr size_t SZ_256 = (size_t)NT * 256 * 2;
constexpr size_t SZ_192 = (size_t)NT * 192 * 2;
constexpr size_t AR_Z1 = 0;
constexpr size_t AR_Z2 = AR_Z1 + (size_t)NT * Z1W * 2;
constexpr size_t AR_RWP = AR_Z2 + (size_t)NT * Z2W * 2;
constexpr size_t AR_LA = AR_RWP + 7 * SZ_384;
constexpr size_t SZ_AR = AR_LA + 2 * SZ_192;
constexpr size_t AR_PART = 201326592;
constexpr size_t OFF_BAR = OFF_AR + SZ_AR;
constexpr size_t WS_TOTAL = OFF_BAR + 256;
constexpr size_t WB_W13T = 0;
constexpr size_t WB_W2T = 5632ull * 1024 * 2;
constexpr size_t WB_WINT = 0;
constexpr size_t WB_WOUTT = WB_WINT + 3328ull * 1024 * 2;
constexpr size_t WB_RWW2T = WB_WOUTT + 1024ull * 1024 * 2;
constexpr size_t WB_RWA2T = WB_RWW2T + 2ull * 384 * 64 * 2;
constexpr size_t WB_RWG2T = WB_RWA2T + 2ull * 384 * 64 * 2;
constexpr size_t WB_RGGT = WB_RWG2T + 384ull * 128 * 2;
constexpr size_t WB_GLAT = WB_RGGT + 16ull * 64 * 64 * 2;

struct Params {
  const float *x, *c, *ctx, *c_ctx, *w_mod, *b_mod, *norm_pre, *norm_post, *ffn_w1, *ffn_w3, *ffn_w2, *w_in, *w_out,
      *rg_conv_w, *rg_conv_b, *rg_gate_a_w, *rg_gate_a_b, *rg_gate_x_w, *rg_gate_x_b, *rg_lambda,
      *gla_alpha_w2, *gla_alpha_b, *gla_norm, *rw_mu, *rw_w0, *rw_w2, *rw_a0, *rw_a2, *rw_g2, *rw_k_k, *rw_k_a,
      *rw_r_k, *rw_ln_w, *rw_ln_b;
  float* out;
  char* ws;
};

extern __shared__ __attribute__((aligned(16))) char g_smem[];

DEV const float* kparg(int off) {
  const char __attribute__((address_space(4)))* kp =
      (const char __attribute__((address_space(4)))*)__builtin_amdgcn_kernarg_segment_ptr();
  return *(const float* volatile const __attribute__((address_space(4)))*)(kp + off);
}
#define KP(name) kparg((int)__builtin_offsetof(Params, name))
#define KWS ((char*)kparg((int)__builtin_offsetof(Params, ws)))
#define KOUT ((float*)kparg((int)__builtin_offsetof(Params, out)))
struct PTag {};

DEV int my_tid() {
  int t = threadIdx.x;
  asm volatile("" : "+v"(t));
  return t;
}
DEV int my_bid() {
  int b = blockIdx.x;
  asm volatile("" : "+s"(b));
  return b;
}
DEV float bf2f(u16 u) { return __uint_as_float(((unsigned)u) << 16); }
typedef float v2f_ __attribute__((ext_vector_type(2)));
typedef __bf16 v2bf_ __attribute__((ext_vector_type(2)));
DEV unsigned pack2(float a, float b) {
  v2f_ f = {a, b};
  v2bf_ h = __builtin_convertvector(f, v2bf_);
  return __builtin_bit_cast(unsigned, h);
}
DEV u16 f2bf(float f) { return (u16)(pack2(f, 0.f) & 0xffffu); }
DEV float lo2f(unsigned u) { return __uint_as_float(u << 16); }
DEV float hi2f(unsigned u) { return __uint_as_float(u & 0xffff0000u); }
DEV float wave_sum(float v);
DEV float sigmoidf_(float x) { return __builtin_amdgcn_rcpf(1.f + __expf(-x)); }
DEV float siluf_(float x) { return x * __builtin_amdgcn_rcpf(1.f + __expf(-x)); }
DEV float tanhf_(float x) { return 1.f - 2.f * __builtin_amdgcn_rcpf(1.f + __expf(2.f * x)); }
DEV float log_sigmoidf_(float x) { return fminf(x, 0.f) - __logf(1.f + __expf(-fabsf(x))); }
template <int CTRL>
DEV float dpp_f(float x) {
  return __int_as_float(__builtin_amdgcn_update_dpp(0, __float_as_int(x), CTRL, 0xf, 0xf, true));
}
DEV float quad_sum(float x) {
  x += dpp_f<0xB1>(x);
  x += dpp_f<0x4E>(x);
  return x;
}
DEV float oct_sum(float x) {
  x = quad_sum(x);
  x += dpp_f<0x141>(x);
  return x;
}
DEV float wave_sum(float x) {
  x = quad_sum(x);
  x += dpp_f<0x141>(x);
  x += dpp_f<0x140>(x);
  float r0 = __int_as_float(__builtin_amdgcn_readlane(__float_as_int(x), 0));
  float r1 = __int_as_float(__builtin_amdgcn_readlane(__float_as_int(x), 16));
  float r2 = __int_as_float(__builtin_amdgcn_readlane(__float_as_int(x), 32));
  float r3 = __int_as_float(__builtin_amdgcn_readlane(__float_as_int(x), 48));
  return (r0 + r1) + (r2 + r3);
}
DEV int seq_row(int b, int dir, int s) {
  if (s < 256) {
    int t = dir ? 255 - s : s;
    return NLAT + b * 256 + t;
  }
  int t = s - 256;
  t = dir ? 4095 - t : t;
  return b * 4096 + t;
}

DEV void phase_adaln(PTag p) {
  const int ltid = my_tid();
  const int lbid = my_bid();
  (void)ltid; (void)lbid;
  float* sc = (float*)g_smem;
  float* red = sc + 9 * 1024;
  float* mod = (float*)(KWS + OFF_MOD);
  const int tid = ltid;
  for (int i = tid; i < 9 * 1024; i += NTHREADS) {
    int m = i >> 10, k = i & 1023;
    float v = (m < 8) ? KP(c)[m * 1024 + k] : KP(c_ctx)[k];
    sc[i] = siluf_(v);
  }
  __syncthreads();
  for (int job = lbid; job < 256; job += gridDim.x) {
    int l = job >> 6, j0 = (job & 63) * 144;
    const float* W = KP(w_mod) + (size_t)l * 1024 * 9216;
    int cgp = tid % 36, ig = tid / 36;
    if (tid < 504) {
      float acc[9][4];
#pragma unroll
      for (int m = 0; m < 9; ++m)
#pragma unroll
        for (int q = 0; q < 4; ++q) acc[m][q] = 0.f;
#pragma unroll 4
      for (int i = ig; i < 1024; i += 14) {
        const f32x4 wv_ = __builtin_nontemporal_load((const f32x4*)(W + (size_t)i * 9216 + j0 + cgp * 4));
        float4 w4 = make_float4(wv_[0], wv_[1], wv_[2], wv_[3]);
#pragma unroll
        for (int m = 0; m < 9; ++m) {
          float s = sc[m * 1024 + i];
          acc[m][0] += s * w4.x;
          acc[m][1] += s * w4.y;
          acc[m][2] += s * w4.z;
          acc[m][3] += s * w4.w;
        }
      }
#pragma unroll
      for (int m = 0; m < 9; ++m)
#pragma unroll
        for (int q = 0; q < 4; ++q) red[(ig * 9 + m) * 144 + cgp * 4 + q] = acc[m][q];
    }
    __syncthreads();
    for (int o = tid; o < 9 * 144; o += NTHREADS) {
      int m = o / 144, cc = o % 144;
      float s = KP(b_mod)[l * 9216 + j0 + cc];
#pragma unroll
      for (int g = 0; g < 14; ++g) s += red[(g * 9 + m) * 144 + cc];
      mod[(size_t)(l * 9 + m) * 9216 + j0 + cc] = s;
    }
    __syncthreads();
  }
}

DEV void conv_job(const float* srcA, const float* srcB, int interleave, int ld, int Kvalid, int Nvalid, u16* dst,
                  int Kdst, int Ndst, int& tb) {
  const int ltid = my_tid();
  const int lbid = my_bid();
  float* tile = (float*)g_smem;
  const int tid = ltid;
  int tk = (Kdst + 63) / 64, nt = (Ndst / 64) * tk;
  int G = gridDim.x;
  int start = (((int)lbid - (tb % G)) % G + G) % G;
  tb += nt;
  if (start >= nt) return;
  const int nl = tid & 63;
  auto loadt = [&](int t, float (&v)[8]) __attribute__((always_inline)) {
    int nn0 = (t / tk) * 64, k0 = (t % tk) * 64;
    int nn = nn0 + nl;
    const float* src;
    int col;
    bool nv;
    if (interleave) {
      int g = nn >> 5, w = nn & 31;
      col = g * 16 + (w & 15);
      src = (w < 16) ? srcA : srcB;
      nv = true;
    } else {
      col = nn;
      src = srcA;
      nv = nn < Nvalid;
    }
#pragma unroll
    for (int pass = 0; pass < 8; ++pass) {
      int k = k0 + pass * 8 + (tid >> 6);
      v[pass] = (nv && k < Kvalid) ? __builtin_nontemporal_load(src + (size_t)k * ld + col) : 0.f;
    }
  };
  float cur[8];
  loadt(start, cur);
  for (int t = start; t < nt; t += G) {
    float nxt[8];
    loadt((t + G < nt) ? t + G : t, nxt);
    int nn0 = (t / tk) * 64, k0 = (t % tk) * 64;
#pragma unroll
    for (int pass = 0; pass < 8; ++pass) tile[nl * 65 + pass * 8 + (tid >> 6)] = cur[pass];
    __syncthreads();
    {
      int nl2 = tid >> 3, kc = tid & 7;
      int k = k0 + kc * 8;
      if (k < Kdst) {
        const float* tp = tile + nl2 * 65 + kc * 8;
        uint4 o;
        o.x = pack2(tp[0], tp[1]);
        o.y = pack2(tp[2], tp[3]);
        o.z = pack2(tp[4], tp[5]);
        o.w = pack2(tp[6], tp[7]);
        *(uint4*)(dst + (size_t)(nn0 + nl2) * Kdst + k) = o;
      }
    }
    __syncthreads();
#pragma unroll
    for (int pass = 0; pass < 8; ++pass) cur[pass] = nxt[pass];
  }
}

DEV void conv_ffn(PTag p, int l, int f) {
  int tb = 0;
  u16* wb = (u16*)(KWS + OFF_WB);
  size_t o13 = ((size_t)(l * 2 + f)) * 1024 * 2816;
  conv_job(KP(ffn_w1) + o13, KP(ffn_w3) + o13, 1, 2816, 1024, 5632, (u16*)((char*)wb + WB_W13T), 1024, 5632, tb);
  conv_job(KP(ffn_w2) + o13, nullptr, 0, 1024, 2816, 1024, (u16*)((char*)wb + WB_W2T), 2816, 1024, tb);
}
DEV void conv_mixer(PTag p, int l) {
  int tb = 0;
  char* wb = KWS + OFF_WB;
  conv_job(KP(w_in) + (size_t)l * 1024 * PIN, nullptr, 0, PIN, 1024, PIN, (u16*)(wb + WB_WINT), 1024, PINP, tb);
  conv_job(KP(w_out) + (size_t)l * 1024 * 1024, nullptr, 0, 1024, 1024, 1024, (u16*)(wb + WB_WOUTT), 1024, 1024, tb);
  for (int d = 0; d < 2; ++d) {
    conv_job(KP(rw_w2) + (size_t)(l * 2 + d) * 64 * 384, nullptr, 0, 384, 64, 384, (u16*)(wb + WB_RWW2T) + d * 384 * 64, 64,
             384, tb);
    conv_job(KP(rw_a2) + (size_t)(l * 2 + d) * 64 * 384, nullptr, 0, 384, 64, 384, (u16*)(wb + WB_RWA2T) + d * 384 * 64, 64,
             384, tb);
    conv_job(KP(gla_alpha_w2) + (size_t)(l * 2 + d) * 16 * 192, nullptr, 0, 192, 16, 192, (u16*)(wb + WB_GLAT) + d * 192 * 32,
             32, 192, tb);
    for (int h = 0; h < 4; ++h) {
      conv_job(KP(rg_gate_a_w) + (size_t)((l * 2 + d) * 4 + h) * 4096, nullptr, 0, 64, 64, 64,
               (u16*)(wb + WB_RGGT) + ((d * 2 + 0) * 4 + h) * 4096, 64, 64, tb);
      conv_job(KP(rg_gate_x_w) + (size_t)((l * 2 + d) * 4 + h) * 4096, nullptr, 0, 64, 64, 64,
               (u16*)(wb + WB_RGGT) + ((d * 2 + 1) * 4 + h) * 4096, 64, 64, tb);
    }
  }
  conv_job(KP(rw_g2) + (size_t)l * 128 * 384, nullptr, 0, 384, 128, 384, (u16*)(wb + WB_RWG2T), 128, 384, tb);
}

template <bool SPLITY, int NR>
DEV void phase_rows_t(PTag p, int init, int has_y, const float* gpost, const float* mod_gate, float coef,
                      int has_next, const float* gpre, const float* mod_shift, const float* mod_scale, int rbeg,
                      int rend) {
  const int ltid = my_tid();
  const int lbid = my_bid();
  const int lane = ltid & 63;
  const int gw = lbid * 8 + (ltid >> 6), nw = gridDim.x * 8;
  float* hc = (float*)(KWS + OFF_HC);
  const u16* Y = (const u16*)(KWS + OFF_Y);
  u16* XN = (u16*)(KWS + OFF_XN);
  float* outp = KOUT;
  const float* xin = KP(x);
  const float* cin = KP(ctx);
  float4 gpo[4], gpr[4];
#pragma unroll
  for (int i = 0; i < 4; ++i) {
    gpo[i] = has_y ? ((const float4*)gpost)[lane + 64 * i] : make_float4(0.f, 0.f, 0.f, 0.f);
    gpr[i] = has_next ? ((const float4*)gpre)[lane + 64 * i] : make_float4(0.f, 0.f, 0.f, 0.f);
  }
  for (int row0 = rbeg + gw; row0 < rend; row0 += NR * nw) {
    float4 h[NR][4], g[NR][4], sh[NR][4], sc[NR][4], y[NR][4];
    uint2 yr[NR][4];
    bool valid[NR];
    float* hp[NR];
    int rows[NR];
#pragma unroll
    for (int r = 0; r < NR; ++r) {
      int row = row0 + r * nw;
      valid[r] = row < rend;
      if (!valid[r]) row = row0;
      rows[r] = row;
      int m = row < NLAT ? (row >> 12) : 8;
      hp[r] = row < NLAT ? outp + (size_t)row * 1024 : hc + (size_t)(row - NLAT) * 1024;
      const float* src = hp[r];
      if (init) src = row < NLAT ? xin + (size_t)row * 1024 : cin + (size_t)(row - NLAT) * 1024;
#pragma unroll
      for (int i = 0; i < 4; ++i) {
        const f32x4 hv = __builtin_nontemporal_load((const f32x4*)src + lane + 64 * i);
        h[r][i] = make_float4(hv[0], hv[1], hv[2], hv[3]);
      }
      if (has_y) {
        if (SPLITY) {
          const float4* pr = (const float4*)((const float*)(KWS + OFF_AR + AR_PART) + (size_t)(row - NLAT) * 1024);
#pragma unroll
          for (int i = 0; i < 4; ++i) {
            float4 a = pr[lane + 64 * i], b = pr[(size_t)NCTXR * 256 + lane + 64 * i];
            float4 c = pr[(size_t)2 * NCTXR * 256 + lane + 64 * i], d = pr[(size_t)3 * NCTXR * 256 + lane + 64 * i];
            y[r][i].x = (a.x + b.x) + (c.x + d.x); y[r][i].y = (a.y + b.y) + (c.y + d.y);
            y[r][i].z = (a.z + b.z) + (c.z + d.z); y[r][i].w = (a.w + b.w) + (c.w + d.w);
          }
        } else {
#pragma unroll
          for (int i = 0; i < 4; ++i) yr[r][i] = ((const uint2*)(Y + (size_t)row * 1024))[lane + 64 * i];
        }
#pragma unroll
        for (int i = 0; i < 4; ++i) g[r][i] = ((const float4*)(mod_gate + (size_t)m * 9216))[lane + 64 * i];
      }
      if (has_next) {
#pragma unroll
        for (int i = 0; i < 4; ++i) {
          sh[r][i] = ((const float4*)(mod_shift + (size_t)m * 9216))[lane + 64 * i];
          sc[r][i] = ((const float4*)(mod_scale + (size_t)m * 9216))[lane + 64 * i];
        }
      }
    }
#pragma unroll
    for (int r = 0; r < NR; ++r) {
      if (has_y) {
        float ss = 0.f;
#pragma unroll
        for (int i = 0; i < 4; ++i) {
          if (!SPLITY) {
            uint2 u = yr[r][i];
            y[r][i].x = lo2f(u.x); y[r][i].y = hi2f(u.x); y[r][i].z = lo2f(u.y); y[r][i].w = hi2f(u.y);
          }
          ss += y[r][i].x * y[r][i].x + y[r][i].y * y[r][i].y + y[r][i].z * y[r][i].z + y[r][i].w * y[r][i].w;
        }
        ss = wave_sum(ss);
        float rs = rsqrtf(ss * (1.f / 1024.f) + 1e-6f) * coef;
#pragma unroll
        for (int i = 0; i < 4; ++i) {
          h[r][i].x += g[r][i].x * (y[r][i].x * rs * gpo[i].x);
          h[r][i].y += g[r][i].y * (y[r][i].y * rs * gpo[i].y);
          h[r][i].z += g[r][i].z * (y[r][i].z * rs * gpo[i].z);
          h[r][i].w += g[r][i].w * (y[r][i].w * rs * gpo[i].w);
        }
      }
    }
#pragma unroll
    for (int r = 0; r < NR; ++r) {
      if ((init || has_y) && valid[r]) {
#pragma unroll
        for (int i = 0; i < 4; ++i)
          __builtin_nontemporal_store(f32x4{h[r][i].x, h[r][i].y, h[r][i].z, h[r][i].w}, (f32x4*)hp[r] + lane + 64 * i);
      }
      if (has_next) {
        float ss = 0.f;
#pragma unroll
        for (int i = 0; i < 4; ++i)
          ss += h[r][i].x * h[r][i].x + h[r][i].y * h[r][i].y + h[r][i].z * h[r][i].z + h[r][i].w * h[r][i].w;
        ss = wave_sum(ss);
        float rs = rsqrtf(ss * (1.f / 1024.f) + 1e-6f);
        if (valid[r]) {
#pragma unroll
          for (int i = 0; i < 4; ++i) {
            float a = (h[r][i].x * rs * gpr[i].x) * (1.f + sc[r][i].x) + sh[r][i].x;
            float b = (h[r][i].y * rs * gpr[i].y) * (1.f + sc[r][i].y) + sh[r][i].y;
            float c = (h[r][i].z * rs * gpr[i].z) * (1.f + sc[r][i].z) + sh[r][i].z;
            float d = (h[r][i].w * rs * gpr[i].w) * (1.f + sc[r][i].w) + sh[r][i].w;
            uint2 o;
            o.x = pack2(a, b);
            o.y = pack2(c, d);
            ((uint2*)(XN + (size_t)rows[r] * 1024))[lane + 64 * i] = o;
          }
        }
      }
    }
  }
}
DEV void phase_rows(PTag p, int init, int has_y, const float* gpost, const float* mod_gate, float coef,
                    int has_next, const float* gpre, const float* mod_shift, const float* mod_scale, int Mrows,
                    int ysplit = 0) {
  if (ysplit && Mrows > NLAT) {
    phase_rows_t<false, 2>(p, init, has_y, gpost, mod_gate, coef, has_next, gpre, mod_shift, mod_scale, 0, NLAT);
    phase_rows_t<true, 1>(p, init, has_y, gpost, mod_gate, coef, has_next, gpre, mod_shift, mod_scale, NLAT, Mrows);
  } else {
    phase_rows_t<false, 2>(p, init, has_y, gpost, mod_gate, coef, has_next, gpre, mod_shift, mod_scale, 0, Mrows);
  }
}

constexpr int BM = 256, BK = 64, HALF = 128, HT = HALF * BK;
DEV int lds_byte(int r, int c) {
  int st = (r >> 4) * 2 + (c >> 5), rr = r & 15, cc = c & 31, ob = rr * 64 + cc * 2;
  return st * 1024 + (ob ^ (((ob >> 9) & 1) << 5));
}
DEV void stage_rc(int b, int& R, int& C) {
  int st = b / 1024, sb = b % 1024, swz = sb ^ (((sb >> 9) & 1) << 5);
  R = (st >> 1) * 16 + swz / 64;
  C = (st & 1) * 32 + (swz % 64) / 2;
}
enum { EPI_UP = 0, EPI_Y = 1, EPI_Z = 2 };

template <int K, int EPI, bool SPLIT = false>
DEV void gemm_phase(const u16* __restrict__ A, const u16* __restrict__ Bt, int M, int N, u16* __restrict__ O0,
                    u16* __restrict__ O1, int nsplit_rowtiles = 0, float* __restrict__ Pp = nullptr) {
  const int ltid = my_tid();
  const int lbid = my_bid();
  (void)ltid; (void)lbid;
  u16* shm = (u16*)g_smem;
#define SA(b, h) (shm + ((b) * 2 + (h)) * HT)
#define SB(b, h) (shm + (4 + (b) * 2 + (h)) * HT)
#define STAGE(P, GB, kc)                                                                                        \
  do {                                                                                                           \
    __builtin_amdgcn_global_load_lds((const unsigned*)((const char*)(GB) + vb0 + (kc) * (BK * 2)),              \
                                     (unsigned*)((char*)(P) + wbase), 16, 0, 0);                                 \
    __builtin_amdgcn_global_load_lds((const unsigned*)((const char*)(GB) + vb1 + (kc) * (BK * 2)),              \
                                     (unsigned*)((char*)(P) + wbase + 8192), 16, 0, 0);                          \
  } while (0)
#define LDA(dst, b, h)                                                                                 \
  for (int m = 0; m < 4; ++m)                                                                          \
    for (int k = 0; k < 2; ++k)                                                                        \
  dst[m][k] = *reinterpret_cast<const bf16x8*>(aBase + (((b) * 2 + (h)) * 16384 + m * 2048 + k * 1024))
#define LDB(dst, b, h)                                                                                 \
  for (int n = 0; n < 2; ++n)                                                                          \
    for (int k = 0; k < 2; ++k)                                                                        \
  dst[n][k] = *reinterpret_cast<const bf16x8*>(bBase + (((b) * 2 + (h)) * 16384 + n * 2048 + k * 1024))
#define MMA(ai, bj, At_, Bt_)                                                                          \
  do {                                                                                                 \
    __builtin_amdgcn_s_setprio(1);                                                                     \
    for (int m = 0; m < 4; ++m)                                                                        \
      for (int n = 0; n < 2; ++n)                                                                      \
        for (int k = 0; k < 2; ++k)                                                                    \
          acc[ai][bj][m][n] =                                                                          \
              __builtin_amdgcn_mfma_f32_16x16x32_bf16(At_[m][k], Bt_[n][k], acc[ai][bj][m][n], 0, 0, 0); \
    __builtin_amdgcn_s_setprio(0);                                                                     \
  } while (0)
#define WAIT_V(n) asm volatile("s_waitcnt vmcnt(" #n ")" ::: "memory")
#define WAIT_L(n) asm volatile("s_waitcnt lgkmcnt(" #n ")" ::: "memory")
#define BAR __builtin_amdgcn_s_barrier()
#define SCHED __builtin_amdgcn_sched_barrier(0)

  const int tid = ltid;
  const int tid16 = tid * 16;
  unsigned off0, off1;
  {
    int r, c;
    stage_rc(tid16, r, c);
    off0 = (unsigned)(r * K + c) * 2u;
    stage_rc(tid16 + 8192, r, c);
    off1 = (unsigned)(r * K + c) * 2u;
  }
  const int wbase = __builtin_amdgcn_readfirstlane(tid >> 6) * 1024;
  const int wid = tid >> 6, lane = tid & 63, wr = wid >> 2, wc = wid & 3, fr = lane & 15, fq = lane >> 4;
  const int nM = M / BM, nN = N / BM, nwg = nM * nN;
  const int lo_ = lds_byte(fr, fq * 8);
  const char* aBase = (const char*)g_smem + wr * 8192 + lo_;
  const char* bBase = (const char*)g_smem + 65536 + wc * 4096 + lo_;
  constexpr int WGM = 8;
  const int nitems = SPLIT ? nsplit_rowtiles * nN * 4 : nwg;
  const int lb2 = SPLIT ? (lbid + 128) % (int)gridDim.x : lbid;
  for (int tix = lb2; tix < nitems; tix += gridDim.x) {
    int brow, bcol, nt, kbeg, schunk;
    if (!SPLIT) {
      int wgid = tix;
      {
        int q = nwg / 8, r = nwg % 8, xcd = wgid % 8, off = wgid / 8;
        wgid = (xcd < r ? xcd * (q + 1) : r * (q + 1) + (xcd - r) * q) + off;
      }
      int nig = WGM * nN, gid = wgid / nig, fm = gid * WGM, gsz = min(nM - fm, WGM);
      int pm = fm + ((wgid % nig) % gsz), pn = (wgid % nig) / gsz;
      brow = pm * BM;
      bcol = pn * BM;
      nt = K / BK;
      kbeg = 0;
      schunk = -1;
    } else {
      schunk = tix & 3;
      int ct = tix >> 2;
      brow = M + (ct / nN) * BM;
      bcol = (ct % nN) * BM;
      constexpr int q4 = ((K / BK) / 8) * 2;
      kbeg = (schunk < 2) ? schunk * q4 : 2 * q4 + (schunk - 2) * ((K / BK - 2 * q4) / 2);
      nt = (schunk < 2) ? q4 : (K / BK - 2 * q4) / 2;
    }
    f32x4 acc[2][2][4][2];
#pragma unroll
    for (int a = 0; a < 2; ++a)
#pragma unroll
      for (int b = 0; b < 2; ++b)
#pragma unroll
        for (int m = 0; m < 4; ++m)
#pragma unroll
          for (int n = 0; n < 2; ++n) acc[a][b][m][n] = f32x4{0.f, 0.f, 0.f, 0.f};
    bf16x8 At[4][2], B0[2][2], B1[2][2];
    const u16* gA0 = A + (size_t)brow * K + kbeg * BK;
    const u16* gA1 = gA0 + (size_t)HALF * K;
    const u16* gB0 = Bt + (size_t)bcol * K + kbeg * BK;
    const u16* gB1 = gB0 + (size_t)HALF * K;
    unsigned vb0 = off0, vb1 = off1;
    STAGE(SB(0, 0), gB0, 0);
    STAGE(SA(0, 0), gA0, 0);
    STAGE(SB(0, 1), gB1, 0);
    STAGE(SA(0, 1), gA1, 0);
    if (wr == 1) BAR;
    WAIT_V(4);
    BAR;
    STAGE(SB(1, 0), gB0, 1);
    STAGE(SA(1, 0), gA0, 1);
    STAGE(SB(1, 1), gB1, 1);
    WAIT_V(6);
    BAR;
#pragma unroll 1
    for (int t = 0; t < nt - 2; t += 2, vb0 += 2 * BK * 2, vb1 += 2 * BK * 2) {
      LDB(B0, 0, 0); SCHED; LDA(At, 0, 0); STAGE(SA(1, 1), gA1, 1);
      WAIT_L(8); BAR; WAIT_L(0); MMA(0, 0, At, B0); BAR; SCHED;
      LDB(B1, 0, 1); STAGE(SB(0, 0), gB0, 2);
      BAR; WAIT_L(0); MMA(0, 1, At, B1); BAR;
      LDA(At, 0, 1); STAGE(SA(0, 0), gA0, 2);
      BAR; WAIT_L(0); MMA(1, 0, At, B0); BAR; SCHED;
      STAGE(SB(0, 1), gB1, 2);
      WAIT_V(6); BAR; MMA(1, 1, At, B1); BAR;
      LDB(B0, 1, 0); SCHED; LDA(At, 1, 0); STAGE(SA(0, 1), gA1, 2);
      WAIT_L(8); BAR; WAIT_L(0); MMA(0, 0, At, B0); BAR; SCHED;
      LDB(B1, 1, 1); STAGE(SB(1, 0), gB0, 3);
      BAR; WAIT_L(0); MMA(0, 1, At, B1); BAR;
      LDA(At, 1, 1); STAGE(SA(1, 0), gA0, 3);
      BAR; WAIT_L(0); MMA(1, 0, At, B0); BAR; SCHED;
      STAGE(SB(1, 1), gB1, 3);
      WAIT_V(6); BAR; MMA(1, 1, At, B1); BAR;
    }
    {
      LDB(B0, 0, 0); LDA(At, 0, 0); STAGE(SA(1, 1), gA1, 1);
      BAR; WAIT_L(0); MMA(0, 0, At, B0); BAR;
      LDB(B1, 0, 1); BAR; WAIT_L(0); MMA(0, 1, At, B1); BAR;
      LDA(At, 0, 1); WAIT_V(4); BAR; WAIT_L(0); MMA(1, 0, At, B0); MMA(1, 1, At, B1); BAR;
    }
    {
      LDB(B0, 1, 0); LDA(At, 1, 0); WAIT_V(2); BAR; WAIT_L(0); MMA(0, 0, At, B0); BAR;
      LDB(B1, 1, 1); WAIT_V(0); BAR; WAIT_L(0); MMA(0, 1, At, B1); BAR;
      LDA(At, 1, 1); BAR; WAIT_L(0); MMA(1, 0, At, B0); MMA(1, 1, At, B1); BAR;
    }
    if (wr == 0) BAR;
#pragma unroll
    for (int ai = 0; ai < 2; ++ai)
#pragma unroll
      for (int bj = 0; bj < 2; ++bj)
#pragma unroll
        for (int m = 0; m < 4; ++m) {
          int rowb = brow + ai * HALF + wr * 64 + m * 16 + fq * 4;
          if (EPI == EPI_UP) {
            int hcol = ((bcol + bj * HALF + wc * 32) >> 1) + fr;
#pragma unroll
            for (int j = 0; j < 4; ++j) {
              float a = acc[ai][bj][m][0][j], b = acc[ai][bj][m][1][j];
              O0[(size_t)(rowb + j) * DFF + hcol] = f2bf(siluf_(a) * b);
            }
          } else {
#pragma unroll
            for (int n = 0; n < 2; ++n) {
              int col = bcol + bj * HALF + wc * 32 + n * 16 + fr;
#pragma unroll
              for (int j = 0; j < 4; ++j) {
                float v = acc[ai][bj][m][n][j];
                if (EPI == EPI_Y) {
                  if (!SPLIT) O0[(size_t)(rowb + j) * DM + col] = f2bf(v);
                  else Pp[((size_t)schunk * NCTXR + (size_t)(rowb + j - M)) * DM + col] = v;
                } else {
                  if (col < Z1W) O0[(size_t)(rowb + j) * Z1W + col] = f2bf(v);
                  else if (col < PIN) O1[(size_t)(rowb + j) * Z2W + (col - Z1W)] = f2bf(v);
                }
              }
            }
          }
        }
  }
#undef SA
#undef SB
#undef STAGE
#undef LDA
#undef LDB
#undef MMA
}

DEV bf16x8 ld_frag_g(const u16* p) { return *reinterpret_cast<const bf16x8*>(p); }
DEV bf16x8 ld_frag_s(const u16* p) { return *reinterpret_cast<const bf16x8*>(p); }

constexpr int ALD = 392;
constexpr int XLD = 264;
constexpr int GLD = 40;

DEV void phase_prep(PTag p, int l) {
  const int ltid = my_tid();
  const int lbid = my_bid();
  (void)ltid; (void)lbid;
  const int tid = ltid, lane = tid & 63, wid = tid >> 6;
  const int fr = lane & 15, fq = lane >> 4;
  char* ar = KWS + OFF_AR;
  const u16* Z1 = (const u16*)(ar + AR_Z1);
  const u16* Z2 = (const u16*)(ar + AR_Z2);
  u16* RWP = (u16*)(ar + AR_RWP);
  u16* LA = (u16*)(ar + AR_LA);
  float* invn = (float*)(KWS + OFF_INVN);
  u16* Gout = (u16*)(KWS + OFF_Y);
  u16* RGP = (u16*)(KWS + OFF_XN);
  const char* wb = KWS + OFF_WB;
  u16* A_lds = (u16*)g_smem;
  u16* X_lds = (u16*)(g_smem + 50176);
  u16* Gl_lds = (u16*)(g_smem + 50176 + 33792);
  const float* mu = KP(rw_mu) + (size_t)l * 1536;
  const float* k_k = KP(rw_k_k) + (size_t)l * 384;

  for (int tile = lbid; tile < NLAT / 64 + NCTXR / 32; tile += gridDim.x) {
    const int nrows = tile < NLAT / 64 ? 64 : 32;
    const int r0 = tile < NLAT / 64 ? tile * 64 : NLAT + (tile - NLAT / 64) * 32;
    const int nmt = nrows >> 4;
    const bool lat = r0 < NLAT;
    const int tpos0 = lat ? (r0 & 4095) : ((r0 - NLAT) & 255);
    const int seglen = lat ? 4096 : 256;
    for (int it0 = 0; it0 < (nrows * 192) / NTHREADS; it0 += 4) {
      uint4 own[4], n0[4], n1[4], n2[4], n3[4];
#pragma unroll
      for (int b4 = 0; b4 < 4; ++b4) {
        int q = (it0 + b4) * NTHREADS + tid;
        int i = q / 192, cc = q % 192, c0 = cc * 8;
        int row = r0 + i, tpos = tpos0 + i;
        const u16* zr = Z2 + (size_t)row * Z2W + c0;
        uint4 z4 = {0u, 0u, 0u, 0u};
        own[b4] = *(const uint4*)zr;
        n0[b4] = z4; n1[b4] = z4; n2[b4] = z4; n3[b4] = z4;
        if (lat) {
          int gcol = tpos & 63, grow = tpos >> 6;
          if (gcol > 0) n0[b4] = *(const uint4*)(zr - Z2W);
          if (gcol < 63) n1[b4] = *(const uint4*)(zr + Z2W);
          if (grow > 0) n2[b4] = *(const uint4*)(zr - 64 * Z2W);
          if (grow < 63) n3[b4] = *(const uint4*)(zr + 64 * Z2W);
        } else {
          if (tpos > 0) n0[b4] = *(const uint4*)(zr - Z2W);
          if (tpos < 255) n1[b4] = *(const uint4*)(zr + Z2W);
          n2[b4] = n0[b4];
          n3[b4] = n1[b4];
        }
      }
#pragma unroll
      for (int b4 = 0; b4 < 4; ++b4) {
        int q = (it0 + b4) * NTHREADS + tid;
        int i = q / 192, cc = q % 192, c0 = cc * 8;
        int row = r0 + i;
        float4 mu0 = *(const float4*)(mu + c0), mu1 = *(const float4*)(mu + c0 + 4);
        float f[8];
        {
          float o0 = lo2f(own[b4].x), o1 = hi2f(own[b4].x), o2 = lo2f(own[b4].y), o3 = hi2f(own[b4].y);
          float o4 = lo2f(own[b4].z), o5 = hi2f(own[b4].z), o6 = lo2f(own[b4].w), o7 = hi2f(own[b4].w);
          float s0 = lo2f(n0[b4].x), s1 = hi2f(n1[b4].x), s2 = lo2f(n2[b4].y), s3 = hi2f(n3[b4].y);
          float s4 = lo2f(n0[b4].z), s5 = hi2f(n1[b4].z), s6 = lo2f(n2[b4].w), s7 = hi2f(n3[b4].w);
          f[0] = o0 + mu0.x * (s0 - o0);
          f[1] = o1 + mu0.y * (s1 - o1);
          f[2] = o2 + mu0.z * (s2 - o2);
          f[3] = o3 + mu0.w * (s3 - o3);
          f[4] = o4 + mu1.x * (s4 - o4);
          f[5] = o5 + mu1.y * (s5 - o5);
          f[6] = o6 + mu1.z * (s6 - o6);
          f[7] = o7 + mu1.w * (s7 - o7);
        }
        if (c0 < 1152) {
          int arr = c0 / 384, cin = c0 % 384;
          uint4 o;
          o.x = pack2(f[0], f[1]); o.y = pack2(f[2], f[3]); o.z = pack2(f[4], f[5]); o.w = pack2(f[6], f[7]);
          *(uint4*)(RWP + (size_t)arr * NT * 384 + (size_t)row * 384 + cin) = o;
          if (arr == 1) {
            float4 kk0 = *(const float4*)(k_k + cin), kk1 = *(const float4*)(k_k + cin + 4);
            float a0 = f[0] * kk0.x, a1 = f[1] * kk0.y, a2 = f[2] * kk0.z, a3 = f[3] * kk0.w;
            float a4 = f[4] * kk1.x, a5 = f[5] * kk1.y, a6 = f[6] * kk1.z, a7 = f[7] * kk1.w;
            float ss = a0 * a0 + a1 * a1 + a2 * a2 + a3 * a3 + a4 * a4 + a5 * a5 + a6 * a6 + a7 * a7;
            ss = oct_sum(ss);
            if ((lane & 7) == 0) invn[(size_t)row * 8 + (cin >> 6)] = 1.f / fmaxf(sqrtf(ss), 1e-12f);
          }
        } else {
          int cl = c0 - 1152;
          if (cl < 128) {
#pragma unroll
            for (int e = 0; e < 8; ++e) f[e] = tanhf_(f[e]);
          } else if (cl >= 256) {
#pragma unroll
            for (int e = 0; e < 8; ++e) f[e] = sigmoidf_(f[e]);
          }
          uint4 o;
          o.x = pack2(f[0], f[1]); o.y = pack2(f[2], f[3]); o.z = pack2(f[4], f[5]); o.w = pack2(f[6], f[7]);
          *(uint4*)(A_lds + i * ALD + cl) = o;
        }
      }
    }
    {
      const float* cw = KP(rg_conv_w) + (size_t)l * 4 * 256;
      const float* cb = KP(rg_conv_b) + (size_t)l * 256;
      for (int it = 0; it < nrows / 16; ++it) {
        int q = it * NTHREADS + tid;
        int i = q >> 5, c0 = (q & 31) * 8;
        int row = r0 + i, tpos = tpos0 + i;
        float accv[8];
        {
          float4 b0 = *(const float4*)(cb + c0), b1 = *(const float4*)(cb + c0 + 4);
          accv[0] = b0.x; accv[1] = b0.y; accv[2] = b0.z; accv[3] = b0.w;
          accv[4] = b1.x; accv[5] = b1.y; accv[6] = b1.z; accv[7] = b1.w;
        }
#pragma unroll
        for (int j = 0; j < 4; ++j) {
          int tt = tpos + j - 2;
          if (tt >= 0 && tt < seglen) {
            uint4 xv = *(const uint4*)(Z1 + (size_t)(row + j - 2) * Z1W + c0);
            float4 w0 = *(const float4*)(cw + j * 256 + c0), w1 = *(const float4*)(cw + j * 256 + c0 + 4);
            accv[0] += w0.x * lo2f(xv.x); accv[1] += w0.y * hi2f(xv.x);
            accv[2] += w0.z * lo2f(xv.y); accv[3] += w0.w * hi2f(xv.y);
            accv[4] += w1.x * lo2f(xv.z); accv[5] += w1.y * hi2f(xv.z);
            accv[6] += w1.z * lo2f(xv.w); accv[7] += w1.w * hi2f(xv.w);
          }
        }
        uint4 o;
        o.x = pack2(accv[0], accv[1]); o.y = pack2(accv[2], accv[3]);
        o.z = pack2(accv[4], accv[5]); o.w = pack2(accv[6], accv[7]);
        *(uint4*)(X_lds + i * XLD + c0) = o;
      }
      {
        int q = tid;
        int i = q >> 3, d = (q >> 2) & 1, ch = q & 3;
        uint4 o = {0u, 0u, 0u, 0u};
        if (ch < 2 && i < nrows) o = *(const uint4*)(Z1 + (size_t)(r0 + i) * Z1W + 1664 + d * 16 + ch * 8);
        *(uint4*)(Gl_lds + (d * 64 + i) * GLD + ch * 8) = o;
      }
    }
    __syncthreads();
    for (int u = wid; u < 120; u += 8) {
      int g = u / 24, ntile = u % 24, n0 = ntile * 16;
      int n = n0 + fr;
      int nc = n0 + fq * 4;
      f32x4 acc[4];
#pragma unroll
      for (int m = 0; m < 4; ++m) acc[m] = f32x4{0.f, 0.f, 0.f, 0.f};
      if (g < 4) {
        const u16* Bt = (const u16*)(wb + ((g < 2) ? WB_RWW2T : WB_RWA2T)) + (size_t)(g & 1) * 384 * 64;
        bf16x8 b0 = ld_frag_g(Bt + (size_t)n * 64 + fq * 8), b1 = ld_frag_g(Bt + (size_t)n * 64 + 32 + fq * 8);
#pragma unroll
        for (int m = 0; m < 4; ++m) if (m < nmt) {
          const u16* ap = A_lds + (m * 16 + fr) * ALD + g * 64 + fq * 8;
          acc[m] = __builtin_amdgcn_mfma_f32_16x16x32_bf16(b0, ld_frag_s(ap), acc[m], 0, 0, 0);
          acc[m] = __builtin_amdgcn_mfma_f32_16x16x32_bf16(b1, ld_frag_s(ap + 32), acc[m], 0, 0, 0);
        }
      } else {
        const u16* Bt = (const u16*)(wb + WB_RWG2T);
        bf16x8 b[4];
#pragma unroll
        for (int k = 0; k < 4; ++k) b[k] = ld_frag_g(Bt + (size_t)n * 128 + k * 32 + fq * 8);
#pragma unroll
        for (int m = 0; m < 4; ++m) if (m < nmt) {
          const u16* ap = A_lds + (m * 16 + fr) * ALD + 256 + fq * 8;
#pragma unroll
          for (int k = 0; k < 4; ++k)
            acc[m] = __builtin_amdgcn_mfma_f32_16x16x32_bf16(b[k], ld_frag_s(ap + k * 32), acc[m], 0, 0, 0);
        }
      }
      if (g < 2) {
        float4 w0v = *(const float4*)(KP(rw_w0) + (size_t)(l * 2 + g) * 384 + nc);
        u16* dst = RWP + (size_t)(3 + g) * NT * 384;
#pragma unroll
        for (int m = 0; m < 4; ++m) if (m < nmt) {
          int row = r0 + m * 16 + fr;
          uint2 o;
          o.x = pack2(sigmoidf_(w0v.x + acc[m][0]) * 0.60653066f, sigmoidf_(w0v.y + acc[m][1]) * 0.60653066f);
          o.y = pack2(sigmoidf_(w0v.z + acc[m][2]) * 0.60653066f, sigmoidf_(w0v.w + acc[m][3]) * 0.60653066f);
          *(uint2*)(dst + (size_t)row * 384 + nc) = o;
        }
      } else if (g < 4) {
        float4 a0v = *(const float4*)(KP(rw_a0) + (size_t)(l * 2 + (g - 2)) * 384 + nc);
        u16* dst = RWP + (size_t)(5 + (g - 2)) * NT * 384;
#pragma unroll
        for (int m = 0; m < 4; ++m) if (m < nmt) {
          int row = r0 + m * 16 + fr;
          uint2 o;
          o.x = pack2(sigmoidf_(a0v.x + acc[m][0]), sigmoidf_(a0v.y + acc[m][1]));
          o.y = pack2(sigmoidf_(a0v.z + acc[m][2]), sigmoidf_(a0v.w + acc[m][3]));
          *(uint2*)(dst + (size_t)row * 384 + nc) = o;
        }
      } else {
#pragma unroll
        for (int m = 0; m < 4; ++m) if (m < nmt) {
          int row = r0 + m * 16 + fr;
          uint2 o;
          o.x = pack2(acc[m][0], acc[m][1]);
          o.y = pack2(acc[m][2], acc[m][3]);
          *(uint2*)(Gout + (size_t)row * 384 + nc) = o;
        }
      }
    }
    for (int u = wid; u < 32; u += 8) {
      int d = u >> 4, hd = (u >> 2) & 3, ntile = u & 3;
      int nl = ntile * 16 + fr;
      int chc = hd * 64 + ntile * 16 + fq * 4;
      const u16* Ba = (const u16*)(wb + WB_RGGT) + (size_t)((d * 2 + 0) * 4 + hd) * 4096 + nl * 64;
      const u16* Bx = (const u16*)(wb + WB_RGGT) + (size_t)((d * 2 + 1) * 4 + hd) * 4096 + nl * 64;
      bf16x8 ba0 = ld_frag_g(Ba + fq * 8), ba1 = ld_frag_g(Ba + 32 + fq * 8);
      bf16x8 bx0 = ld_frag_g(Bx + fq * 8), bx1 = ld_frag_g(Bx + 32 + fq * 8);
      float4 gab = *(const float4*)(KP(rg_gate_a_b) + (size_t)(l * 2 + d) * 256 + chc);
      float4 gxb = *(const float4*)(KP(rg_gate_x_b) + (size_t)(l * 2 + d) * 256 + chc);
      float4 lam = *(const float4*)(KP(rg_lambda) + (size_t)(l * 2 + d) * 256 + chc);
      float spl[4] = {__logf(1.f + __expf(-lam.x)) * 8.f, __logf(1.f + __expf(-lam.y)) * 8.f,
                      __logf(1.f + __expf(-lam.z)) * 8.f, __logf(1.f + __expf(-lam.w)) * 8.f};
      float gabv[4] = {gab.x, gab.y, gab.z, gab.w}, gxbv[4] = {gxb.x, gxb.y, gxb.z, gxb.w};
      u16* dla = RGP + (size_t)(d * 2 + 0) * NT * 256;
      u16* dbx = RGP + (size_t)(d * 2 + 1) * NT * 256;
#pragma unroll
      for (int m = 0; m < 4; ++m) if (m < nmt) {
        const u16* ap = X_lds + (m * 16 + fr) * XLD + hd * 64 + fq * 8;
        bf16x8 a0 = ld_frag_s(ap), a1 = ld_frag_s(ap + 32);
        f32x4 ca = f32x4{0.f, 0.f, 0.f, 0.f}, cx = ca;
        ca = __builtin_amdgcn_mfma_f32_16x16x32_bf16(ba0, a0, ca, 0, 0, 0);
        ca = __builtin_amdgcn_mfma_f32_16x16x32_bf16(ba1, a1, ca, 0, 0, 0);
        cx = __builtin_amdgcn_mfma_f32_16x16x32_bf16(bx0, a0, cx, 0, 0, 0);
        cx = __builtin_amdgcn_mfma_f32_16x16x32_bf16(bx1, a1, cx, 0, 0, 0);
        int il = m * 16 + fr;
        int row = r0 + il;
        uint2 xcv = *(const uint2*)(X_lds + il * XLD + chc);
        float xc[4] = {lo2f(xcv.x), hi2f(xcv.x), lo2f(xcv.y), hi2f(xcv.y)};
        float la[4], bx[4];
#pragma unroll
        for (int j = 0; j < 4; ++j) {
          float r = sigmoidf_(ca[j] + gabv[j]), ig = sigmoidf_(cx[j] + gxbv[j]);
          float loga = -r * spl[j];
          float mult = __builtin_amdgcn_sqrtf(fmaxf(1.f - __expf(2.f * loga), 0.f));
          la[j] = loga;
          bx[j] = mult * ig * xc[j];
        }
        uint2 o;
        o.x = pack2(la[0], la[1]); o.y = pack2(la[2], la[3]);
        *(uint2*)(dla + (size_t)row * 256 + chc) = o;
        o.x = pack2(bx[0], bx[1]); o.y = pack2(bx[2], bx[3]);
        *(uint2*)(dbx + (size_t)row * 256 + chc) = o;
      }
    }
    for (int u = wid; u < 24; u += 8) {
      int d = u / 12, ntile = u % 12;
      int n = ntile * 16 + fr;
      int nc = ntile * 16 + fq * 4;
      const u16* Bt = (const u16*)(wb + WB_GLAT) + (size_t)d * 192 * 32;
      bf16x8 b0 = ld_frag_g(Bt + (size_t)n * 32 + fq * 8);
      float4 bb = *(const float4*)(KP(gla_alpha_b) + (size_t)(l * 2 + d) * 192 + nc);
      u16* dst = LA + (size_t)d * NT * 192;
#pragma unroll
      for (int m = 0; m < 4; ++m) if (m < nmt) {
        const u16* ap = Gl_lds + (d * 64 + m * 16 + fr) * GLD + fq * 8;
        f32x4 cacc = f32x4{0.f, 0.f, 0.f, 0.f};
        cacc = __builtin_amdgcn_mfma_f32_16x16x32_bf16(b0, ld_frag_s(ap), cacc, 0, 0, 0);
        int row = r0 + m * 16 + fr;
        uint2 o;
        o.x = pack2(log_sigmoidf_(cacc[0] + bb.x) * (1.f / 16.f), log_sigmoidf_(cacc[1] + bb.y) * (1.f / 16.f));
        o.y = pack2(log_sigmoidf_(cacc[2] + bb.z) * (1.f / 16.f), log_sigmoidf_(cacc[3] + bb.w) * (1.f / 16.f));
        *(uint2*)(dst + (size_t)row * 192 + nc) = o;
      }
    }
    __syncthreads();
  }
}

constexpr int TC = 32;
constexpr int NSTEP = 4352;
typedef float v2f __attribute__((ext_vector_type(2)));
DEV v2f pkfma(v2f a, v2f b, v2f c) { return __builtin_elementwise_fma(a, b, c); }
DEV float hex_sum(float x) {
  x = quad_sum(x);
  x += dpp_f<0x141>(x);
  x += dpp_f<0x140>(x);
  return x;
}
#define DPPADD(r, ctrl) "v_add_f32_dpp " r ", " r ", " r " " ctrl " row_mask:0xf bank_mask:0xf bound_ctrl:1\n\t"
DEV void hex_sum2(float& x, float& y) {
  asm volatile("s_nop 1\n\t"
               DPPADD("%0", "quad_perm:[1,0,3,2]") DPPADD("%1", "quad_perm:[1,0,3,2]") "s_nop 0\n\t"
               DPPADD("%0", "quad_perm:[2,3,0,1]") DPPADD("%1", "quad_perm:[2,3,0,1]") "s_nop 0\n\t"
               DPPADD("%0", "row_half_mirror") DPPADD("%1", "row_half_mirror") "s_nop 0\n\t"
               DPPADD("%0", "row_mirror") DPPADD("%1", "row_mirror")
               : "+v"(x), "+v"(y));
}
DEV void hex_sum4(float& a, float& b, float& c, float& d) {
  asm volatile("s_nop 1\n\t"
               DPPADD("%0", "quad_perm:[1,0,3,2]") DPPADD("%1", "quad_perm:[1,0,3,2]")
               DPPADD("%2", "quad_perm:[1,0,3,2]") DPPADD("%3", "quad_perm:[1,0,3,2]")
               DPPADD("%0", "quad_perm:[2,3,0,1]") DPPADD("%1", "quad_perm:[2,3,0,1]")
               DPPADD("%2", "quad_perm:[2,3,0,1]") DPPADD("%3", "quad_perm:[2,3,0,1]")
               DPPADD("%0", "row_half_mirror") DPPADD("%1", "row_half_mirror")
               DPPADD("%2", "row_half_mirror") DPPADD("%3", "row_half_mirror")
               DPPADD("%0", "row_mirror") DPPADD("%1", "row_mirror")
               DPPADD("%2", "row_mirror") DPPADD("%3", "row_mirror")
               : "+v"(a), "+v"(b), "+v"(c), "+v"(d));
}
DEV void oct_sum2(float& x, float& y) {
  asm volatile("s_nop 1\n\t"
               DPPADD("%0", "quad_perm:[1,0,3,2]") DPPADD("%1", "quad_perm:[1,0,3,2]") "s_nop 0\n\t"
               DPPADD("%0", "quad_perm:[2,3,0,1]") DPPADD("%1", "quad_perm:[2,3,0,1]") "s_nop 0\n\t"
               DPPADD("%0", "row_half_mirror") DPPADD("%1", "row_half_mirror")
               : "+v"(x), "+v"(y));
}
DEV void oct_sum3(float& a, float& b, float& c) {
  asm volatile("s_nop 1\n\t"
               DPPADD("%0", "quad_perm:[1,0,3,2]") DPPADD("%1", "quad_perm:[1,0,3,2]") DPPADD("%2", "quad_perm:[1,0,3,2]")
               DPPADD("%0", "quad_perm:[2,3,0,1]") DPPADD("%1", "quad_perm:[2,3,0,1]") DPPADD("%2", "quad_perm:[2,3,0,1]")
               DPPADD("%0", "row_half_mirror") DPPADD("%1", "row_half_mirror") DPPADD("%2", "row_half_mirror")
               : "+v"(a), "+v"(b), "+v"(c));
}

constexpr int RST = 392;
struct RwOps { float4 w, k, a, b, wr; float2 vv; float2 sc; };
struct RwOps8 { float4 w0, w1, k0, k1, a0, a1, b0, b1, r0, r1; float vv; float2 sc; };
DEV void scan_rwkv(PTag p, int l, int task) {
  const int ltid = my_tid();
  const int tid = ltid, lane = tid & 63, w = tid >> 6;
  const int half = task & 1, sc = task >> 1;
  const int b = sc / 12, h = (sc % 12) >> 1, dir = sc & 1;
  char* ar = KWS + OFF_AR;
  const u16* RWP = (const u16*)(ar + AR_RWP);
  const u16* Rg = RWP, *Kg = RWP + (size_t)NT * 384, *Vg = RWP + (size_t)2 * NT * 384;
  const u16* Ug = RWP + (size_t)(3 + dir) * NT * 384, *Ag = RWP + (size_t)(5 + dir) * NT * 384;
  const float* invn = (const float*)(KWS + OFF_INVN);
  u16* Yd = (u16*)(ar + AR_Z2) + (size_t)dir * NT * 384;
  float* buf = (float*)g_smem;
  float* ybuf = buf + 2 * TC * RST;
  const int rl = lane >> 3, kg = lane & 7;
  const int lrow = w * 8 + rl;
  const int lstep = tid >> 4, lq = tid & 15;
  const int ce = h * 64 + lq * 4;
  float4 kkc = *(const float4*)(KP(rw_k_k) + (size_t)l * 384 + ce);
  float4 kac = *(const float4*)(KP(rw_k_a) + (size_t)l * 384 + ce);
  v2f S0 = {0.f, 0.f}, S1 = {0.f, 0.f}, S2 = {0.f, 0.f}, S3 = {0.f, 0.f};

  uint2 gr, gk, gv, gu, ga;
  float gin;
  auto issue = [&](int c) {
    int row = seq_row(b, dir, c * TC + lstep);
    size_t o = (size_t)row * 384 + ce;
    gr = *(const uint2*)(Rg + o);
    gk = *(const uint2*)(Kg + o);
    gv = *(const uint2*)(Vg + o);
    gu = *(const uint2*)(Ug + o);
    ga = *(const uint2*)(Ag + o);
    gin = invn[(size_t)row * 8 + h];
  };
  auto commit = [&](int c, int) {
    float* d = buf + (size_t)((c & 1) * TC + lstep) * RST;
    float r0 = lo2f(gr.x), r1 = hi2f(gr.x), r2 = lo2f(gr.y), r3 = hi2f(gr.y);
    float k0 = lo2f(gk.x), k1 = hi2f(gk.x), k2 = lo2f(gk.y), k3 = hi2f(gk.y);
    float v0 = lo2f(gv.x), v1 = hi2f(gv.x), v2 = lo2f(gv.y), v3 = hi2f(gv.y);
    float u0 = lo2f(gu.x), u1 = hi2f(gu.x), u2 = lo2f(gu.y), u3 = hi2f(gu.y);
    float a0 = lo2f(ga.x), a1 = hi2f(ga.x), a2 = lo2f(ga.y), a3 = hi2f(ga.y);
    float w0 = __expf(-u0), w1 = __expf(-u1), w2 = __expf(-u2), w3 = __expf(-u3);
    float d0 = k0 * (1.f + (a0 - 1.f) * kac.x), d1 = k1 * (1.f + (a1 - 1.f) * kac.y);
    float d2 = k2 * (1.f + (a2 - 1.f) * kac.z), d3 = k3 * (1.f + (a3 - 1.f) * kac.w);
    float q0 = k0 * kkc.x * gin, q1 = k1 * kkc.y * gin, q2 = k2 * kkc.z * gin, q3 = k3 * kkc.w * gin;
    float b0 = q0 * a0, b1 = q1 * a1, b2 = q2 * a2, b3 = q3 * a3;
    *(float4*)(d + lq * 4) = make_float4(w0, w1, w2, w3);
    *(float4*)(d + 64 + lq * 4) = make_float4(d0, d1, d2, d3);
    *(float4*)(d + 128 + lq * 4) = make_float4(-q0, -q1, -q2, -q3);
    *(float4*)(d + 192 + lq * 4) = make_float4(b0, b1, b2, b3);
    *(float4*)(d + 256 + lq * 4) = make_float4(w0 * r0, w1 * r1, w2 * r2, w3 * r3);
    *(float4*)(d + 320 + lq * 4) = make_float4(v0, v1, v2, v3);
    float br = b0 * r0 + b1 * r1 + b2 * r2 + b3 * r3;
    float kr = d0 * r0 + d1 * r1 + d2 * r2 + d3 * r3;
    hex_sum2(br, kr);
    if (lq == 0) *(float2*)(d + 384) = make_float2(br, kr);
  };
  issue(0);
  commit(0, 0);
  __syncthreads();
  constexpr int NCH = NSTEP / TC;
#pragma unroll 1
  for (int c = 0; c < NCH; ++c) {
    const int cn = (c + 1 < NCH) ? c + 1 : c;
    issue(cn);
    const float* cb = buf + (size_t)(c & 1) * TC * RST;
    float* yb = ybuf + (c & 1) * TC * 32;
    if (w < 4) {
      auto ld = [&](int s) {
        RwOps8 o;
        const float* sb = cb + s * RST + kg * 8;
        o.w0 = *(const float4*)(sb);        o.w1 = *(const float4*)(sb + 4);
        o.k0 = *(const float4*)(sb + 64);   o.k1 = *(const float4*)(sb + 68);
        o.a0 = *(const float4*)(sb + 128);  o.a1 = *(const float4*)(sb + 132);
        o.b0 = *(const float4*)(sb + 192);  o.b1 = *(const float4*)(sb + 196);
        o.r0 = *(const float4*)(sb + 256);  o.r1 = *(const float4*)(sb + 260);
        o.vv = cb[s * RST + 320 + half * 32 + lrow];
        o.sc = *(const float2*)(cb + s * RST + 384);
        return o;
      };
      RwOps8 cur = ld(0);
#pragma unroll 8
      for (int s = 0; s < TC; ++s) {
        RwOps8 nxt = ld((s + 1) & (TC - 1));
        v2f t1 = S0 * v2f{cur.a0.x, cur.a0.y}, t2 = S0 * v2f{cur.r0.x, cur.r0.y};
        t1 = pkfma(S1, v2f{cur.a0.z, cur.a0.w}, t1);
        t2 = pkfma(S1, v2f{cur.r0.z, cur.r0.w}, t2);
        t1 = pkfma(S2, v2f{cur.a1.x, cur.a1.y}, t1);
        t2 = pkfma(S2, v2f{cur.r1.x, cur.r1.y}, t2);
        t1 = pkfma(S3, v2f{cur.a1.z, cur.a1.w}, t1);
        t2 = pkfma(S3, v2f{cur.r1.z, cur.r1.w}, t2);
        float sa = t1.x + t1.y, yy = t2.x + t2.y;
        oct_sum2(sa, yy);
        v2f sa2 = {sa, sa}, va2 = {cur.vv, cur.vv};
        S0 = pkfma(S0, v2f{cur.w0.x, cur.w0.y}, pkfma(sa2, v2f{cur.b0.x, cur.b0.y}, va2 * v2f{cur.k0.x, cur.k0.y}));
        S1 = pkfma(S1, v2f{cur.w0.z, cur.w0.w}, pkfma(sa2, v2f{cur.b0.z, cur.b0.w}, va2 * v2f{cur.k0.z, cur.k0.w}));
        S2 = pkfma(S2, v2f{cur.w1.x, cur.w1.y}, pkfma(sa2, v2f{cur.b1.x, cur.b1.y}, va2 * v2f{cur.k1.x, cur.k1.y}));
        S3 = pkfma(S3, v2f{cur.w1.z, cur.w1.w}, pkfma(sa2, v2f{cur.b1.z, cur.b1.w}, va2 * v2f{cur.k1.z, cur.k1.w}));
        yy = fmaf(sa, cur.sc.x, fmaf(cur.vv, cur.sc.y, yy));
        yb[s * 32 + lrow] = yy;
        cur = nxt;
      }
    }
    commit(c + 1, cn);
    __syncthreads();
    if (lq < 8) {
      int row = seq_row(b, dir, c * TC + lstep);
      float4 yv = *(const float4*)(yb + lstep * 32 + lq * 4);
      uint2 o;
      o.x = pack2(yv.x, yv.y);
      o.y = pack2(yv.z, yv.w);
      *(uint2*)(Yd + (size_t)row * 384 + h * 64 + half * 32 + lq * 4) = o;
    }
  }
  __syncthreads();
}

constexpr int GST = 288;
struct GlOps { float4 a03, k03, q03; float2 a45, k45, q45; float v0, v1, v2; };
DEV void scan_gla_rg(PTag p, int l, int task) {
  const int ltid = my_tid();
  const int tid = ltid, lane = tid & 63, w = tid >> 6;
  const int b = task >> 3, hd = (task >> 1) & 3, dir = task & 1;
  char* ar = KWS + OFF_AR;
  const u16* Z1 = (const u16*)(ar + AR_Z1);
  const u16* LAg = (const u16*)(ar + AR_LA) + (size_t)dir * NT * 192;
  u16* Od = (u16*)(ar + AR_Z2) + (size_t)(2 + dir) * NT * 384;
  const u16* RGP = (const u16*)(KWS + OFF_XN);
  const u16* RLA = RGP + (size_t)(dir * 2 + 0) * NT * 256;
  const u16* RBX = RGP + (size_t)(dir * 2 + 1) * NT * 256;
  u16* Hd = (u16*)(KWS + OFF_Y) + (size_t)NT * 384 + (size_t)dir * NT * 256;
  float* buf = (float*)g_smem;
  float* obuf = buf + 2 * TC * GST;
  unsigned* rgbuf = (unsigned*)(obuf + 2 * TC * 128);
  u16* hbuf = (u16*)(rgbuf + 2 * TC * 64);
  const int el = lane >> 3, dg = lane & 7;
  const int c0 = w * 24 + el;
  const int lstep = tid >> 4, lq = tid & 15;
  v2f S[3][3];
#pragma unroll
  for (int c = 0; c < 3; ++c)
#pragma unroll
    for (int j = 0; j < 3; ++j) S[c][j] = v2f{0.f, 0.f};
  float hst = 0.f;
  uint2 gq, gk, gl_, gv0, gv1, rla, rbx;
  auto issue = [&](int c) {
    int row = seq_row(b, dir, c * TC + lstep);
    const u16* zr = Z1 + (size_t)row * Z1W;
    uint2 z = {0u, 0u};
    gq = z; gk = z; gl_ = z; gv1 = z;
    if (lq < 12) {
      gq = *(const uint2*)(zr + 512 + hd * 48 + lq * 4);
      gk = *(const uint2*)(zr + 704 + hd * 48 + lq * 4);
      gl_ = *(const uint2*)(LAg + (size_t)row * 192 + hd * 48 + lq * 4);
    }
    gv0 = *(const uint2*)(zr + 896 + hd * 96 + lq * 4);
    if (lq < 8) gv1 = *(const uint2*)(zr + 896 + hd * 96 + 64 + lq * 4);
    rla = *(const uint2*)(RLA + (size_t)row * 256 + hd * 64 + lq * 4);
    rbx = *(const uint2*)(RBX + (size_t)row * 256 + hd * 64 + lq * 4);
  };
  auto commit = [&](int c, int) {
    float* d = buf + (size_t)((c & 1) * TC + lstep) * GST;
    const float qs = 0.14433756729740643f;
    if (lq < 12) {
      float av[4] = {__expf(lo2f(gl_.x)), __expf(hi2f(gl_.x)), __expf(lo2f(gl_.y)), __expf(hi2f(gl_.y))};
      float kv[4] = {lo2f(gk.x), hi2f(gk.x), lo2f(gk.y), hi2f(gk.y)};
      float qv[4] = {lo2f(gq.x) * qs, hi2f(gq.x) * qs, lo2f(gq.y) * qs, hi2f(gq.y) * qs};
#pragma unroll
      for (int e = 0; e < 4; ++e) {
        int dd = lq * 4 + e;
        int pos = (dd / 6) * 20 + (dd % 6);
        d[pos] = av[e];
        d[6 + pos] = kv[e];
        d[12 + pos] = qv[e];
      }
    }
    {
      float vv0[4] = {lo2f(gv0.x), hi2f(gv0.x), lo2f(gv0.y), hi2f(gv0.y)};
      float vv1[4] = {lo2f(gv1.x), hi2f(gv1.x), lo2f(gv1.y), hi2f(gv1.y)};
#pragma unroll
      for (int e = 0; e < 4; ++e) {
        int c = lq * 4 + e, r = c % 24;
        d[160 + (c / 24) * 32 + (r % 8) * 4 + (r / 8)] = vv0[e];
        if (lq < 8) {
          int c2 = 64 + lq * 4 + e, r2 = c2 % 24;
          d[160 + (c2 / 24) * 32 + (r2 % 8) * 4 + (r2 / 8)] = vv1[e];
        }
      }
    }
    unsigned* rd = rgbuf + (size_t)((c & 1) * TC + lstep) * 64 + lq * 4;
    uint4 ro;
    ro.x = (rla.x & 0xffffu) | (rbx.x << 16);
    ro.y = (rla.x >> 16) | (rbx.x & 0xffff0000u);
    ro.z = (rla.y & 0xffffu) | (rbx.y << 16);
    ro.w = (rla.y >> 16) | (rbx.y & 0xffff0000u);
    *(uint4*)rd = ro;
  };
  issue(0);
  commit(0, 0);
  __syncthreads();
  constexpr int NCH = NSTEP / TC;
#pragma unroll 1
  for (int c = 0; c < NCH; ++c) {
    const int cn = (c + 1 < NCH) ? c + 1 : c;
    issue(cn);
    const float* cb = buf + (size_t)(c & 1) * TC * GST;
    float* ob = obuf + (c & 1) * TC * 128;
    if (w < 4) {
      auto ld = [&](int s) {
        GlOps o;
        const float* sb = cb + s * GST + dg * 20;
        float4 r0 = *(const float4*)(sb), r1 = *(const float4*)(sb + 4), r2 = *(const float4*)(sb + 8);
        float4 r3 = *(const float4*)(sb + 12);
        float2 r4 = *(const float2*)(sb + 16);
        o.a03 = r0;
        o.a45 = make_float2(r1.x, r1.y);
        o.k03 = make_float4(r1.z, r1.w, r2.x, r2.y);
        o.k45 = make_float2(r2.z, r2.w);
        o.q03 = r3;
        o.q45 = r4;
        float4 vq = *(const float4*)(cb + s * GST + 160 + w * 32 + el * 4);
        o.v0 = vq.x; o.v1 = vq.y; o.v2 = vq.z;
        return o;
      };
      GlOps cur = ld(0);
#pragma unroll 8
      for (int s = 0; s < TC; ++s) {
        GlOps nxt = ld((s + 1) & (TC - 1));
        v2f al[3] = {v2f{cur.a03.x, cur.a03.y}, v2f{cur.a03.z, cur.a03.w}, v2f{cur.a45.x, cur.a45.y}};
        v2f kk[3] = {v2f{cur.k03.x, cur.k03.y}, v2f{cur.k03.z, cur.k03.w}, v2f{cur.k45.x, cur.k45.y}};
        v2f qq[3] = {v2f{cur.q03.x, cur.q03.y}, v2f{cur.q03.z, cur.q03.w}, v2f{cur.q45.x, cur.q45.y}};
        v2f vv[3] = {v2f{cur.v0, cur.v0}, v2f{cur.v1, cur.v1}, v2f{cur.v2, cur.v2}};
        float r[3];
#pragma unroll
        for (int ci = 0; ci < 3; ++ci) {
#pragma unroll
          for (int j = 0; j < 3; ++j) S[ci][j] = pkfma(al[j], S[ci][j], kk[j] * vv[ci]);
          v2f o = qq[0] * S[ci][0];
          o = pkfma(qq[1], S[ci][1], o);
          o = pkfma(qq[2], S[ci][2], o);
          r[ci] = o.x + o.y;
        }
        oct_sum3(r[0], r[1], r[2]);
        typedef float v3f __attribute__((ext_vector_type(3)));
        *(v3f*)(ob + s * 128 + w * 32 + el * 4) = v3f{r[0], r[1], r[2]};
        cur = nxt;
      }
    } else if (w == 4) {
      const unsigned* rb = rgbuf + (size_t)(c & 1) * TC * 64 + lane;
      u16* hb = hbuf + (size_t)(c & 1) * TC * 64 + lane;
      unsigned uu[TC];
#pragma unroll
      for (int s = 0; s < TC; ++s) uu[s] = rb[s * 64];
#pragma unroll
      for (int s = 0; s < TC; ++s) {
        float a = __expf(lo2f(uu[s]));
        hst = fmaf(a, hst, hi2f(uu[s]));
        hb[s * 64] = f2bf(hst);
      }
    }
    commit(c + 1, cn);
    __syncthreads();
    {
      int row = seq_row(b, dir, c * TC + lstep);
      u16* orow = Od + (size_t)row * 384 + hd * 96;
      const float* orow_l = ob + lstep * 128;
      float x0[4], x1[4];
#pragma unroll
      for (int e = 0; e < 4; ++e) {
        int c = lq * 4 + e, r = c % 24;
        x0[e] = orow_l[(c / 24) * 32 + (r % 8) * 4 + (r / 8)];
        int c2 = 64 + (lq & 7) * 4 + e, r2 = c2 % 24;
        x1[e] = orow_l[(c2 / 24) * 32 + (r2 % 8) * 4 + (r2 / 8)];
      }
      uint2 o;
      o.x = pack2(x0[0], x0[1]); o.y = pack2(x0[2], x0[3]);
      *(uint2*)(orow + lq * 4) = o;
      if (lq < 8) {
        o.x = pack2(x1[0], x1[1]); o.y = pack2(x1[2], x1[3]);
        *(uint2*)(orow + 64 + lq * 4) = o;
      }
      uint2 hv = *(const uint2*)(hbuf + (size_t)((c & 1) * TC + lstep) * 64 + lq * 4);
      *(uint2*)(Hd + (size_t)row * 256 + hd * 64 + lq * 4) = hv;
    }
  }
  __syncthreads();
}

DEV void phase_scan(PTag p, int l, int mode) {
  const int lbid = my_bid();
  for (int task = lbid; task < 256; task += gridDim.x) {
    if (task < 192) { if (mode != 2) scan_rwkv(p, l, task); }
    else { if (mode != 1) scan_gla_rg(p, l, task - 192); }
  }
}

DEV float gelu_tanh(float x) {
  float u = 0.7978845608028654f * (x + 0.044715f * x * x * x);
  return 0.5f * x * (1.f + tanhf_(u));
}
DEV void phase_post(PTag p, int l) {
  const int ltid = my_tid();
  const int lbid = my_bid();
  const int lane = ltid & 63;
  const int gw = lbid * 8 + (ltid >> 6), nw = gridDim.x * 8;
  char* ar = KWS + OFF_AR;
  const u16* Z1 = (const u16*)(ar + AR_Z1);
  const u16* RWP = (const u16*)(ar + AR_RWP);
  const u16* RWY = (const u16*)(ar + AR_Z2);
  const u16* Gg = (const u16*)(KWS + OFF_Y);
  const u16* RGH = Gg + (size_t)NT * 384;
  u16* YM = (u16*)(KWS + OFF_XN);
  const float* gnorm = KP(gla_norm) + (size_t)l * 96;
  const float* r_k = KP(rw_r_k) + (size_t)l * 384;
  const float* k_a = KP(rw_k_a) + (size_t)l * 384;
  const float* ln_w = KP(rw_ln_w) + (size_t)l * 384;
  const float* ln_b = KP(rw_ln_b) + (size_t)l * 384;
  float gn0 = gnorm[lane], gn1 = (lane < 32) ? gnorm[64 + lane] : 0.f;
  float rkc[6], kac[6], lwc[6], lbc[6];
#pragma unroll
  for (int j = 0; j < 6; ++j) {
    rkc[j] = r_k[j * 64 + lane]; kac[j] = k_a[j * 64 + lane];
    lwc[j] = ln_w[j * 64 + lane]; lbc[j] = ln_b[j * 64 + lane];
  }
  const int l32 = lane < 32 ? lane : 0;
  for (int row = gw; row < NT; row += nw) {
    uint2 hf = *(const uint2*)(RGH + (size_t)row * 256 + lane * 4);
    uint2 hb = *(const uint2*)(RGH + (size_t)NT * 256 + (size_t)row * 256 + lane * 4);
    uint2 gb = *(const uint2*)(Z1 + (size_t)row * Z1W + 256 + lane * 4);
    const u16* of = RWY + (size_t)2 * NT * 384 + (size_t)row * 384;
    const u16* ob = RWY + (size_t)3 * NT * 384 + (size_t)row * 384;
    const u16* og = Z1 + (size_t)row * Z1W + 1280;
    u16 gof0[4], gob0[4], gog0[4], gof1[4], gob1[4], gog1[4];
#pragma unroll
    for (int hd = 0; hd < 4; ++hd) {
      gof0[hd] = of[hd * 96 + lane]; gob0[hd] = ob[hd * 96 + lane]; gog0[hd] = og[hd * 96 + lane];
      gof1[hd] = of[hd * 96 + 64 + l32]; gob1[hd] = ob[hd * 96 + 64 + l32]; gog1[hd] = og[hd * 96 + 64 + l32];
    }
    size_t ro = (size_t)row * 384;
    u16 wyf[6], wyb[6], wr[6], wk[6], wv[6], waf[6], wab[6], wg[6];
#pragma unroll
    for (int j = 0; j < 6; ++j) {
      int idx = j * 64 + lane;
      wyf[j] = RWY[ro + idx]; wyb[j] = RWY[(size_t)NT * 384 + ro + idx];
      wr[j] = RWP[ro + idx]; wk[j] = RWP[(size_t)NT * 384 + ro + idx]; wv[j] = RWP[(size_t)2 * NT * 384 + ro + idx];
      waf[j] = RWP[(size_t)5 * NT * 384 + ro + idx]; wab[j] = RWP[(size_t)6 * NT * 384 + ro + idx];
      wg[j] = Gg[ro + idx];
    }
    {
      float y0 = (lo2f(hf.x) + lo2f(hb.x)) * gelu_tanh(lo2f(gb.x));
      float y1 = (hi2f(hf.x) + hi2f(hb.x)) * gelu_tanh(hi2f(gb.x));
      float y2 = (lo2f(hf.y) + lo2f(hb.y)) * gelu_tanh(lo2f(gb.y));
      float y3 = (hi2f(hf.y) + hi2f(hb.y)) * gelu_tanh(hi2f(gb.y));
      uint2 o;
      o.x = pack2(y0, y1); o.y = pack2(y2, y3);
      *(uint2*)(YM + (size_t)row * 1024 + lane * 4) = o;
    }
#pragma unroll
    for (int hd = 0; hd < 4; ++hd) {
      float v0 = bf2f(gof0[hd]) + bf2f(gob0[hd]);
      float v1 = (lane < 32) ? (bf2f(gof1[hd]) + bf2f(gob1[hd])) : 0.f;
      float ss = wave_sum(v0 * v0 + v1 * v1);
      float rs = rsqrtf(ss * (1.f / 96.f) + 1e-6f);
      YM[(size_t)row * 1024 + 256 + hd * 96 + lane] = f2bf(v0 * rs * gn0 * siluf_(bf2f(gog0[hd])));
      if (lane < 32)
        YM[(size_t)row * 1024 + 256 + hd * 96 + 64 + lane] = f2bf(v1 * rs * gn1 * siluf_(bf2f(gog1[hd])));
    }
#pragma unroll
    for (int j = 0; j < 6; ++j) {
      int idx = j * 64 + lane;
      float y = bf2f(wyf[j]) + bf2f(wyb[j]);
      float r = bf2f(wr[j]), k = bf2f(wk[j]), v = bf2f(wv[j]);
      float af = bf2f(waf[j]), ab = bf2f(wab[j]);
      float mean = wave_sum(y) * (1.f / 64.f);
      float dlt = y - mean;
      float var = wave_sum(dlt * dlt) * (1.f / 64.f);
      float bon = wave_sum(r * k * rkc[j] * (2.f + (af + ab - 2.f) * kac[j]));
      float yn = dlt * rsqrtf(var + 64e-5f) * lwc[j] + lbc[j];
      yn += bon * v;
      YM[(size_t)row * 1024 + 640 + idx] = f2bf(yn * bf2f(wg[j]));
    }
  }
}

constexpr int NPHASES = 2 + 12 * 4;

DEV void run_phase(PTag p, int ph, int rep) {
  float* mod = (float*)(KWS + OFF_MOD);
  char* ws = KWS;
  u16* XN = (u16*)(ws + OFF_XN);
  u16* Yb = (u16*)(ws + OFF_Y);
  u16* U = (u16*)(ws + OFF_AR);
  if (ph == 0) {
    phase_adaln(p);
    __syncthreads();
    conv_ffn(p, 0, 0);
    return;
  }
  if (ph == 1) {
    phase_rows(p, 1, 0, nullptr, nullptr, 0.f, 1, KP(norm_pre) + 0, mod + 0 * 1024, mod + 1 * 1024, NT);
    return;
  }
  int q = ph - 2, l = q / 12, k = q % 12;
  const float* modl = mod + (size_t)l * 9 * 9216;
  const bool last = (l == 3);
  const int Mlate = last ? NLAT : NT;
  switch (k) {
    case 0:
      gemm_phase<1024, EPI_UP>(XN, (const u16*)(ws + OFF_WB + WB_W13T), NT, 5632, U, nullptr);
      break;
    case 1:
      gemm_phase<2816, EPI_Y>(U, (const u16*)(ws + OFF_WB + WB_W2T), NLAT, 1024, Yb, nullptr);
      gemm_phase<2816, EPI_Y, true>(U, (const u16*)(ws + OFF_WB + WB_W2T), NLAT, 1024, Yb, nullptr, NCTXR / BM,
                                    (float*)(ws + OFF_AR + AR_PART));
      break;
    case 2:
      phase_rows(p, 0, 1, KP(norm_post) + (size_t)(l * 3 + 0) * 1024, modl + 2 * 1024, 0.5f, 1,
                 KP(norm_pre) + (size_t)(l * 3 + 1) * 1024, modl + 3 * 1024, modl + 4 * 1024, NT, 1);
      conv_mixer(p, l);
      break;
    case 3:
      gemm_phase<1024, EPI_Z>(XN, (const u16*)(ws + OFF_WB + WB_WINT), NT, PINP, (u16*)(ws + OFF_AR + AR_Z1),
                              (u16*)(ws + OFF_AR + AR_Z2));
      break;
    case 4:
      phase_prep(p, l);
      break;
    case 5:
      phase_scan(p, l, rep == 0 ? 0 : SCAN_PROBE_MODE);
      break;
    case 6:
      phase_post(p, l);
      break;
    case 7:
      gemm_phase<1024, EPI_Y>(XN, (const u16*)(ws + OFF_WB + WB_WOUTT), NLAT, 1024, Yb, nullptr);
      if (!last)
        gemm_phase<1024, EPI_Y, true>(XN, (const u16*)(ws + OFF_WB + WB_WOUTT), NLAT, 1024, Yb, nullptr, NCTXR / BM,
                                      (float*)(ws + OFF_AR + AR_PART));
      break;
    case 8:
      phase_rows(p, 0, 1, KP(norm_post) + (size_t)(l * 3 + 1) * 1024, modl + 5 * 1024, 1.0f, 1,
                 KP(norm_pre) + (size_t)(l * 3 + 2) * 1024, modl + 6 * 1024, modl + 7 * 1024, Mlate, 1);
      conv_ffn(p, l, 1);
      break;
    case 9:
      gemm_phase<1024, EPI_UP>(XN, (const u16*)(ws + OFF_WB + WB_W13T), Mlate, 5632, U, nullptr);
      break;
    case 10:
      gemm_phase<2816, EPI_Y>(U, (const u16*)(ws + OFF_WB + WB_W2T), NLAT, 1024, Yb, nullptr);
      if (!last)
        gemm_phase<2816, EPI_Y, true>(U, (const u16*)(ws + OFF_WB + WB_W2T), NLAT, 1024, Yb, nullptr, NCTXR / BM,
                                      (float*)(ws + OFF_AR + AR_PART));
      break;
    case 11:
      if (!last) {
        const float* modn = mod + (size_t)(l + 1) * 9 * 9216;
        phase_rows(p, 0, 1, KP(norm_post) + (size_t)(l * 3 + 2) * 1024, modl + 8 * 1024, 0.5f, 1,
                   KP(norm_pre) + (size_t)((l + 1) * 3 + 0) * 1024, modn + 0 * 1024, modn + 1 * 1024, NT, 1);
        conv_ffn(p, l + 1, 0);
      } else {
        phase_rows(p, 0, 1, KP(norm_post) + (size_t)(l * 3 + 2) * 1024, modl + 8 * 1024, 0.5f, 0, nullptr, nullptr,
                   nullptr, NLAT);
      }
      break;
  }
}

#ifndef REP_SCAN
#define REP_SCAN 1
#endif
#ifndef REP_GEMM
#define REP_GEMM 1
#endif
#ifndef REP_PREP
#define REP_PREP 1
#endif
#ifndef REP_POST
#define REP_POST 1
#endif
DEV int phase_reps(int ph) {
  if (ph < 2) return 1;
  int k = (ph - 2) % 12;
  if (k == 5) return REP_SCAN;
  if (k == 4) return REP_PREP;
  if (k == 6) return REP_POST;
  if (k == 0 || k == 1 || k == 3 || k == 7 || k == 9 || k == 10) return REP_GEMM;
  return 1;
}
DEV void grid_barrier(unsigned* ctr, unsigned target) {
  asm volatile("s_waitcnt vmcnt(0)" ::: "memory");
  __syncthreads();
  if (threadIdx.x == 0) {
    __builtin_amdgcn_fence(__ATOMIC_RELEASE, "agent");
    asm volatile("s_waitcnt vmcnt(0)" ::: "memory");
    __hip_atomic_fetch_add(ctr, 1u, __ATOMIC_RELAXED, __HIP_MEMORY_SCOPE_AGENT);
    while (__hip_atomic_load(ctr, __ATOMIC_RELAXED, __HIP_MEMORY_SCOPE_AGENT) < target) __builtin_amdgcn_s_sleep(1);
    __builtin_amdgcn_fence(__ATOMIC_ACQUIRE, "agent");
    asm volatile("s_waitcnt vmcnt(0)" ::: "memory");
  }
  __syncthreads();
}

__global__ void __launch_bounds__(NTHREADS, 2) mega_kernel(Params params_, int ph_lo, int ph_hi) {
  PTag p;
  cg::grid_group grid = cg::this_grid();
  unsigned* bar = (unsigned*)(KWS + OFF_BAR);
  if (blockIdx.x == 0 && threadIdx.x == 0) __hip_atomic_store(bar, 0u, __ATOMIC_RELAXED, __HIP_MEMORY_SCOPE_AGENT);
  unsigned nsync = 0;
  for (int ph = ph_lo; ph < ph_hi; ++ph) {
    const int reps = phase_reps(ph);
    for (int r = 0; r < reps; ++r) {
      if (ph > ph_lo || r > 0) {
        if (nsync == 0) grid.sync();
        else grid_barrier(bar, nsync * gridDim.x);
        ++nsync;
      }
      run_phase(p, ph, r);
    }
  }
}

extern "C" void kernel_launch(void* const* d_in, const int* in_sizes, int n_in, void* d_out, int out_size, void* d_ws,
                              size_t ws_size, hipStream_t stream) {
  static int grid_blocks = 0;
  if (!grid_blocks) {
    int dev = 0, cus = 0, per_cu = 0;
    hipGetDevice(&dev);
    hipDeviceGetAttribute(&cus, hipDeviceAttributeMultiprocessorCount, dev);
    hipFuncSetAttribute((const void*)mega_kernel, hipFuncAttributeMaxDynamicSharedMemorySize, (int)SMEM_BYTES);
    hipOccupancyMaxActiveBlocksPerMultiprocessor(&per_cu, mega_kernel, NTHREADS, SMEM_BYTES);
    if (per_cu < 1) per_cu = 1;
    grid_blocks = cus * per_cu;
    if (ws_size < WS_TOTAL) fprintf(stderr, "workspace too small: %zu < %zu\n", ws_size, (size_t)WS_TOTAL);
  }
  Params p{};
  const float** pp = (const float**)&p;
  for (int i = 0; i < 34; ++i) pp[i] = (const float*)d_in[i];
  p.out = (float*)d_out;
  p.ws = (char*)d_ws;
#ifdef MULTI_LAUNCH
  for (int ph = 0; ph < NPHASES; ++ph) {
    hipLaunchKernelGGL(mega_kernel, dim3(grid_blocks), dim3(NTHREADS), SMEM_BYTES, stream, p, ph, ph + 1);
  }
#else
  int lo = 0, hi = NPHASES;
  void* args[] = {&p, &lo, &hi};
  hipError_t e = hipLaunchCooperativeKernel((const void*)mega_kernel, dim3(grid_blocks), dim3(NTHREADS), args,
                                            SMEM_BYTES, stream);
  if (e != hipSuccess) fprintf(stderr, "cooperative launch failed: %s (grid %d)\n", hipGetErrorString(e), grid_blocks);
#endif
}
```

```cpp
#include <hip/hip_runtime.h>
#include <hip/hip_cooperative_groups.h>
#include <cstdio>
namespace cg = cooperative_groups;
#define SCAN_PROBE_MODE 0

typedef unsigned short u16;
using bf16x8 = __attribute__((ext_vector_type(8))) short;
using f32x4 = __attribute__((ext_vector_type(4))) float;

#define DEV __device__ __forceinline__

constexpr int NLAT = 32768, NCTXR = 2048, NT = 34816;
constexpr int DM = 1024, DFF = 2816, PIN = 3232, PINP = 3328;
constexpr int Z1W = 1696, Z2W = 1536;
constexpr int NTHREADS = 512;
constexpr size_t SMEM_BYTES = 131072;

constexpr size_t OFF_MOD = 0;
constexpr size_t SZ_MOD = 4ull * 9 * 9216 * 4;
constexpr size_t OFF_HC = OFF_MOD + SZ_MOD;
constexpr size_t SZ_HC = 2048ull * 1024 * 4;
constexpr size_t OFF_INVN = OFF_HC + SZ_HC;
constexpr size_t SZ_INVN = (size_t)NT * 8 * 4;
constexpr size_t OFF_WB = OFF_INVN + SZ_INVN;
constexpr size_t SZ_WB = 5632ull * 1024 * 2 + 1024ull * 2816 * 2;
constexpr size_t OFF_XN = OFF_WB + SZ_WB;
constexpr size_t SZ_XN = (size_t)NT * 1024 * 2;
constexpr size_t OFF_Y = OFF_XN + SZ_XN;
constexpr size_t SZ_Y = SZ_XN;
constexpr size_t OFF_AR = OFF_Y + SZ_Y;
constexpr size_t SZ_384 = (size_t)NT * 384 * 2;
constexpr size_t SZ_256 = (size_t)NT * 256 * 2;
constexpr size_t SZ_192 = (size_t)NT * 192 * 2;
constexpr size_t AR_Z1 = 0;
constexpr size_t AR_Z2 = AR_Z1 + (size_t)NT * Z1W * 2;
constexpr size_t AR_RWP = AR_Z2 + (size_t)NT * Z2W * 2;
constexpr size_t AR_LA = AR_RWP + 7 * SZ_384;
constexpr size_t SZ_AR = AR_LA + 2 * SZ_192;
constexpr size_t AR_PART = 201326592;
constexpr size_t OFF_BAR = OFF_AR + SZ_AR;
constexpr size_t WS_TOTAL = OFF_BAR + 256;
constexpr size_t WB_W13T = 0;
constexpr size_t WB_W2T = 5632ull * 1024 * 2;
constexpr size_t WB_WINT = 0;
constexpr size_t WB_WOUTT = WB_WINT + 3328ull * 1024 * 2;
constexpr size_t WB_RWW2T = WB_WOUTT + 1024ull * 1024 * 2;
constexpr size_t WB_RWA2T = WB_RWW2T + 2ull * 384 * 64 * 2;
constexpr size_t WB_RWG2T = WB_RWA2T + 2ull * 384 * 64 * 2;
constexpr size_t WB_RGGT = WB_RWG2T + 384ull * 128 * 2;
constexpr size_t WB_GLAT = WB_RGGT + 16ull * 64 * 64 * 2;

struct Params {
  const float *x, *c, *ctx, *c_ctx, *w_mod, *b_mod, *norm_pre, *norm_post, *ffn_w1, *ffn_w3, *ffn_w2, *w_in, *w_out,
      *rg_conv_w, *rg_conv_b, *rg_gate_a_w, *rg_gate_a_b, *rg_gate_x_w, *rg_gate_x_b, *rg_lambda,
      *gla_alpha_w2, *gla_alpha_b, *gla_norm, *rw_mu, *rw_w0, *rw_w2, *rw_a0, *rw_a2, *rw_g2, *rw_k_k, *rw_k_a,
      *rw_r_k, *rw_ln_w, *rw_ln_b;
  float* out;
  char* ws;
};

extern __shared__ __attribute__((aligned(16))) char g_smem[];

DEV const float* kparg(int off) {
  const char __attribute__((address_space(4)))* kp =
      (const char __attribute__((address_space(4)))*)__builtin_amdgcn_kernarg_segment_ptr();
  return *(const float* volatile const __attribute__((address_space(4)))*)(kp + off);
}
#define KP(name) kparg((int)__builtin_offsetof(Params, name))
#define KWS ((char*)kparg((int)__builtin_offsetof(Params, ws)))
#define KOUT ((float*)kparg((int)__builtin_offsetof(Params, out)))
struct PTag {};

DEV int my_tid() {
  int t = threadIdx.x;
  asm volatile("" : "+v"(t));
  return t;
}
DEV int my_bid() {
  int b = blockIdx.x;
  asm volatile("" : "+s"(b));
  return b;
}
DEV float bf2f(u16 u) { return __uint_as_float(((unsigned)u) << 16); }
typedef float v2f_ __attribute__((ext_vector_type(2)));
typedef __bf16 v2bf_ __attribute__((ext_vector_type(2)));
DEV unsigned pack2(float a, float b) {
  v2f_ f = {a, b};
  v2bf_ h = __builtin_convertvector(f, v2bf_);
  return __builtin_bit_cast(unsigned, h);
}
DEV u16 f2bf(float f) { return (u16)(pack2(f, 0.f) & 0xffffu); }
DEV float lo2f(unsigned u) { return __uint_as_float(u << 16); }
DEV float hi2f(unsigned u) { return __uint_as_float(u & 0xffff0000u); }
DEV float wave_sum(float v);
DEV float sigmoidf_(float x) { return __builtin_amdgcn_rcpf(1.f + __expf(-x)); }
DEV float siluf_(float x) { return x * __builtin_amdgcn_rcpf(1.f + __expf(-x)); }
DEV float tanhf_(float x) { return 1.f - 2.f * __builtin_amdgcn_rcpf(1.f + __expf(2.f * x)); }
DEV float log_sigmoidf_(float x) { return fminf(x, 0.f) - __logf(1.f + __expf(-fabsf(x))); }
template <int CTRL>
DEV float dpp_f(float x) {
  return __int_as_float(__builtin_amdgcn_update_dpp(0, __float_as_int(x), CTRL, 0xf, 0xf, true));
}
DEV float quad_sum(float x) {
  x += dpp_f<0xB1>(x);
  x += dpp_f<0x4E>(x);
  return x;
}
DEV float oct_sum(float x) {
  x = quad_sum(x);
  x += dpp_f<0x141>(x);
  return x;
}
DEV float wave_sum(float x) {
  x = quad_sum(x);
  x += dpp_f<0x141>(x);
  x += dpp_f<0x140>(x);
  float r0 = __int_as_float(__builtin_amdgcn_readlane(__float_as_int(x), 0));
  float r1 = __int_as_float(__builtin_amdgcn_readlane(__float_as_int(x), 16));
  float r2 = __int_as_float(__builtin_amdgcn_readlane(__float_as_int(x), 32));
  float r3 = __int_as_float(__builtin_amdgcn_readlane(__float_as_int(x), 48));
  return (r0 + r1) + (r2 + r3);
}
DEV int seq_row(int b, int dir, int s) {
  if (s < 256) {
    int t = dir ? 255 - s : s;
    return NLAT + b * 256 + t;
  }
  int t = s - 256;
  t = dir ? 4095 - t : t;
  return b * 4096 + t;
}

DEV void phase_adaln(PTag p) {
  const int ltid = my_tid();
  const int lbid = my_bid();
  (void)ltid; (void)lbid;
  float* sc = (float*)g_smem;
  float* red = sc + 9 * 1024;
  float* mod = (float*)(KWS + OFF_MOD);
  const int tid = ltid;
  for (int i = tid; i < 9 * 1024; i += NTHREADS) {
    int m = i >> 10, k = i & 1023;
    float v = (m < 8) ? KP(c)[m * 1024 + k] : KP(c_ctx)[k];
    sc[i] = siluf_(v);
  }
  __syncthreads();
  for (int job = lbid; job < 256; job += gridDim.x) {
    int l = job >> 6, j0 = (job & 63) * 144;
    const float* W = KP(w_mod) + (size_t)l * 1024 * 9216;
    int cgp = tid % 36, ig = tid / 36;
    if (tid < 504) {
      float acc[9][4];
#pragma unroll
      for (int m = 0; m < 9; ++m)
#pragma unroll
        for (int q = 0; q < 4; ++q) acc[m][q] = 0.f;
#pragma unroll 4
      for (int i = ig; i < 1024; i += 14) {
        const f32x4 wv_ = __builtin_nontemporal_load((const f32x4*)(W + (size_t)i * 9216 + j0 + cgp * 4));
        float4 w4 = make_float4(wv_[0], wv_[1], wv_[2], wv_[3]);
#pragma unroll
        for (int m = 0; m < 9; ++m) {
          float s = sc[m * 1024 + i];
          acc[m][0] += s * w4.x;
          acc[m][1] += s * w4.y;
          acc[m][2] += s * w4.z;
          acc[m][3] += s * w4.w;
        }
      }
#pragma unroll
      for (int m = 0; m < 9; ++m)
#pragma unroll
        for (int q = 0; q < 4; ++q) red[(ig * 9 + m) * 144 + cgp * 4 + q] = acc[m][q];
    }
    __syncthreads();
    for (int o = tid; o < 9 * 144; o += NTHREADS) {
      int m = o / 144, cc = o % 144;
      float s = KP(b_mod)[l * 9216 + j0 + cc];
#pragma unroll
      for (int g = 0; g < 14; ++g) s += red[(g * 9 + m) * 144 + cc];
      mod[(size_t)(l * 9 + m) * 9216 + j0 + cc] = s;
    }
    __syncthreads();
  }
}

DEV void conv_job(const float* srcA, const float* srcB, int interleave, int ld, int Kvalid, int Nvalid, u16* dst,
                  int Kdst, int Ndst, int& tb) {
  const int ltid = my_tid();
  const int lbid = my_bid();
  float* tile = (float*)g_smem;
  const int tid = ltid;
  int tk = (Kdst + 63) / 64, nt = (Ndst / 64) * tk;
  int G = gridDim.x;
  int start = (((int)lbid - (tb % G)) % G + G) % G;
  tb += nt;
  if (start >= nt) return;
  const int nl = tid & 63;
  auto loadt = [&](int t, float (&v)[8]) __attribute__((always_inline)) {
    int nn0 = (t / tk) * 64, k0 = (t % tk) * 64;
    int nn = nn0 + nl;
    const float* src;
    int col;
    bool nv;
    if (interleave) {
      int g = nn >> 5, w = nn & 31;
      col = g * 16 + (w & 15);
      src = (w < 16) ? srcA : srcB;
      nv = true;
    } else {
      col = nn;
      src = srcA;
      nv = nn < Nvalid;
    }
#pragma unroll
    for (int pass = 0; pass < 8; ++pass) {
      int k = k0 + pass * 8 + (tid >> 6);
      v[pass] = (nv && k < Kvalid) ? __builtin_nontemporal_load(src + (size_t)k * ld + col) : 0.f;
    }
  };
  float cur[8];
  loadt(start, cur);
  for (int t = start; t < nt; t += G) {
    float nxt[8];
    loadt((t + G < nt) ? t + G : t, nxt);
    int nn0 = (t / tk) * 64, k0 = (t % tk) * 64;
#pragma unroll
    for (int pass = 0; pass < 8; ++pass) tile[nl * 65 + pass * 8 + (tid >> 6)] = cur[pass];
    __syncthreads();
    {
      int nl2 = tid >> 3, kc = tid & 7;
      int k = k0 + kc * 8;
      if (k < Kdst) {
        const float* tp = tile + nl2 * 65 + kc * 8;
        uint4 o;
        o.x = pack2(tp[0], tp[1]);
        o.y = pack2(tp[2], tp[3]);
        o.z = pack2(tp[4], tp[5]);
        o.w = pack2(tp[6], tp[7]);
        *(uint4*)(dst + (size_t)(nn0 + nl2) * Kdst + k) = o;
      }
    }
    __syncthreads();
#pragma unroll
    for (int pass = 0; pass < 8; ++pass) cur[pass] = nxt[pass];
  }
}

DEV void conv_ffn(PTag p, int l, int f) {
  int tb = 0;
  u16* wb = (u16*)(KWS + OFF_WB);
  size_t o13 = ((size_t)(l * 2 + f)) * 1024 * 2816;
  conv_job(KP(ffn_w1) + o13, KP(ffn_w3) + o13, 1, 2816, 1024, 5632, (u16*)((char*)wb + WB_W13T), 1024, 5632, tb);
  conv_job(KP(ffn_w2) + o13, nullptr, 0, 1024, 2816, 1024, (u16*)((char*)wb + WB_W2T), 2816, 1024, tb);
}
DEV void conv_mixer(PTag p, int l) {
  int tb = 0;
  char* wb = KWS + OFF_WB;
  conv_job(KP(w_in) + (size_t)l * 1024 * PIN, nullptr, 0, PIN, 1024, PIN, (u16*)(wb + WB_WINT), 1024, PINP, tb);
  conv_job(KP(w_out) + (size_t)l * 1024 * 1024, nullptr, 0, 1024, 1024, 1024, (u16*)(wb + WB_WOUTT), 1024, 1024, tb);
  for (int d = 0; d < 2; ++d) {
    conv_job(KP(rw_w2) + (size_t)(l * 2 + d) * 64 * 384, nullptr, 0, 384, 64, 384, (u16*)(wb + WB_RWW2T) + d * 384 * 64, 64,
             384, tb);
    conv_job(KP(rw_a2) + (size_t)(l * 2 + d) * 64 * 384, nullptr, 0, 384, 64, 384, (u16*)(wb + WB_RWA2T) + d * 384 * 64, 64,
             384, tb);
    conv_job(KP(gla_alpha_w2) + (size_t)(l * 2 + d) * 16 * 192, nullptr, 0, 192, 16, 192, (u16*)(wb + WB_GLAT) + d * 192 * 32,
             32, 192, tb);
    for (int h = 0; h < 4; ++h) {
      conv_job(KP(rg_gate_a_w) + (size_t)((l * 2 + d) * 4 + h) * 4096, nullptr, 0, 64, 64, 64,
               (u16*)(wb + WB_RGGT) + ((d * 2 + 0) * 4 + h) * 4096, 64, 64, tb);
      conv_job(KP(rg_gate_x_w) + (size_t)((l * 2 + d) * 4 + h) * 4096, nullptr, 0, 64, 64, 64,
               (u16*)(wb + WB_RGGT) + ((d * 2 + 1) * 4 + h) * 4096, 64, 64, tb);
    }
  }
  conv_job(KP(rw_g2) + (size_t)l * 128 * 384, nullptr, 0, 384, 128, 384, (u16*)(wb + WB_RWG2T), 128, 384, tb);
}

template <bool SPLITY, int NR>
DEV void phase_rows_t(PTag p, int init, int has_y, const float* gpost, const float* mod_gate, float coef,
                      int has_next, const float* gpre, const float* mod_shift, const float* mod_scale, int rbeg,
                      int rend) {
  const int ltid = my_tid();
  const int lbid = my_bid();
  const int lane = ltid & 63;
  const int gw = lbid * 8 + (ltid >> 6), nw = gridDim.x * 8;
  float* hc = (float*)(KWS + OFF_HC);
  const u16* Y = (const u16*)(KWS + OFF_Y);
  u16* XN = (u16*)(KWS + OFF_XN);
  float* outp = KOUT;
  const float* xin = KP(x);
  const float* cin = KP(ctx);
  float4 gpo[4], gpr[4];
#pragma unroll
  for (int i = 0; i < 4; ++i) {
    gpo[i] = has_y ? ((const float4*)gpost)[lane + 64 * i] : make_float4(0.f, 0.f, 0.f, 0.f);
    gpr[i] = has_next ? ((const float4*)gpre)[lane + 64 * i] : make_float4(0.f, 0.f, 0.f, 0.f);
  }
  for (int row0 = rbeg + gw; row0 < rend; row0 += NR * nw) {
    float4 h[NR][4], g[NR][4], sh[NR][4], sc[NR][4], y[NR][4];
    uint2 yr[NR][4];
    bool valid[NR];
    float* hp[NR];
    int rows[NR];
#pragma unroll
    for (int r = 0; r < NR; ++r) {
      int row = row0 + r * nw;
      valid[r] = row < rend;
      if (!valid[r]) row = row0;
      rows[r] = row;
      int m = row < NLAT ? (row >> 12) : 8;
      hp[r] = row < NLAT ? outp + (size_t)row * 1024 : hc + (size_t)(row - NLAT) * 1024;
      const float* src = hp[r];
      if (init) src = row < NLAT ? xin + (size_t)row * 1024 : cin + (size_t)(row - NLAT) * 1024;
#pragma unroll
      for (int i = 0; i < 4; ++i) {
        const f32x4 hv = __builtin_nontemporal_load((const f32x4*)src + lane + 64 * i);
        h[r][i] = make_float4(hv[0], hv[1], hv[2], hv[3]);
      }
      if (has_y) {
        if (SPLITY) {
          const float4* pr = (const float4*)((const float*)(KWS + OFF_AR + AR_PART) + (size_t)(row - NLAT) * 1024);
#pragma unroll
          for (int i = 0; i < 4; ++i) {
            float4 a = pr[lane + 64 * i], b = pr[(size_t)NCTXR * 256 + lane + 64 * i];
            float4 c = pr[(size_t)2 * NCTXR * 256 + lane + 64 * i], d = pr[(size_t)3 * NCTXR * 256 + lane + 64 * i];
            y[r][i].x = (a.x + b.x) + (c.x + d.x); y[r][i].y = (a.y + b.y) + (c.y + d.y);
            y[r][i].z = (a.z + b.z) + (c.z + d.z); y[r][i].w = (a.w + b.w) + (c.w + d.w);
          }
        } else {
#pragma unroll
          for (int i = 0; i < 4; ++i) yr[r][i] = ((const uint2*)(Y + (size_t)row * 1024))[lane + 64 * i];
        }
#pragma unroll
        for (int i = 0; i < 4; ++i) g[r][i] = ((const float4*)(mod_gate + (size_t)m * 9216))[lane + 64 * i];
      }
      if (has_next) {
#pragma unroll
        for (int i = 0; i < 4; ++i) {
          sh[r][i] = ((const float4*)(mod_shift + (size_t)m * 9216))[lane + 64 * i];
          sc[r][i] = ((const float4*)(mod_scale + (size_t)m * 9216))[lane + 64 * i];
        }
      }
    }
#pragma unroll
    for (int r = 0; r < NR; ++r) {
      if (has_y) {
        float ss = 0.f;
#pragma unroll
        for (int i = 0; i < 4; ++i) {
          if (!SPLITY) {
            uint2 u = yr[r][i];
            y[r][i].x = lo2f(u.x); y[r][i].y = hi2f(u.x); y[r][i].z = lo2f(u.y); y[r][i].w = hi2f(u.y);
          }
          ss += y[r][i].x * y[r][i].x + y[r][i].y * y[r][i].y + y[r][i].z * y[r][i].z + y[r][i].w * y[r][i].w;
        }
        ss = wave_sum(ss);
        float rs = rsqrtf(ss * (1.f / 1024.f) + 1e-6f) * coef;
#pragma unroll
        for (int i = 0; i < 4; ++i) {
          h[r][i].x += g[r][i].x * (y[r][i].x * rs * gpo[i].x);
          h[r][i].y += g[r][i].y * (y[r][i].y * rs * gpo[i].y);
          h[r][i].z += g[r][i].z * (y[r][i].z * rs * gpo[i].z);
          h[r][i].w += g[r][i].w * (y[r][i].w * rs * gpo[i].w);
        }
      }
    }
#pragma unroll
    for (int r = 0; r < NR; ++r) {
      if ((init || has_y) && valid[r]) {
#pragma unroll
        for (int i = 0; i < 4; ++i)
          __builtin_nontemporal_store(f32x4{h[r][i].x, h[r][i].y, h[r][i].z, h[r][i].w}, (f32x4*)hp[r] + lane + 64 * i);
      }
      if (has_next) {
        float ss = 0.f;
#pragma unroll
        for (int i = 0; i < 4; ++i)
          ss += h[r][i].x * h[r][i].x + h[r][i].y * h[r][i].y + h[r][i].z * h[r][i].z + h[r][i].w * h[r][i].w;
        ss = wave_sum(ss);
        float rs = rsqrtf(ss * (1.f / 1024.f) + 1e-6f);
        if (valid[r]) {
#pragma unroll
          for (int i = 0; i < 4; ++i) {
            float a = (h[r][i].x * rs * gpr[i].x) * (1.f + sc[r][i].x) + sh[r][i].x;
            float b = (h[r][i].y * rs * gpr[i].y) * (1.f + sc[r][i].y) + sh[r][i].y;
            float c = (h[r][i].z * rs * gpr[i].z) * (1.f + sc[r][i].z) + sh[r][i].z;
            float d = (h[r][i].w * rs * gpr[i].w) * (1.f + sc[r][i].w) + sh[r][i].w;
            uint2 o;
            o.x = pack2(a, b);
            o.y = pack2(c, d);
            ((uint2*)(XN + (size_t)rows[r] * 1024))[lane + 64 * i] = o;
          }
        }
      }
    }
  }
}
DEV void phase_rows(PTag p, int init, int has_y, const float* gpost, const float* mod_gate, float coef,
                    int has_next, const float* gpre, const float* mod_shift, const float* mod_scale, int Mrows,
                    int ysplit = 0) {
  if (ysplit && Mrows > NLAT) {
    phase_rows_t<false, 2>(p, init, has_y, gpost, mod_gate, coef, has_next, gpre, mod_shift, mod_scale, 0, NLAT);
    phase_rows_t<true, 1>(p, init, has_y, gpost, mod_gate, coef, has_next, gpre, mod_shift, mod_scale, NLAT, Mrows);
  } else {
    phase_rows_t<false, 2>(p, init, has_y, gpost, mod_gate, coef, has_next, gpre, mod_shift, mod_scale, 0, Mrows);
  }
}

constexpr int BM = 256, BK = 64, HALF = 128, HT = HALF * BK;
DEV int lds_byte(int r, int c) {
  int st = (r >> 4) * 2 + (c >> 5), rr = r & 15, cc = c & 31, ob = rr * 64 + cc * 2;
  return st * 1024 + (ob ^ (((ob >> 9) & 1) << 5));
}
DEV void stage_rc(int b, int& R, int& C) {
  int st = b / 1024, sb = b % 1024, swz = sb ^ (((sb >> 9) & 1) << 5);
  R = (st >> 1) * 16 + swz / 64;
  C = (st & 1) * 32 + (swz % 64) / 2;
}
enum { EPI_UP = 0, EPI_Y = 1, EPI_Z = 2 };

template <int K, int EPI, bool SPLIT = false>
DEV void gemm_phase(const u16* __restrict__ A, const u16* __restrict__ Bt, int M, int N, u16* __restrict__ O0,
                    u16* __restrict__ O1, int nsplit_rowtiles = 0, float* __restrict__ Pp = nullptr) {
  const int ltid = my_tid();
  const int lbid = my_bid();
  (void)ltid; (void)lbid;
  u16* shm = (u16*)g_smem;
#define SA(b, h) (shm + ((b) * 2 + (h)) * HT)
#define SB(b, h) (shm + (4 + (b) * 2 + (h)) * HT)
#define STAGE(P, GB, kc)                                                                                        \
  do {                                                                                                           \
    __builtin_amdgcn_global_load_lds((const unsigned*)((const char*)(GB) + vb0 + (kc) * (BK * 2)),              \
                                     (unsigned*)((char*)(P) + wbase), 16, 0, 0);                                 \
    __builtin_amdgcn_global_load_lds((const unsigned*)((const char*)(GB) + vb1 + (kc) * (BK * 2)),              \
                                     (unsigned*)((char*)(P) + wbase + 8192), 16, 0, 0);                          \
  } while (0)
#define LDA(dst, b, h)                                                                                 \
  for (int m = 0; m < 4; ++m)                                                                          \
    for (int k = 0; k < 2; ++k)                                                                        \
  dst[m][k] = *reinterpret_cast<const bf16x8*>(aBase + (((b) * 2 + (h)) * 16384 + m * 2048 + k * 1024))
#define LDB(dst, b, h)                                                                                 \
  for (int n = 0; n < 2; ++n)                                                                          \
    for (int k = 0; k < 2; ++k)                                                                        \
  dst[n][k] = *reinterpret_cast<const bf16x8*>(bBase + (((b) * 2 + (h)) * 16384 + n * 2048 + k * 1024))
#define MMA(ai, bj, At_, Bt_)                                                                          \
  do {                                                                                                 \
    __builtin_amdgcn_s_setprio(1);                                                                     \
    for (int m = 0; m < 4; ++m)                                                                        \
      for (int n = 0; n < 2; ++n)                                                                      \
        for (int k = 0; k < 2; ++k)                                                                    \
          acc[ai][bj][m][n] =                                                                          \
              __builtin_amdgcn_mfma_f32_16x16x32_bf16(At_[m][k], Bt_[n][k], acc[ai][bj][m][n], 0, 0, 0); \
    __builtin_amdgcn_s_setprio(0);                                                                     \
  } while (0)
#define WAIT_V(n) asm volatile("s_waitcnt vmcnt(" #n ")" ::: "memory")
#define WAIT_L(n) asm volatile("s_waitcnt lgkmcnt(" #n ")" ::: "memory")
#define BAR __builtin_amdgcn_s_barrier()
#define SCHED __builtin_amdgcn_sched_barrier(0)

  const int tid = ltid;
  const int tid16 = tid * 16;
  unsigned off0, off1;
  {
    int r, c;
    stage_rc(tid16, r, c);
    off0 = (unsigned)(r * K + c) * 2u;
    stage_rc(tid16 + 8192, r, c);
    off1 = (unsigned)(r * K + c) * 2u;
  }
  const int wbase = __builtin_amdgcn_readfirstlane(tid >> 6) * 1024;
  const int wid = tid >> 6, lane = tid & 63, wr = wid >> 2, wc = wid & 3, fr = lane & 15, fq = lane >> 4;
  const int nM = M / BM, nN = N / BM, nwg = nM * nN;
  const int lo_ = lds_byte(fr, fq * 8);
  const char* aBase = (const char*)g_smem + wr * 8192 + lo_;
  const char* bBase = (const char*)g_smem + 65536 + wc * 4096 + lo_;
  constexpr int WGM = 8;
  const int nitems = SPLIT ? nsplit_rowtiles * nN * 4 : nwg;
  const int lb2 = SPLIT ? (lbid + 128) % (int)gridDim.x : lbid;
  for (int tix = lb2; tix < nitems; tix += gridDim.x) {
    int brow, bcol, nt, kbeg, schunk;
    if (!SPLIT) {
      int wgid = tix;
      {
        int q = nwg / 8, r = nwg % 8, xcd = wgid % 8, off = wgid / 8;
        wgid = (xcd < r ? xcd * (q + 1) : r * (q + 1) + (xcd - r) * q) + off;
      }
      int nig = WGM * nN, gid = wgid / nig, fm = gid * WGM, gsz = min(nM - fm, WGM);
      int pm = fm + ((wgid % nig) % gsz), pn = (wgid % nig) / gsz;
      brow = pm * BM;
      bcol = pn * BM;
      nt = K / BK;
      kbeg = 0;
      schunk = -1;
    } else {
      schunk = tix & 3;
      int ct = tix >> 2;
      brow = M + (ct / nN) * BM;
      bcol = (ct % nN) * BM;
      constexpr int q4 = ((K / BK) / 8) * 2;
      kbeg = (schunk < 2) ? schunk * q4 : 2 * q4 + (schunk - 2) * ((K / BK - 2 * q4) / 2);
      nt = (schunk < 2) ? q4 : (K / BK - 2 * q4) / 2;
    }
    f32x4 acc[2][2][4][2];
#pragma unroll
    for (int a = 0; a < 2; ++a)
#pragma unroll
      for (int b = 0; b < 2; ++b)
#pragma unroll
        for (int m = 0; m < 4; ++m)
#pragma unroll
          for (int n = 0; n < 2; ++n) acc[a][b][m][n] = f32x4{0.f, 0.f, 0.f, 0.f};
    bf16x8 At[4][2], B0[2][2], B1[2][2];
    const u16* gA0 = A + (size_t)brow * K + kbeg * BK;
    const u16* gA1 = gA0 + (size_t)HALF * K;
    const u16* gB0 = Bt + (size_t)bcol * K + kbeg * BK;
    const u16* gB1 = gB0 + (size_t)HALF * K;
    unsigned vb0 = off0, vb1 = off1;
    STAGE(SB(0, 0), gB0, 0);
    STAGE(SA(0, 0), gA0, 0);
    STAGE(SB(0, 1), gB1, 0);
    STAGE(SA(0, 1), gA1, 0);
    if (wr == 1) BAR;
    WAIT_V(4);
    BAR;
    STAGE(SB(1, 0), gB0, 1);
    STAGE(SA(1, 0), gA0, 1);
    STAGE(SB(1, 1), gB1, 1);
    WAIT_V(6);
    BAR;
#pragma unroll 1
    for (int t = 0; t < nt - 2; t += 2, vb0 += 2 * BK * 2, vb1 += 2 * BK * 2) {
      LDB(B0, 0, 0); SCHED; LDA(At, 0, 0); STAGE(SA(1, 1), gA1, 1);
      WAIT_L(8); BAR; WAIT_L(0); MMA(0, 0, At, B0); BAR; SCHED;
      LDB(B1, 0, 1); STAGE(SB(0, 0), gB0, 2);
      BAR; WAIT_L(0); MMA(0, 1, At, B1); BAR;
      LDA(At, 0, 1); STAGE(SA(0, 0), gA0, 2);
      BAR; WAIT_L(0); MMA(1, 0, At, B0); BAR; SCHED;
      STAGE(SB(0, 1), gB1, 2);
      WAIT_V(6); BAR; MMA(1, 1, At, B1); BAR;
      LDB(B0, 1, 0); SCHED; LDA(At, 1, 0); STAGE(SA(0, 1), gA1, 2);
      WAIT_L(8); BAR; WAIT_L(0); MMA(0, 0, At, B0); BAR; SCHED;
      LDB(B1, 1, 1); STAGE(SB(1, 0), gB0, 3);
      BAR; WAIT_L(0); MMA(0, 1, At, B1); BAR;
      LDA(At, 1, 1); STAGE(SA(1, 0), gA0, 3);
      BAR; WAIT_L(0); MMA(1, 0, At, B0); BAR; SCHED;
      STAGE(SB(1, 1), gB1, 3);
      WAIT_V(6); BAR; MMA(1, 1, At, B1); BAR;
    }
    {
      LDB(B0, 0, 0); LDA(At, 0, 0); STAGE(SA(1, 1), gA1, 1);
      BAR; WAIT_L(0); MMA(0, 0, At, B0); BAR;
      LDB(B1, 0, 1); BAR; WAIT_L(0); MMA(0, 1, At, B1); BAR;
      LDA(At, 0, 1); WAIT_V(4); BAR; WAIT_L(0); MMA(1, 0, At, B0); MMA(1, 1, At, B1); BAR;
    }
    {
      LDB(B0, 1, 0); LDA(At, 1, 0); WAIT_V(2); BAR; WAIT_L(0); MMA(0, 0, At, B0); BAR;
      LDB(B1, 1, 1); WAIT_V(0); BAR; WAIT_L(0); MMA(0, 1, At, B1); BAR;
      LDA(At, 1, 1); BAR; WAIT_L(0); MMA(1, 0, At, B0); MMA(1, 1, At, B1); BAR;
    }
    if (wr == 0) BAR;
#pragma unroll
    for (int ai = 0; ai < 2; ++ai)
#pragma unroll
      for (int bj = 0; bj < 2; ++bj)
#pragma unroll
        for (int m = 0; m < 4; ++m) {
          int rowb = brow + ai * HALF + wr * 64 + m * 16 + fq * 4;
          if (EPI == EPI_UP) {
            int hcol = ((bcol + bj * HALF + wc * 32) >> 1) + fr;
#pragma unroll
            for (int j = 0; j < 4; ++j) {
              float a = acc[ai][bj][m][0][j], b = acc[ai][bj][m][1][j];
              O0[(size_t)(rowb + j) * DFF + hcol] = f2bf(siluf_(a) * b);
            }
          } else {
#pragma unroll
            for (int n = 0; n < 2; ++n) {
              int col = bcol + bj * HALF + wc * 32 + n * 16 + fr;
#pragma unroll
              for (int j = 0; j < 4; ++j) {
                float v = acc[ai][bj][m][n][j];
                if (EPI == EPI_Y) {
                  if (!SPLIT) O0[(size_t)(rowb + j) * DM + col] = f2bf(v);
                  else Pp[((size_t)schunk * NCTXR + (size_t)(rowb + j - M)) * DM + col] = v;
                } else {
                  if (col < Z1W) O0[(size_t)(rowb + j) * Z1W + col] = f2bf(v);
                  else if (col < PIN) O1[(size_t)(rowb + j) * Z2W + (col - Z1W)] = f2bf(v);
                }
              }
            }
          }
        }
  }
#undef SA
#undef SB
#undef STAGE
#undef LDA
#undef LDB
#undef MMA
}

DEV bf16x8 ld_frag_g(const u16* p) { return *reinterpret_cast<const bf16x8*>(p); }
DEV bf16x8 ld_frag_s(const u16* p) { return *reinterpret_cast<const bf16x8*>(p); }

constexpr int ALD = 392;
constexpr int XLD = 264;
constexpr int GLD = 40;

DEV void phase_prep(PTag p, int l) {
  const int ltid = my_tid();
  const int lbid = my_bid();
  (void)ltid; (void)lbid;
  const int tid = ltid, lane = tid & 63, wid = tid >> 6;
  const int fr = lane & 15, fq = lane >> 4;
  char* ar = KWS + OFF_AR;
  const u16* Z1 = (const u16*)(ar + AR_Z1);
  const u16* Z2 = (const u16*)(ar + AR_Z2);
  u16* RWP = (u16*)(ar + AR_RWP);
  u16* LA = (u16*)(ar + AR_LA);
  float* invn = (float*)(KWS + OFF_INVN);
  u16* Gout = (u16*)(KWS + OFF_Y);
  u16* RGP = (u16*)(KWS + OFF_XN);
  const char* wb = KWS + OFF_WB;
  u16* A_lds = (u16*)g_smem;
  u16* X_lds = (u16*)(g_smem + 50176);
  u16* Gl_lds = (u16*)(g_smem + 50176 + 33792);
  const float* mu = KP(rw_mu) + (size_t)l * 1536;
  const float* k_k = KP(rw_k_k) + (size_t)l * 384;

  const int Gp = gridDim.x;
  const int swz = (Gp % 8 == 0) ? (lbid % 8) * (Gp / 8) + lbid / 8 : lbid;
  for (int base = 0; base < NLAT / 64 + NCTXR / 32; base += Gp) {
    const int tile = base + ((base + Gp <= NLAT / 64) ? swz : lbid);
    if (tile >= NLAT / 64 + NCTXR / 32) continue;
    const int nrows = tile < NLAT / 64 ? 64 : 32;
    const int r0 = tile < NLAT / 64 ? tile * 64 : NLAT + (tile - NLAT / 64) * 32;
    const int nmt = nrows >> 4;
    const bool lat = r0 < NLAT;
    const int tpos0 = lat ? (r0 & 4095) : ((r0 - NLAT) & 255);
    const int seglen = lat ? 4096 : 256;
    for (int it0 = 0; it0 < (nrows * 192) / NTHREADS; it0 += 4) {
      uint4 own[4], n0[4], n1[4], n2[4], n3[4];
#pragma unroll
      for (int b4 = 0; b4 < 4; ++b4) {
        int q = (it0 + b4) * NTHREADS + tid;
        int i = q / 192, cc = q % 192, c0 = cc * 8;
        int row = r0 + i, tpos = tpos0 + i;
        const u16* zr = Z2 + (size_t)row * Z2W + c0;
        uint4 z4 = {0u, 0u, 0u, 0u};
        own[b4] = *(const uint4*)zr;
        n0[b4] = z4; n1[b4] = z4; n2[b4] = z4; n3[b4] = z4;
        if (lat) {
          int gcol = tpos & 63, grow = tpos >> 6;
          if (gcol > 0) n0[b4] = *(const uint4*)(zr - Z2W);
          if (gcol < 63) n1[b4] = *(const uint4*)(zr + Z2W);
          if (grow > 0) n2[b4] = *(const uint4*)(zr - 64 * Z2W);
          if (grow < 63) n3[b4] = *(const uint4*)(zr + 64 * Z2W);
        } else {
          if (tpos > 0) n0[b4] = *(const uint4*)(zr - Z2W);
          if (tpos < 255) n1[b4] = *(const uint4*)(zr + Z2W);
          n2[b4] = n0[b4];
          n3[b4] = n1[b4];
        }
      }
#pragma unroll
      for (int b4 = 0; b4 < 4; ++b4) {
        int q = (it0 + b4) * NTHREADS + tid;
        int i = q / 192, cc = q % 192, c0 = cc * 8;
        int row = r0 + i;
        float4 mu0 = *(const float4*)(mu + c0), mu1 = *(const float4*)(mu + c0 + 4);
        float f[8];
        {
          float o0 = lo2f(own[b4].x), o1 = hi2f(own[b4].x), o2 = lo2f(own[b4].y), o3 = hi2f(own[b4].y);
          float o4 = lo2f(own[b4].z), o5 = hi2f(own[b4].z), o6 = lo2f(own[b4].w), o7 = hi2f(own[b4].w);
          float s0 = lo2f(n0[b4].x), s1 = hi2f(n1[b4].x), s2 = lo2f(n2[b4].y), s3 = hi2f(n3[b4].y);
          float s4 = lo2f(n0[b4].z), s5 = hi2f(n1[b4].z), s6 = lo2f(n2[b4].w), s7 = hi2f(n3[b4].w);
          f[0] = o0 + mu0.x * (s0 - o0);
          f[1] = o1 + mu0.y * (s1 - o1);
          f[2] = o2 + mu0.z * (s2 - o2);
          f[3] = o3 + mu0.w * (s3 - o3);
          f[4] = o4 + mu1.x * (s4 - o4);
          f[5] = o5 + mu1.y * (s5 - o5);
          f[6] = o6 + mu1.z * (s6 - o6);
          f[7] = o7 + mu1.w * (s7 - o7);
        }
        if (c0 < 1152) {
          int arr = c0 / 384, cin = c0 % 384;
          uint4 o;
          o.x = pack2(f[0], f[1]); o.y = pack2(f[2], f[3]); o.z = pack2(f[4], f[5]); o.w = pack2(f[6], f[7]);
          *(uint4*)(RWP + (size_t)arr * NT * 384 + (size_t)row * 384 + cin) = o;
          if (arr == 1) {
            float4 kk0 = *(const float4*)(k_k + cin), kk1 = *(const float4*)(k_k + cin + 4);
            float a0 = f[0] * kk0.x, a1 = f[1] * kk0.y, a2 = f[2] * kk0.z, a3 = f[3] * kk0.w;
            float a4 = f[4] * kk1.x, a5 = f[5] * kk1.y, a6 = f[6] * kk1.z, a7 = f[7] * kk1.w;
            float ss = a0 * a0 + a1 * a1 + a2 * a2 + a3 * a3 + a4 * a4 + a5 * a5 + a6 * a6 + a7 * a7;
            ss = oct_sum(ss);
            if ((lane & 7) == 0) invn[(size_t)row * 8 + (cin >> 6)] = 1.f / fmaxf(sqrtf(ss), 1e-12f);
          }
        } else {
          int cl = c0 - 1152;
          if (cl < 128) {
#pragma unroll
            for (int e = 0; e < 8; ++e) f[e] = tanhf_(f[e]);
          } else if (cl >= 256) {
#pragma unroll
            for (int e = 0; e < 8; ++e) f[e] = sigmoidf_(f[e]);
          }
          uint4 o;
          o.x = pack2(f[0], f[1]); o.y = pack2(f[2], f[3]); o.z = pack2(f[4], f[5]); o.w = pack2(f[6], f[7]);
          *(uint4*)(A_lds + i * ALD + cl) = o;
        }
      }
    }
    {
      const float* cw = KP(rg_conv_w) + (size_t)l * 4 * 256;
      const float* cb = KP(rg_conv_b) + (size_t)l * 256;
      for (int it = 0; it < nrows / 16; ++it) {
        int q = it * NTHREADS + tid;
        int i = q >> 5, c0 = (q & 31) * 8;
        int row = r0 + i, tpos = tpos0 + i;
        float accv[8];
        {
          float4 b0 = *(const float4*)(cb + c0), b1 = *(const float4*)(cb + c0 + 4);
          accv[0] = b0.x; accv[1] = b0.y; accv[2] = b0.z; accv[3] = b0.w;
          accv[4] = b1.x; accv[5] = b1.y; accv[6] = b1.z; accv[7] = b1.w;
        }
#pragma unroll
        for (int j = 0; j < 4; ++j) {
          int tt = tpos + j - 2;
          if (tt >= 0 && tt < seglen) {
            uint4 xv = *(const uint4*)(Z1 + (size_t)(row + j - 2) * Z1W + c0);
            float4 w0 = *(const float4*)(cw + j * 256 + c0), w1 = *(const float4*)(cw + j * 256 + c0 + 4);
            accv[0] += w0.x * lo2f(xv.x); accv[1] += w0.y * hi2f(xv.x);
            accv[2] += w0.z * lo2f(xv.y); accv[3] += w0.w * hi2f(xv.y);
            accv[4] += w1.x * lo2f(xv.z); accv[5] += w1.y * hi2f(xv.z);
            accv[6] += w1.z * lo2f(xv.w); accv[7] += w1.w * hi2f(xv.w);
          }
        }
        uint4 o;
        o.x = pack2(accv[0], accv[1]); o.y = pack2(accv[2], accv[3]);
        o.z = pack2(accv[4], accv[5]); o.w = pack2(accv[6], accv[7]);
        *(uint4*)(X_lds + i * XLD + c0) = o;
      }
      {
        int q = tid;
        int i = q >> 3, d = (q >> 2) & 1, ch = q & 3;
        uint4 o = {0u, 0u, 0u, 0u};
        if (ch < 2 && i < nrows) o = *(const uint4*)(Z1 + (size_t)(r0 + i) * Z1W + 1664 + d * 16 + ch * 8);
        *(uint4*)(Gl_lds + (d * 64 + i) * GLD + ch * 8) = o;
      }
    }
    __syncthreads();
    for (int u = wid; u < 120; u += 8) {
      int g = u / 24, ntile = u % 24, n0 = ntile * 16;
      int n = n0 + fr;
      int nc = n0 + fq * 4;
      f32x4 acc[4];
#pragma unroll
      for (int m = 0; m < 4; ++m) acc[m] = f32x4{0.f, 0.f, 0.f, 0.f};
      if (g < 4) {
        const u16* Bt = (const u16*)(wb + ((g < 2) ? WB_RWW2T : WB_RWA2T)) + (size_t)(g & 1) * 384 * 64;
        bf16x8 b0 = ld_frag_g(Bt + (size_t)n * 64 + fq * 8), b1 = ld_frag_g(Bt + (size_t)n * 64 + 32 + fq * 8);
#pragma unroll
        for (int m = 0; m < 4; ++m) if (m < nmt) {
          const u16* ap = A_lds + (m * 16 + fr) * ALD + g * 64 + fq * 8;
          acc[m] = __builtin_amdgcn_mfma_f32_16x16x32_bf16(b0, ld_frag_s(ap), acc[m], 0, 0, 0);
          acc[m] = __builtin_amdgcn_mfma_f32_16x16x32_bf16(b1, ld_frag_s(ap + 32), acc[m], 0, 0, 0);
        }
      } else {
        const u16* Bt = (const u16*)(wb + WB_RWG2T);
        bf16x8 b[4];
#pragma unroll
        for (int k = 0; k < 4; ++k) b[k] = ld_frag_g(Bt + (size_t)n * 128 + k * 32 + fq * 8);
#pragma unroll
        for (int m = 0; m < 4; ++m) if (m < nmt) {
          const u16* ap = A_lds + (m * 16 + fr) * ALD + 256 + fq * 8;
#pragma unroll
          for (int k = 0; k < 4; ++k)
            acc[m] = __builtin_amdgcn_mfma_f32_16x16x32_bf16(b[k], ld_frag_s(ap + k * 32), acc[m], 0, 0, 0);
        }
      }
      if (g < 2) {
        float4 w0v = *(const float4*)(KP(rw_w0) + (size_t)(l * 2 + g) * 384 + nc);
        u16* dst = RWP + (size_t)(3 + g) * NT * 384;
#pragma unroll
        for (int m = 0; m < 4; ++m) if (m < nmt) {
          int row = r0 + m * 16 + fr;
          uint2 o;
          o.x = pack2(sigmoidf_(w0v.x + acc[m][0]) * 0.60653066f, sigmoidf_(w0v.y + acc[m][1]) * 0.60653066f);
          o.y = pack2(sigmoidf_(w0v.z + acc[m][2]) * 0.60653066f, sigmoidf_(w0v.w + acc[m][3]) * 0.60653066f);
          *(uint2*)(dst + (size_t)row * 384 + nc) = o;
        }
      } else if (g < 4) {
        float4 a0v = *(const float4*)(KP(rw_a0) + (size_t)(l * 2 + (g - 2)) * 384 + nc);
        u16* dst = RWP + (size_t)(5 + (g - 2)) * NT * 384;
#pragma unroll
        for (int m = 0; m < 4; ++m) if (m < nmt) {
          int row = r0 + m * 16 + fr;
          uint2 o;
          o.x = pack2(sigmoidf_(a0v.x + acc[m][0]), sigmoidf_(a0v.y + acc[m][1]));
          o.y = pack2(sigmoidf_(a0v.z + acc[m][2]), sigmoidf_(a0v.w + acc[m][3]));
          *(uint2*)(dst + (size_t)row * 384 + nc) = o;
        }
      } else {
#pragma unroll
        for (int m = 0; m < 4; ++m) if (m < nmt) {
          int row = r0 + m * 16 + fr;
          uint2 o;
          o.x = pack2(acc[m][0], acc[m][1]);
          o.y = pack2(acc[m][2], acc[m][3]);
          *(uint2*)(Gout + (size_t)row * 384 + nc) = o;
        }
      }
    }
    for (int u = wid; u < 32; u += 8) {
      int d = u >> 4, hd = (u >> 2) & 3, ntile = u & 3;
      int nl = ntile * 16 + fr;
      int chc = hd * 64 + ntile * 16 + fq * 4;
      const u16* Ba = (const u16*)(wb + WB_RGGT) + (size_t)((d * 2 + 0) * 4 + hd) * 4096 + nl * 64;
      const u16* Bx = (const u16*)(wb + WB_RGGT) + (size_t)((d * 2 + 1) * 4 + hd) * 4096 + nl * 64;
      bf16x8 ba0 = ld_frag_g(Ba + fq * 8), ba1 = ld_frag_g(Ba + 32 + fq * 8);
      bf16x8 bx0 = ld_frag_g(Bx + fq * 8), bx1 = ld_frag_g(Bx + 32 + fq * 8);
      float4 gab = *(const float4*)(KP(rg_gate_a_b) + (size_t)(l * 2 + d) * 256 + chc);
      float4 gxb = *(const float4*)(KP(rg_gate_x_b) + (size_t)(l * 2 + d) * 256 + chc);
      float4 lam = *(const float4*)(KP(rg_lambda) + (size_t)(l * 2 + d) * 256 + chc);
      float spl[4] = {__logf(1.f + __expf(-lam.x)) * 8.f, __logf(1.f + __expf(-lam.y)) * 8.f,
                      __logf(1.f + __expf(-lam.z)) * 8.f, __logf(1.f + __expf(-lam.w)) * 8.f};
      float gabv[4] = {gab.x, gab.y, gab.z, gab.w}, gxbv[4] = {gxb.x, gxb.y, gxb.z, gxb.w};
      u16* dla = RGP + (size_t)(d * 2 + 0) * NT * 256;
      u16* dbx = RGP + (size_t)(d * 2 + 1) * NT * 256;
#pragma unroll
      for (int m = 0; m < 4; ++m) if (m < nmt) {
        const u16* ap = X_lds + (m * 16 + fr) * XLD + hd * 64 + fq * 8;
        bf16x8 a0 = ld_frag_s(ap), a1 = ld_frag_s(ap + 32);
        f32x4 ca = f32x4{0.f, 0.f, 0.f, 0.f}, cx = ca;
        ca = __builtin_amdgcn_mfma_f32_16x16x32_bf16(ba0, a0, ca, 0, 0, 0);
        ca = __builtin_amdgcn_mfma_f32_16x16x32_bf16(ba1, a1, ca, 0, 0, 0);
        cx = __builtin_amdgcn_mfma_f32_16x16x32_bf16(bx0, a0, cx, 0, 0, 0);
        cx = __builtin_amdgcn_mfma_f32_16x16x32_bf16(bx1, a1, cx, 0, 0, 0);
        int il = m * 16 + fr;
        int row = r0 + il;
        uint2 xcv = *(const uint2*)(X_lds + il * XLD + chc);
        float xc[4] = {lo2f(xcv.x), hi2f(xcv.x), lo2f(xcv.y), hi2f(xcv.y)};
        float la[4], bx[4];
#pragma unroll
        for (int j = 0; j < 4; ++j) {
          float r = sigmoidf_(ca[j] + gabv[j]), ig = sigmoidf_(cx[j] + gxbv[j]);
          float loga = -r * spl[j];
          float mult = __builtin_amdgcn_sqrtf(fmaxf(1.f - __expf(2.f * loga), 0.f));
          la[j] = loga;
          bx[j] = mult * ig * xc[j];
        }
        uint2 o;
        o.x = pack2(la[0], la[1]); o.y = pack2(la[2], la[3]);
        *(uint2*)(dla + (size_t)row * 256 + chc) = o;
        o.x = pack2(bx[0], bx[1]); o.y = pack2(bx[2], bx[3]);
        *(uint2*)(dbx + (size_t)row * 256 + chc) = o;
      }
    }
    for (int u = wid; u < 24; u += 8) {
      int d = u / 12, ntile = u % 12;
      int n = ntile * 16 + fr;
      int nc = ntile * 16 + fq * 4;
      const u16* Bt = (const u16*)(wb + WB_GLAT) + (size_t)d * 192 * 32;
      bf16x8 b0 = ld_frag_g(Bt + (size_t)n * 32 + fq * 8);
      float4 bb = *(const float4*)(KP(gla_alpha_b) + (size_t)(l * 2 + d) * 192 + nc);
      u16* dst = LA + (size_t)d * NT * 192;
#pragma unroll
      for (int m = 0; m < 4; ++m) if (m < nmt) {
        const u16* ap = Gl_lds + (d * 64 + m * 16 + fr) * GLD + fq * 8;
        f32x4 cacc = f32x4{0.f, 0.f, 0.f, 0.f};
        cacc = __builtin_amdgcn_mfma_f32_16x16x32_bf16(b0, ld_frag_s(ap), cacc, 0, 0, 0);
        int row = r0 + m * 16 + fr;
        uint2 o;
        o.x = pack2(log_sigmoidf_(cacc[0] + bb.x) * (1.f / 16.f), log_sigmoidf_(cacc[1] + bb.y) * (1.f / 16.f));
        o.y = pack2(log_sigmoidf_(cacc[2] + bb.z) * (1.f / 16.f), log_sigmoidf_(cacc[3] + bb.w) * (1.f / 16.f));
        *(uint2*)(dst + (size_t)row * 192 + nc) = o;
      }
    }
    __syncthreads();
  }
}

constexpr int TC = 32;
constexpr int NSTEP = 4352;
typedef float v2f __attribute__((ext_vector_type(2)));
DEV v2f pkfma(v2f a, v2f b, v2f c) { return __builtin_elementwise_fma(a, b, c); }
DEV float hex_sum(float x) {
  x = quad_sum(x);
  x += dpp_f<0x141>(x);
  x += dpp_f<0x140>(x);
  return x;
}
#define DPPADD(r, ctrl) "v_add_f32_dpp " r ", " r ", " r " " ctrl " row_mask:0xf bank_mask:0xf bound_ctrl:1\n\t"
DEV void hex_sum2(float& x, float& y) {
  asm volatile("s_nop 1\n\t"
               DPPADD("%0", "quad_perm:[1,0,3,2]") DPPADD("%1", "quad_perm:[1,0,3,2]") "s_nop 0\n\t"
               DPPADD("%0", "quad_perm:[2,3,0,1]") DPPADD("%1", "quad_perm:[2,3,0,1]") "s_nop 0\n\t"
               DPPADD("%0", "row_half_mirror") DPPADD("%1", "row_half_mirror") "s_nop 0\n\t"
               DPPADD("%0", "row_mirror") DPPADD("%1", "row_mirror")
               : "+v"(x), "+v"(y));
}
DEV void hex_sum4(float& a, float& b, float& c, float& d) {
  asm volatile("s_nop 1\n\t"
               DPPADD("%0", "quad_perm:[1,0,3,2]") DPPADD("%1", "quad_perm:[1,0,3,2]")
               DPPADD("%2", "quad_perm:[1,0,3,2]") DPPADD("%3", "quad_perm:[1,0,3,2]")
               DPPADD("%0", "quad_perm:[2,3,0,1]") DPPADD("%1", "quad_perm:[2,3,0,1]")
               DPPADD("%2", "quad_perm:[2,3,0,1]") DPPADD("%3", "quad_perm:[2,3,0,1]")
               DPPADD("%0", "row_half_mirror") DPPADD("%1", "row_half_mirror")
               DPPADD("%2", "row_half_mirror") DPPADD("%3", "row_half_mirror")
               DPPADD("%0", "row_mirror") DPPADD("%1", "row_mirror")
               DPPADD("%2", "row_mirror") DPPADD("%3", "row_mirror")
               : "+v"(a), "+v"(b), "+v"(c), "+v"(d));
}
DEV void oct_sum2(float& x, float& y) {
  asm volatile("s_nop 1\n\t"
               DPPADD("%0", "quad_perm:[1,0,3,2]") DPPADD("%1", "quad_perm:[1,0,3,2]") "s_nop 0\n\t"
               DPPADD("%0", "quad_perm:[2,3,0,1]") DPPADD("%1", "quad_perm:[2,3,0,1]") "s_nop 0\n\t"
               DPPADD("%0", "row_half_mirror") DPPADD("%1", "row_half_mirror")
               : "+v"(x), "+v"(y));
}
DEV void oct_sum3(float& a, float& b, float& c) {
  asm volatile("s_nop 1\n\t"
               DPPADD("%0", "quad_perm:[1,0,3,2]") DPPADD("%1", "quad_perm:[1,0,3,2]") DPPADD("%2", "quad_perm:[1,0,3,2]")
               DPPADD("%0", "quad_perm:[2,3,0,1]") DPPADD("%1", "quad_perm:[2,3,0,1]") DPPADD("%2", "quad_perm:[2,3,0,1]")
               DPPADD("%0", "row_half_mirror") DPPADD("%1", "row_half_mirror") DPPADD("%2", "row_half_mirror")
               : "+v"(a), "+v"(b), "+v"(c));
}

constexpr int RST = 392;
struct RwOps { float4 w, k, a, b, wr; float2 vv; float2 sc; };
struct RwOps8 { float4 w0, w1, k0, k1, a0, a1, b0, b1, r0, r1; float vv; float2 sc; };
DEV void scan_rwkv(PTag p, int l, int task) {
  const int ltid = my_tid();
  const int tid = ltid, lane = tid & 63, w = tid >> 6;
  const int half = task & 1, sc = task >> 1;
  const int b = sc / 12, h = (sc % 12) >> 1, dir = sc & 1;
  char* ar = KWS + OFF_AR;
  const u16* RWP = (const u16*)(ar + AR_RWP);
  const u16* Rg = RWP, *Kg = RWP + (size_t)NT * 384, *Vg = RWP + (size_t)2 * NT * 384;
  const u16* Ug = RWP + (size_t)(3 + dir) * NT * 384, *Ag = RWP + (size_t)(5 + dir) * NT * 384;
  const float* invn = (const float*)(KWS + OFF_INVN);
  u16* Yd = (u16*)(ar + AR_Z2) + (size_t)dir * NT * 384;
  float* buf = (float*)g_smem;
  float* ybuf = buf + 2 * TC * RST;
  const int rl = lane >> 3, kg = lane & 7;
  const int lrow = w * 8 + rl;
  const int lstep = tid >> 4, lq = tid & 15;
  const int ce = h * 64 + lq * 4;
  float4 kkc = *(const float4*)(KP(rw_k_k) + (size_t)l * 384 + ce);
  float4 kac = *(const float4*)(KP(rw_k_a) + (size_t)l * 384 + ce);
  v2f S0 = {0.f, 0.f}, S1 = {0.f, 0.f}, S2 = {0.f, 0.f}, S3 = {0.f, 0.f};

  uint2 gr, gk, gv, gu, ga;
  float gin;
  auto issue = [&](int c) {
    int row = seq_row(b, dir, c * TC + lstep);
    size_t o = (size_t)row * 384 + ce;
    gr = *(const uint2*)(Rg + o);
    gk = *(const uint2*)(Kg + o);
    gv = *(const uint2*)(Vg + o);
    gu = *(const uint2*)(Ug + o);
    ga = *(const uint2*)(Ag + o);
    gin = invn[(size_t)row * 8 + h];
  };
  auto commit = [&](int c, int) {
    float* d = buf + (size_t)((c & 1) * TC + lstep) * RST;
    float r0 = lo2f(gr.x), r1 = hi2f(gr.x), r2 = lo2f(gr.y), r3 = hi2f(gr.y);
    float k0 = lo2f(gk.x), k1 = hi2f(gk.x), k2 = lo2f(gk.y), k3 = hi2f(gk.y);
    float v0 = lo2f(gv.x), v1 = hi2f(gv.x), v2 = lo2f(gv.y), v3 = hi2f(gv.y);
    float u0 = lo2f(gu.x), u1 = hi2f(gu.x), u2 = lo2f(gu.y), u3 = hi2f(gu.y);
    float a0 = lo2f(ga.x), a1 = hi2f(ga.x), a2 = lo2f(ga.y), a3 = hi2f(ga.y);
    float w0 = __expf(-u0), w1 = __expf(-u1), w2 = __expf(-u2), w3 = __expf(-u3);
    float d0 = k0 * (1.f + (a0 - 1.f) * kac.x), d1 = k1 * (1.f + (a1 - 1.f) * kac.y);
    float d2 = k2 * (1.f + (a2 - 1.f) * kac.z), d3 = k3 * (1.f + (a3 - 1.f) * kac.w);
    float q0 = k0 * kkc.x * gin, q1 = k1 * kkc.y * gin, q2 = k2 * kkc.z * gin, q3 = k3 * kkc.w * gin;
    float b0 = q0 * a0, b1 = q1 * a1, b2 = q2 * a2, b3 = q3 * a3;
    *(float4*)(d + lq * 4) = make_float4(w0, w1, w2, w3);
    *(float4*)(d + 64 + lq * 4) = make_float4(d0, d1, d2, d3);
    *(float4*)(d + 128 + lq * 4) = make_float4(-q0, -q1, -q2, -q3);
    *(float4*)(d + 192 + lq * 4) = make_float4(b0, b1, b2, b3);
    *(float4*)(d + 256 + lq * 4) = make_float4(w0 * r0, w1 * r1, w2 * r2, w3 * r3);
    *(float4*)(d + 320 + lq * 4) = make_float4(v0, v1, v2, v3);
    float br = b0 * r0 + b1 * r1 + b2 * r2 + b3 * r3;
    float kr = d0 * r0 + d1 * r1 + d2 * r2 + d3 * r3;
    hex_sum2(br, kr);
    if (lq == 0) *(float2*)(d + 384) = make_float2(br, kr);
  };
  issue(0);
  commit(0, 0);
  __syncthreads();
  constexpr int NCH = NSTEP / TC;
#pragma unroll 1
  for (int c = 0; c < NCH; ++c) {
    const int cn = (c + 1 < NCH) ? c + 1 : c;
    issue(cn);
    const float* cb = buf + (size_t)(c & 1) * TC * RST;
    float* yb = ybuf + (c & 1) * TC * 32;
    if (w < 4) {
      auto ld = [&](int s) {
        RwOps8 o;
        const float* sb = cb + s * RST + kg * 8;
        o.w0 = *(const float4*)(sb);        o.w1 = *(const float4*)(sb + 4);
        o.k0 = *(const float4*)(sb + 64);   o.k1 = *(const float4*)(sb + 68);
        o.a0 = *(const float4*)(sb + 128);  o.a1 = *(const float4*)(sb + 132);
        o.b0 = *(const float4*)(sb + 192);  o.b1 = *(const float4*)(sb + 196);
        o.r0 = *(const float4*)(sb + 256);  o.r1 = *(const float4*)(sb + 260);
        o.vv = cb[s * RST + 320 + half * 32 + lrow];
        o.sc = *(const float2*)(cb + s * RST + 384);
        return o;
      };
      RwOps8 cur = ld(0);
#pragma unroll 8
      for (int s = 0; s < TC; ++s) {
        RwOps8 nxt = ld((s + 1) & (TC - 1));
        v2f t1 = S0 * v2f{cur.a0.x, cur.a0.y}, t2 = S0 * v2f{cur.r0.x, cur.r0.y};
        t1 = pkfma(S1, v2f{cur.a0.z, cur.a0.w}, t1);
        t2 = pkfma(S1, v2f{cur.r0.z, cur.r0.w}, t2);
        t1 = pkfma(S2, v2f{cur.a1.x, cur.a1.y}, t1);
        t2 = pkfma(S2, v2f{cur.r1.x, cur.r1.y}, t2);
        t1 = pkfma(S3, v2f{cur.a1.z, cur.a1.w}, t1);
        t2 = pkfma(S3, v2f{cur.r1.z, cur.r1.w}, t2);
        float sa = t1.x + t1.y, yy = t2.x + t2.y;
        oct_sum2(sa, yy);
        v2f sa2 = {sa, sa}, va2 = {cur.vv, cur.vv};
        S0 = pkfma(S0, v2f{cur.w0.x, cur.w0.y}, pkfma(sa2, v2f{cur.b0.x, cur.b0.y}, va2 * v2f{cur.k0.x, cur.k0.y}));
        S1 = pkfma(S1, v2f{cur.w0.z, cur.w0.w}, pkfma(sa2, v2f{cur.b0.z, cur.b0.w}, va2 * v2f{cur.k0.z, cur.k0.w}));
        S2 = pkfma(S2, v2f{cur.w1.x, cur.w1.y}, pkfma(sa2, v2f{cur.b1.x, cur.b1.y}, va2 * v2f{cur.k1.x, cur.k1.y}));
        S3 = pkfma(S3, v2f{cur.w1.z, cur.w1.w}, pkfma(sa2, v2f{cur.b1.z, cur.b1.w}, va2 * v2f{cur.k1.z, cur.k1.w}));
        yy = fmaf(sa, cur.sc.x, fmaf(cur.vv, cur.sc.y, yy));
        yb[s * 32 + lrow] = yy;
        cur = nxt;
      }
    }
    commit(c + 1, cn);
    __syncthreads();
    if (lq < 8) {
      int row = seq_row(b, dir, c * TC + lstep);
      float4 yv = *(const float4*)(yb + lstep * 32 + lq * 4);
      uint2 o;
      o.x = pack2(yv.x, yv.y);
      o.y = pack2(yv.z, yv.w);
      *(uint2*)(Yd + (size_t)row * 384 + h * 64 + half * 32 + lq * 4) = o;
    }
  }
  __syncthreads();
}

constexpr int GST = 288;
struct GlOps { float4 a03, k03, q03; float2 a45, k45, q45; float v0, v1, v2; };
DEV void scan_gla_rg(PTag p, int l, int task) {
  const int ltid = my_tid();
  const int tid = ltid, lane = tid & 63, w = tid >> 6;
  const int b = task >> 3, hd = (task >> 1) & 3, dir = task & 1;
  char* ar = KWS + OFF_AR;
  const u16* Z1 = (const u16*)(ar + AR_Z1);
  const u16* LAg = (const u16*)(ar + AR_LA) + (size_t)dir * NT * 192;
  u16* Od = (u16*)(ar + AR_Z2) + (size_t)(2 + dir) * NT * 384;
  const u16* RGP = (const u16*)(KWS + OFF_XN);
  const u16* RLA = RGP + (size_t)(dir * 2 + 0) * NT * 256;
  const u16* RBX = RGP + (size_t)(dir * 2 + 1) * NT * 256;
  u16* Hd = (u16*)(KWS + OFF_Y) + (size_t)NT * 384 + (size_t)dir * NT * 256;
  float* buf = (float*)g_smem;
  float* obuf = buf + 2 * TC * GST;
  unsigned* rgbuf = (unsigned*)(obuf + 2 * TC * 128);
  u16* hbuf = (u16*)(rgbuf + 2 * TC * 64);
  const int el = lane >> 3, dg = lane & 7;
  const int c0 = w * 24 + el;
  const int lstep = tid >> 4, lq = tid & 15;
  v2f S[3][3];
#pragma unroll
  for (int c = 0; c < 3; ++c)
#pragma unroll
    for (int j = 0; j < 3; ++j) S[c][j] = v2f{0.f, 0.f};
  float hst = 0.f;
  uint2 gq, gk, gl_, gv0, gv1, rla, rbx;
  auto issue = [&](int c) {
    int row = seq_row(b, dir, c * TC + lstep);
    const u16* zr = Z1 + (size_t)row * Z1W;
    uint2 z = {0u, 0u};
    gq = z; gk = z; gl_ = z; gv1 = z;
    if (lq < 12) {
      gq = *(const uint2*)(zr + 512 + hd * 48 + lq * 4);
      gk = *(const uint2*)(zr + 704 + hd * 48 + lq * 4);
      gl_ = *(const uint2*)(LAg + (size_t)row * 192 + hd * 48 + lq * 4);
    }
    gv0 = *(const uint2*)(zr + 896 + hd * 96 + lq * 4);
    if (lq < 8) gv1 = *(const uint2*)(zr + 896 + hd * 96 + 64 + lq * 4);
    rla = *(const uint2*)(RLA + (size_t)row * 256 + hd * 64 + lq * 4);
    rbx = *(const uint2*)(RBX + (size_t)row * 256 + hd * 64 + lq * 4);
  };
  auto commit = [&](int c, int) {
    float* d = buf + (size_t)((c & 1) * TC + lstep) * GST;
    const float qs = 0.14433756729740643f;
    if (lq < 12) {
      float av[4] = {__expf(lo2f(gl_.x)), __expf(hi2f(gl_.x)), __expf(lo2f(gl_.y)), __expf(hi2f(gl_.y))};
      float kv[4] = {lo2f(gk.x), hi2f(gk.x), lo2f(gk.y), hi2f(gk.y)};
      float qv[4] = {lo2f(gq.x) * qs, hi2f(gq.x) * qs, lo2f(gq.y) * qs, hi2f(gq.y) * qs};
#pragma unroll
      for (int e = 0; e < 4; ++e) {
        int dd = lq * 4 + e;
        int pos = (dd / 6) * 20 + (dd % 6);
        d[pos] = av[e];
        d[6 + pos] = kv[e];
        d[12 + pos] = qv[e];
      }
    }
    {
      float vv0[4] = {lo2f(gv0.x), hi2f(gv0.x), lo2f(gv0.y), hi2f(gv0.y)};
      float vv1[4] = {lo2f(gv1.x), hi2f(gv1.x), lo2f(gv1.y), hi2f(gv1.y)};
#pragma unroll
      for (int e = 0; e < 4; ++e) {
        int c = lq * 4 + e, r = c % 24;
        d[160 + (c / 24) * 32 + (r % 8) * 4 + (r / 8)] = vv0[e];
        if (lq < 8) {
          int c2 = 64 + lq * 4 + e, r2 = c2 % 24;
          d[160 + (c2 / 24) * 32 + (r2 % 8) * 4 + (r2 / 8)] = vv1[e];
        }
      }
    }
    unsigned* rd = rgbuf + (size_t)((c & 1) * TC + lstep) * 64 + lq * 4;
    uint4 ro;
    ro.x = (rla.x & 0xffffu) | (rbx.x << 16);
    ro.y = (rla.x >> 16) | (rbx.x & 0xffff0000u);
    ro.z = (rla.y & 0xffffu) | (rbx.y << 16);
    ro.w = (rla.y >> 16) | (rbx.y & 0xffff0000u);
    *(uint4*)rd = ro;
  };
  issue(0);
  commit(0, 0);
  __syncthreads();
  constexpr int NCH = NSTEP / TC;
#pragma unroll 1
  for (int c = 0; c < NCH; ++c) {
    const int cn = (c + 1 < NCH) ? c + 1 : c;
    issue(cn);
    const float* cb = buf + (size_t)(c & 1) * TC * GST;
    float* ob = obuf + (c & 1) * TC * 128;
    if (w < 4) {
      auto ld = [&](int s) {
        GlOps o;
        const float* sb = cb + s * GST + dg * 20;
        float4 r0 = *(const float4*)(sb), r1 = *(const float4*)(sb + 4), r2 = *(const float4*)(sb + 8);
        float4 r3 = *(const float4*)(sb + 12);
        float2 r4 = *(const float2*)(sb + 16);
        o.a03 = r0;
        o.a45 = make_float2(r1.x, r1.y);
        o.k03 = make_float4(r1.z, r1.w, r2.x, r2.y);
        o.k45 = make_float2(r2.z, r2.w);
        o.q03 = r3;
        o.q45 = r4;
        float4 vq = *(const float4*)(cb + s * GST + 160 + w * 32 + el * 4);
        o.v0 = vq.x; o.v1 = vq.y; o.v2 = vq.z;
        return o;
      };
      GlOps cur = ld(0);
#pragma unroll 8
      for (int s = 0; s < TC; ++s) {
        GlOps nxt = ld((s + 1) & (TC - 1));
        v2f al[3] = {v2f{cur.a03.x, cur.a03.y}, v2f{cur.a03.z, cur.a03.w}, v2f{cur.a45.x, cur.a45.y}};
        v2f kk[3] = {v2f{cur.k03.x, cur.k03.y}, v2f{cur.k03.z, cur.k03.w}, v2f{cur.k45.x, cur.k45.y}};
        v2f qq[3] = {v2f{cur.q03.x, cur.q03.y}, v2f{cur.q03.z, cur.q03.w}, v2f{cur.q45.x, cur.q45.y}};
        v2f vv[3] = {v2f{cur.v0, cur.v0}, v2f{cur.v1, cur.v1}, v2f{cur.v2, cur.v2}};
        float r[3];
#pragma unroll
        for (int ci = 0; ci < 3; ++ci) {
#pragma unroll
          for (int j = 0; j < 3; ++j) S[ci][j] = pkfma(al[j], S[ci][j], kk[j] * vv[ci]);
          v2f o = qq[0] * S[ci][0];
          o = pkfma(qq[1], S[ci][1], o);
          o = pkfma(qq[2], S[ci][2], o);
          r[ci] = o.x + o.y;
        }
        oct_sum3(r[0], r[1], r[2]);
        typedef float v3f __attribute__((ext_vector_type(3)));
        *(v3f*)(ob + s * 128 + w * 32 + el * 4) = v3f{r[0], r[1], r[2]};
        cur = nxt;
      }
    } else if (w == 4) {
      const unsigned* rb = rgbuf + (size_t)(c & 1) * TC * 64 + lane;
      u16* hb = hbuf + (size_t)(c & 1) * TC * 64 + lane;
      unsigned uu[TC];
#pragma unroll
      for (int s = 0; s < TC; ++s) uu[s] = rb[s * 64];
#pragma unroll
      for (int s = 0; s < TC; ++s) {
        float a = __expf(lo2f(uu[s]));
        hst = fmaf(a, hst, hi2f(uu[s]));
        hb[s * 64] = f2bf(hst);
      }
    }
    commit(c + 1, cn);
    __syncthreads();
    {
      int row = seq_row(b, dir, c * TC + lstep);
      u16* orow = Od + (size_t)row * 384 + hd * 96;
      const float* orow_l = ob + lstep * 128;
      float x0[4], x1[4];
#pragma unroll
      for (int e = 0; e < 4; ++e) {
        int c = lq * 4 + e, r = c % 24;
        x0[e] = orow_l[(c / 24) * 32 + (r % 8) * 4 + (r / 8)];
        int c2 = 64 + (lq & 7) * 4 + e, r2 = c2 % 24;
        x1[e] = orow_l[(c2 / 24) * 32 + (r2 % 8) * 4 + (r2 / 8)];
      }
      uint2 o;
      o.x = pack2(x0[0], x0[1]); o.y = pack2(x0[2], x0[3]);
      *(uint2*)(orow + lq * 4) = o;
      if (lq < 8) {
        o.x = pack2(x1[0], x1[1]); o.y = pack2(x1[2], x1[3]);
        *(uint2*)(orow + 64 + lq * 4) = o;
      }
      uint2 hv = *(const uint2*)(hbuf + (size_t)((c & 1) * TC + lstep) * 64 + lq * 4);
      *(uint2*)(Hd + (size_t)row * 256 + hd * 64 + lq * 4) = hv;
    }
  }
  __syncthreads();
}

DEV void phase_scan(PTag p, int l, int mode) {
  const int lbid = my_bid();
  const int Gs = gridDim.x;
  const int swz = (Gs % 8 == 0) ? (lbid % 8) * (Gs / 8) + lbid / 8 : lbid;
  for (int base = 0; base < 256; base += Gs) {
    const int task = base + ((base + Gs <= 256) ? swz : lbid);
    if (task >= 256) continue;
    if (task < 192) { if (mode != 2) scan_rwkv(p, l, task); }
    else { if (mode != 1) scan_gla_rg(p, l, task - 192); }
  }
}

DEV float gelu_tanh(float x) {
  float u = 0.7978845608028654f * (x + 0.044715f * x * x * x);
  return 0.5f * x * (1.f + tanhf_(u));
}
DEV void phase_post(PTag p, int l) {
  const int ltid = my_tid();
  const int lbid = my_bid();
  const int lane = ltid & 63;
  const int gw = lbid * 8 + (ltid >> 6), nw = gridDim.x * 8;
  char* ar = KWS + OFF_AR;
  const u16* Z1 = (const u16*)(ar + AR_Z1);
  const u16* RWP = (const u16*)(ar + AR_RWP);
  const u16* RWY = (const u16*)(ar + AR_Z2);
  const u16* Gg = (const u16*)(KWS + OFF_Y);
  const u16* RGH = Gg + (size_t)NT * 384;
  u16* YM = (u16*)(KWS + OFF_XN);
  const float* gnorm = KP(gla_norm) + (size_t)l * 96;
  const float* r_k = KP(rw_r_k) + (size_t)l * 384;
  const float* k_a = KP(rw_k_a) + (size_t)l * 384;
  const float* ln_w = KP(rw_ln_w) + (size_t)l * 384;
  const float* ln_b = KP(rw_ln_b) + (size_t)l * 384;
  float gn0 = gnorm[lane], gn1 = (lane < 32) ? gnorm[64 + lane] : 0.f;
  float rkc[6], kac[6], lwc[6], lbc[6];
#pragma unroll
  for (int j = 0; j < 6; ++j) {
    rkc[j] = r_k[j * 64 + lane]; kac[j] = k_a[j * 64 + lane];
    lwc[j] = ln_w[j * 64 + lane]; lbc[j] = ln_b[j * 64 + lane];
  }
  const int l32 = lane < 32 ? lane : 0;
  for (int row = gw; row < NT; row += nw) {
    uint2 hf = *(const uint2*)(RGH + (size_t)row * 256 + lane * 4);
    uint2 hb = *(const uint2*)(RGH + (size_t)NT * 256 + (size_t)row * 256 + lane * 4);
    uint2 gb = *(const uint2*)(Z1 + (size_t)row * Z1W + 256 + lane * 4);
    const u16* of = RWY + (size_t)2 * NT * 384 + (size_t)row * 384;
    const u16* ob = RWY + (size_t)3 * NT * 384 + (size_t)row * 384;
    const u16* og = Z1 + (size_t)row * Z1W + 1280;
    u16 gof0[4], gob0[4], gog0[4], gof1[4], gob1[4], gog1[4];
#pragma unroll
    for (int hd = 0; hd < 4; ++hd) {
      gof0[hd] = of[hd * 96 + lane]; gob0[hd] = ob[hd * 96 + lane]; gog0[hd] = og[hd * 96 + lane];
      gof1[hd] = of[hd * 96 + 64 + l32]; gob1[hd] = ob[hd * 96 + 64 + l32]; gog1[hd] = og[hd * 96 + 64 + l32];
    }
    size_t ro = (size_t)row * 384;
    u16 wyf[6], wyb[6], wr[6], wk[6], wv[6], waf[6], wab[6], wg[6];
#pragma unroll
    for (int j = 0; j < 6; ++j) {
      int idx = j * 64 + lane;
      wyf[j] = RWY[ro + idx]; wyb[j] = RWY[(size_t)NT * 384 + ro + idx];
      wr[j] = RWP[ro + idx]; wk[j] = RWP[(size_t)NT * 384 + ro + idx]; wv[j] = RWP[(size_t)2 * NT * 384 + ro + idx];
      waf[j] = RWP[(size_t)5 * NT * 384 + ro + idx]; wab[j] = RWP[(size_t)6 * NT * 384 + ro + idx];
      wg[j] = Gg[ro + idx];
    }
    {
      float y0 = (lo2f(hf.x) + lo2f(hb.x)) * gelu_tanh(lo2f(gb.x));
      float y1 = (hi2f(hf.x) + hi2f(hb.x)) * gelu_tanh(hi2f(gb.x));
      float y2 = (lo2f(hf.y) + lo2f(hb.y)) * gelu_tanh(lo2f(gb.y));
      float y3 = (hi2f(hf.y) + hi2f(hb.y)) * gelu_tanh(hi2f(gb.y));
      uint2 o;
      o.x = pack2(y0, y1); o.y = pack2(y2, y3);
      *(uint2*)(YM + (size_t)row * 1024 + lane * 4) = o;
    }
#pragma unroll
    for (int hd = 0; hd < 4; ++hd) {
      float v0 = bf2f(gof0[hd]) + bf2f(gob0[hd]);
      float v1 = (lane < 32) ? (bf2f(gof1[hd]) + bf2f(gob1[hd])) : 0.f;
      float ss = wave_sum(v0 * v0 + v1 * v1);
      float rs = rsqrtf(ss * (1.f / 96.f) + 1e-6f);
      YM[(size_t)row * 1024 + 256 + hd * 96 + lane] = f2bf(v0 * rs * gn0 * siluf_(bf2f(gog0[hd])));
      if (lane < 32)
        YM[(size_t)row * 1024 + 256 + hd * 96 + 64 + lane] = f2bf(v1 * rs * gn1 * siluf_(bf2f(gog1[hd])));
    }
#pragma unroll
    for (int j = 0; j < 6; ++j) {
      int idx = j * 64 + lane;
      float y = bf2f(wyf[j]) + bf2f(wyb[j]);
      float r = bf2f(wr[j]), k = bf2f(wk[j]), v = bf2f(wv[j]);
      float af = bf2f(waf[j]), ab = bf2f(wab[j]);
      float mean = wave_sum(y) * (1.f / 64.f);
      float dlt = y - mean;
      float var = wave_sum(dlt * dlt) * (1.f / 64.f);
      float bon = wave_sum(r * k * rkc[j] * (2.f + (af + ab - 2.f) * kac[j]));
      float yn = dlt * rsqrtf(var + 64e-5f) * lwc[j] + lbc[j];
      yn += bon * v;
      YM[(size_t)row * 1024 + 640 + idx] = f2bf(yn * bf2f(wg[j]));
    }
  }
}

constexpr int NPHASES = 2 + 12 * 4;

DEV void run_phase(PTag p, int ph, int rep) {
  float* mod = (float*)(KWS + OFF_MOD);
  char* ws = KWS;
  u16* XN = (u16*)(ws + OFF_XN);
  u16* Yb = (u16*)(ws + OFF_Y);
  u16* U = (u16*)(ws + OFF_AR);
  if (ph == 0) {
    phase_adaln(p);
    __syncthreads();
    conv_ffn(p, 0, 0);
    return;
  }
  if (ph == 1) {
    phase_rows(p, 1, 0, nullptr, nullptr, 0.f, 1, KP(norm_pre) + 0, mod + 0 * 1024, mod + 1 * 1024, NT);
    return;
  }
  int q = ph - 2, l = q / 12, k = q % 12;
  const float* modl = mod + (size_t)l * 9 * 9216;
  const bool last = (l == 3);
  const int Mlate = last ? NLAT : NT;
  switch (k) {
    case 0:
      gemm_phase<1024, EPI_UP>(XN, (const u16*)(ws + OFF_WB + WB_W13T), NT, 5632, U, nullptr);
      break;
    case 1:
      gemm_phase<2816, EPI_Y>(U, (const u16*)(ws + OFF_WB + WB_W2T), NLAT, 1024, Yb, nullptr);
      gemm_phase<2816, EPI_Y, true>(U, (const u16*)(ws + OFF_WB + WB_W2T), NLAT, 1024, Yb, nullptr, NCTXR / BM,
                                    (float*)(ws + OFF_AR + AR_PART));
      break;
    case 2:
      phase_rows(p, 0, 1, KP(norm_post) + (size_t)(l * 3 + 0) * 1024, modl + 2 * 1024, 0.5f, 1,
                 KP(norm_pre) + (size_t)(l * 3 + 1) * 1024, modl + 3 * 1024, modl + 4 * 1024, NT, 1);
      conv_mixer(p, l);
      break;
    case 3:
      gemm_phase<1024, EPI_Z>(XN, (const u16*)(ws + OFF_WB + WB_WINT), NT, PINP, (u16*)(ws + OFF_AR + AR_Z1),
                              (u16*)(ws + OFF_AR + AR_Z2));
      break;
    case 4:
      phase_prep(p, l);
      break;
    case 5:
      phase_scan(p, l, rep == 0 ? 0 : SCAN_PROBE_MODE);
      break;
    case 6:
      phase_post(p, l);
      break;
    case 7:
      gemm_phase<1024, EPI_Y>(XN, (const u16*)(ws + OFF_WB + WB_WOUTT), NLAT, 1024, Yb, nullptr);
      if (!last)
        gemm_phase<1024, EPI_Y, true>(XN, (const u16*)(ws + OFF_WB + WB_WOUTT), NLAT, 1024, Yb, nullptr, NCTXR / BM,
                                      (float*)(ws + OFF_AR + AR_PART));
      break;
    case 8:
      phase_rows(p, 0, 1, KP(norm_post) + (size_t)(l * 3 + 1) * 1024, modl + 5 * 1024, 1.0f, 1,
                 KP(norm_pre) + (size_t)(l * 3 + 2) * 1024, modl + 6 * 1024, modl + 7 * 1024, Mlate, 1);
      conv_ffn(p, l, 1);
      break;
    case 9:
      gemm_phase<1024, EPI_UP>(XN, (const u16*)(ws + OFF_WB + WB_W13T), Mlate, 5632, U, nullptr);
      break;
    case 10:
      gemm_phase<2816, EPI_Y>(U, (const u16*)(ws + OFF_WB + WB_W2T), NLAT, 1024, Yb, nullptr);
      if (!last)
        gemm_phase<2816, EPI_Y, true>(U, (const u16*)(ws + OFF_WB + WB_W2T), NLAT, 1024, Yb, nullptr, NCTXR / BM,
                                      (float*)(ws + OFF_AR + AR_PART));
      break;
    case 11:
      if (!last) {
        const float* modn = mod + (size_t)(l + 1) * 9 * 9216;
        phase_rows(p, 0, 1, KP(norm_post) + (size_t)(l * 3 + 2) * 1024, modl + 8 * 1024, 0.5f, 1,
                   KP(norm_pre) + (size_t)((l + 1) * 3 + 0) * 1024, modn + 0 * 1024, modn + 1 * 1024, NT, 1);
        conv_ffn(p, l + 1, 0);
      } else {
        phase_rows(p, 0, 1, KP(norm_post) + (size_t)(l * 3 + 2) * 1024, modl + 8 * 1024, 0.5f, 0, nullptr, nullptr,
                   nullptr, NLAT);
      }
      break;
  }
}

#ifndef REP_SCAN
#define REP_SCAN 1
#endif
#ifndef REP_GEMM
#define REP_GEMM 1
#endif
#ifndef REP_PREP
#define REP_PREP 1
#endif
#ifndef REP_POST
#define REP_POST 1
#endif
DEV int phase_reps(int ph) {
  if (ph < 2) return 1;
  int k = (ph - 2) % 12;
  if (k == 5) return REP_SCAN;
  if (k == 4) return REP_PREP;
  if (k == 6) return REP_POST;
  if (k == 0 || k == 1 || k == 3 || k == 7 || k == 9 || k == 10) return REP_GEMM;
  return 1;
}
DEV void grid_barrier(unsigned* ctr, unsigned target) {
  asm volatile("s_waitcnt vmcnt(0)" ::: "memory");
  __syncthreads();
  if (threadIdx.x == 0) {
    __builtin_amdgcn_fence(__ATOMIC_RELEASE, "agent");
    asm volatile("s_waitcnt vmcnt(0)" ::: "memory");
    __hip_atomic_fetch_add(ctr, 1u, __ATOMIC_RELAXED, __HIP_MEMORY_SCOPE_AGENT);
    while (__hip_atomic_load(ctr, __ATOMIC_RELAXED, __HIP_MEMORY_SCOPE_AGENT) < target) __builtin_amdgcn_s_sleep(1);
    __builtin_amdgcn_fence(__ATOMIC_ACQUIRE, "agent");
    asm volatile("s_waitcnt vmcnt(0)" ::: "memory");
  }
  __syncthreads();
}

__global__ void __launch_bounds__(NTHREADS, 2) mega_kernel(Params params_, int ph_lo, int ph_hi) {
  PTag p;
  cg::grid_group grid = cg::this_grid();
  unsigned* bar = (unsigned*)(KWS + OFF_BAR);
  if (blockIdx.x == 0 && threadIdx.x == 0) __hip_atomic_store(bar, 0u, __ATOMIC_RELAXED, __HIP_MEMORY_SCOPE_AGENT);
  unsigned nsync = 0;
  for (int ph = ph_lo; ph < ph_hi; ++ph) {
    const int reps = phase_reps(ph);
    for (int r = 0; r < reps; ++r) {
      if (ph > ph_lo || r > 0) {
        if (nsync == 0) grid.sync();
        else grid_barrier(bar, nsync * gridDim.x);
        ++nsync;
      }
      run_phase(p, ph, r);
    }
  }
}

extern "C" void kernel_launch(void* const* d_in, const int* in_sizes, int n_in, void* d_out, int out_size, void* d_ws,
                              size_t ws_size, hipStream_t stream) {
  static int grid_blocks = 0;
  if (!grid_blocks) {
    int dev = 0, cus = 0, per_cu = 0;
    hipGetDevice(&dev);
    hipDeviceGetAttribute(&cus, hipDeviceAttributeMultiprocessorCount, dev);
    hipFuncSetAttribute((const void*)mega_kernel, hipFuncAttributeMaxDynamicSharedMemorySize, (int)SMEM_BYTES);
    hipOccupancyMaxActiveBlocksPerMultiprocessor(&per_cu, mega_kernel, NTHREADS, SMEM_BYTES);
    if (per_cu < 1) per_cu = 1;
    grid_blocks = cus * per_cu;
    if (ws_size < WS_TOTAL) fprintf(stderr, "workspace too small: %zu < %zu\n", ws_size, (size_t)WS_TOTAL);
  }
  Params p{};
  const float** pp = (const float**)&p;
  for (int i = 0; i < 34; ++i) pp[i] = (const float*)d_in[i];
  p.out = (float*)d_out;
  p.ws = (char*)d_ws;
#ifdef MULTI_LAUNCH
  for (int ph = 0; ph < NPHASES; ++ph) {
    hipLaunchKernelGGL(mega_kernel, dim3(grid_blocks), dim3(NTHREADS), SMEM_BYTES, stream, p, ph, ph + 1);
  }
#else
  int lo = 0, hi = NPHASES;
  void* args[] = {&p, &lo, &hi};
  hipError_t e = hipLaunchCooperativeKernel((const void*)mega_kernel, dim3(grid_blocks), dim3(NTHREADS), args,
                                            SMEM_BYTES, stream);
  if (e != hipSuccess) fprintf(stderr, "cooperative launch failed: %s (grid %d)\n", hipGetErrorString(e), grid_blocks);
#endif
}
```

```cpp
#include <hip/hip_runtime.h>
#include <hip/hip_cooperative_groups.h>
#include <cstdio>
namespace cg = cooperative_groups;
#define SCAN_PROBE_MODE 0

typedef unsigned short u16;
using bf16x8 = __attribute__((ext_vector_type(8))) short;
using f32x4 = __attribute__((ext_vector_type(4))) float;

#define DEV __device__ __forceinline__

constexpr int NLAT = 32768, NCTXR = 2048, NT = 34816;
constexpr int DM = 1024, DFF = 2816, PIN = 3232, PINP = 3328;
constexpr int Z1W = 1696, Z2W = 1536;
constexpr int NTHREADS = 512;
constexpr size_t SMEM_BYTES = 131072;

constexpr size_t OFF_MOD = 0;
constexpr size_t SZ_MOD = 4ull * 9 * 9216 * 4;
constexpr size_t OFF_HC = OFF_MOD + SZ_MOD;
constexpr size_t SZ_HC = 2048ull * 1024 * 4;
constexpr size_t OFF_INVN = OFF_HC + SZ_HC;
constexpr size_t SZ_INVN = (size_t)NT * 8 * 4;
constexpr size_t OFF_WB = OFF_INVN + SZ_INVN;
constexpr size_t SZ_WB = 5632ull * 1024 * 2 + 1024ull * 2816 * 2;
constexpr size_t OFF_XN = OFF_WB + SZ_WB;
constexpr size_t SZ_XN = (size_t)NT * 1024 * 2;
constexpr size_t OFF_Y = OFF_XN + SZ_XN;
constexpr size_t SZ_Y = SZ_XN;
constexpr size_t OFF_AR = OFF_Y + SZ_Y;
constexpr size_t SZ_384 = (size_t)NT * 384 * 2;
constexpr size_t SZ_256 = (size_t)NT * 256 * 2;
constexpr size_t SZ_192 = (size_t)NT * 192 * 2;
constexpr size_t AR_Z1 = 0;
constexpr size_t AR_Z2 = AR_Z1 + (size_t)NT * Z1W * 2;
constexpr size_t AR_RWP = AR_Z2 + (size_t)NT * Z2W * 2;
constexpr size_t AR_LA = AR_RWP + 7 * SZ_384;
constexpr size_t SZ_AR = AR_LA + 2 * SZ_192;
constexpr size_t AR_PART = 201326592;
constexpr size_t OFF_BAR = OFF_AR + SZ_AR;
constexpr size_t WS_TOTAL = OFF_BAR + 16384;
constexpr size_t WB_W13T = 0;
constexpr size_t WB_W2T = 5632ull * 1024 * 2;
constexpr size_t WB_WINT = 0;
constexpr size_t WB_WOUTT = WB_WINT + 3328ull * 1024 * 2;
constexpr size_t WB_RWW2T = WB_WOUTT + 1024ull * 1024 * 2;
constexpr size_t WB_RWA2T = WB_RWW2T + 2ull * 384 * 64 * 2;
constexpr size_t WB_RWG2T = WB_RWA2T + 2ull * 384 * 64 * 2;
constexpr size_t WB_RGGT = WB_RWG2T + 384ull * 128 * 2;
constexpr size_t WB_GLAT = WB_RGGT + 16ull * 64 * 64 * 2;

struct Params {
  const float *x, *c, *ctx, *c_ctx, *w_mod, *b_mod, *norm_pre, *norm_post, *ffn_w1, *ffn_w3, *ffn_w2, *w_in, *w_out,
      *rg_conv_w, *rg_conv_b, *rg_gate_a_w, *rg_gate_a_b, *rg_gate_x_w, *rg_gate_x_b, *rg_lambda,
      *gla_alpha_w2, *gla_alpha_b, *gla_norm, *rw_mu, *rw_w0, *rw_w2, *rw_a0, *rw_a2, *rw_g2, *rw_k_k, *rw_k_a,
      *rw_r_k, *rw_ln_w, *rw_ln_b;
  float* out;
  char* ws;
};

extern __shared__ __attribute__((aligned(16))) char g_smem[];

DEV const float* kparg(int off) {
  const char __attribute__((address_space(4)))* kp =
      (const char __attribute__((address_space(4)))*)__builtin_amdgcn_kernarg_segment_ptr();
  return *(const float* volatile const __attribute__((address_space(4)))*)(kp + off);
}
#define KP(name) kparg((int)__builtin_offsetof(Params, name))
#define KWS ((char*)kparg((int)__builtin_offsetof(Params, ws)))
#define KOUT ((float*)kparg((int)__builtin_offsetof(Params, out)))
struct PTag {};

DEV int my_tid() {
  int t = threadIdx.x;
  asm volatile("" : "+v"(t));
  return t;
}
DEV int my_bid() {
  int b = blockIdx.x;
  asm volatile("" : "+s"(b));
  return b;
}
DEV float bf2f(u16 u) { return __uint_as_float(((unsigned)u) << 16); }
typedef float v2f_ __attribute__((ext_vector_type(2)));
typedef __bf16 v2bf_ __attribute__((ext_vector_type(2)));
DEV unsigned pack2(float a, float b) {
  v2f_ f = {a, b};
  v2bf_ h = __builtin_convertvector(f, v2bf_);
  return __builtin_bit_cast(unsigned, h);
}
DEV u16 f2bf(float f) { return (u16)(pack2(f, 0.f) & 0xffffu); }
DEV float lo2f(unsigned u) { return __uint_as_float(u << 16); }
DEV float hi2f(unsigned u) { return __uint_as_float(u & 0xffff0000u); }
DEV float wave_sum(float v);
DEV float sigmoidf_(float x) { return __builtin_amdgcn_rcpf(1.f + __expf(-x)); }
DEV float siluf_(float x) { return x * __builtin_amdgcn_rcpf(1.f + __expf(-x)); }
DEV float tanhf_(float x) { return 1.f - 2.f * __builtin_amdgcn_rcpf(1.f + __expf(2.f * x)); }
DEV float log_sigmoidf_(float x) { return fminf(x, 0.f) - __logf(1.f + __expf(-fabsf(x))); }
template <int CTRL>
DEV float dpp_f(float x) {
  return __int_as_float(__builtin_amdgcn_update_dpp(0, __float_as_int(x), CTRL, 0xf, 0xf, true));
}
DEV float quad_sum(float x) {
  x += dpp_f<0xB1>(x);
  x += dpp_f<0x4E>(x);
  return x;
}
DEV float oct_sum(float x) {
  x = quad_sum(x);
  x += dpp_f<0x141>(x);
  return x;
}
DEV float wave_sum(float x) {
  x = quad_sum(x);
  x += dpp_f<0x141>(x);
  x += dpp_f<0x140>(x);
  float r0 = __int_as_float(__builtin_amdgcn_readlane(__float_as_int(x), 0));
  float r1 = __int_as_float(__builtin_amdgcn_readlane(__float_as_int(x), 16));
  float r2 = __int_as_float(__builtin_amdgcn_readlane(__float_as_int(x), 32));
  float r3 = __int_as_float(__builtin_amdgcn_readlane(__float_as_int(x), 48));
  return (r0 + r1) + (r2 + r3);
}
DEV int seq_row(int b, int dir, int s) {
  if (s < 256) {
    int t = dir ? 255 - s : s;
    return NLAT + b * 256 + t;
  }
  int t = s - 256;
  t = dir ? 4095 - t : t;
  return b * 4096 + t;
}

DEV void phase_adaln(PTag p) {
  const int ltid = my_tid();
  const int lbid = my_bid();
  (void)ltid; (void)lbid;
  float* sc = (float*)g_smem;
  float* red = sc + 9 * 1024;
  float* mod = (float*)(KWS + OFF_MOD);
  const int tid = ltid;
  for (int i = tid; i < 9 * 1024; i += NTHREADS) {
    int m = i >> 10, k = i & 1023;
    float v = (m < 8) ? KP(c)[m * 1024 + k] : KP(c_ctx)[k];
    sc[i] = siluf_(v);
  }
  __syncthreads();
  for (int job = lbid; job < 256; job += gridDim.x) {
    int l = job >> 6, j0 = (job & 63) * 144;
    const float* W = KP(w_mod) + (size_t)l * 1024 * 9216;
    int cgp = tid % 36, ig = tid / 36;
    if (tid < 504) {
      float acc[9][4];
#pragma unroll
      for (int m = 0; m < 9; ++m)
#pragma unroll
        for (int q = 0; q < 4; ++q) acc[m][q] = 0.f;
#pragma unroll 4
      for (int i = ig; i < 1024; i += 14) {
        const f32x4 wv_ = __builtin_nontemporal_load((const f32x4*)(W + (size_t)i * 9216 + j0 + cgp * 4));
        float4 w4 = make_float4(wv_[0], wv_[1], wv_[2], wv_[3]);
#pragma unroll
        for (int m = 0; m < 9; ++m) {
          float s = sc[m * 1024 + i];
          acc[m][0] += s * w4.x;
          acc[m][1] += s * w4.y;
          acc[m][2] += s * w4.z;
          acc[m][3] += s * w4.w;
        }
      }
#pragma unroll
      for (int m = 0; m < 9; ++m)
#pragma unroll
        for (int q = 0; q < 4; ++q) red[(ig * 9 + m) * 144 + cgp * 4 + q] = acc[m][q];
    }
    __syncthreads();
    for (int o = tid; o < 9 * 144; o += NTHREADS) {
      int m = o / 144, cc = o % 144;
      float s = KP(b_mod)[l * 9216 + j0 + cc];
#pragma unroll
      for (int g = 0; g < 14; ++g) s += red[(g * 9 + m) * 144 + cc];
      mod[(size_t)(l * 9 + m) * 9216 + j0 + cc] = s;
    }
    __syncthreads();
  }
}

DEV void conv_job(const float* srcA, const float* srcB, int interleave, int ld, int Kvalid, int Nvalid, u16* dst,
                  int Kdst, int Ndst, int& tb) {
  const int ltid = my_tid();
  const int lbid = my_bid();
  float* tile = (float*)g_smem;
  const int tid = ltid;
  int tk = (Kdst + 63) / 64, nt = (Ndst / 64) * tk;
  int G = gridDim.x;
  int start = (((int)lbid - (tb % G)) % G + G) % G;
  tb += nt;
  if (start >= nt) return;
  const int nl = tid & 63;
  auto loadt = [&](int t, float (&v)[8]) __attribute__((always_inline)) {
    int nn0 = (t / tk) * 64, k0 = (t % tk) * 64;
    int nn = nn0 + nl;
    const float* src;
    int col;
    bool nv;
    if (interleave) {
      int g = nn >> 5, w = nn & 31;
      col = g * 16 + (w & 15);
      src = (w < 16) ? srcA : srcB;
      nv = true;
    } else {
      col = nn;
      src = srcA;
      nv = nn < Nvalid;
    }
#pragma unroll
    for (int pass = 0; pass < 8; ++pass) {
      int k = k0 + pass * 8 + (tid >> 6);
      v[pass] = (nv && k < Kvalid) ? __builtin_nontemporal_load(src + (size_t)k * ld + col) : 0.f;
    }
  };
  float cur[8];
  loadt(start, cur);
  for (int t = start; t < nt; t += G) {
    float nxt[8];
    loadt((t + G < nt) ? t + G : t, nxt);
    int nn0 = (t / tk) * 64, k0 = (t % tk) * 64;
#pragma unroll
    for (int pass = 0; pass < 8; ++pass) tile[nl * 65 + pass * 8 + (tid >> 6)] = cur[pass];
    __syncthreads();
    {
      int nl2 = tid >> 3, kc = tid & 7;
      int k = k0 + kc * 8;
      if (k < Kdst) {
        const float* tp = tile + nl2 * 65 + kc * 8;
        uint4 o;
        o.x = pack2(tp[0], tp[1]);
        o.y = pack2(tp[2], tp[3]);
        o.z = pack2(tp[4], tp[5]);
        o.w = pack2(tp[6], tp[7]);
        *(uint4*)(dst + (size_t)(nn0 + nl2) * Kdst + k) = o;
      }
    }
    __syncthreads();
#pragma unroll
    for (int pass = 0; pass < 8; ++pass) cur[pass] = nxt[pass];
  }
}

DEV void conv_ffn(PTag p, int l, int f) {
  int tb = 0;
  u16* wb = (u16*)(KWS + OFF_WB);
  size_t o13 = ((size_t)(l * 2 + f)) * 1024 * 2816;
  conv_job(KP(ffn_w1) + o13, KP(ffn_w3) + o13, 1, 2816, 1024, 5632, (u16*)((char*)wb + WB_W13T), 1024, 5632, tb);
  conv_job(KP(ffn_w2) + o13, nullptr, 0, 1024, 2816, 1024, (u16*)((char*)wb + WB_W2T), 2816, 1024, tb);
}
DEV void conv_mixer(PTag p, int l) {
  int tb = 0;
  char* wb = KWS + OFF_WB;
  conv_job(KP(w_in) + (size_t)l * 1024 * PIN, nullptr, 0, PIN, 1024, PIN, (u16*)(wb + WB_WINT), 1024, PINP, tb);
  conv_job(KP(w_out) + (size_t)l * 1024 * 1024, nullptr, 0, 1024, 1024, 1024, (u16*)(wb + WB_WOUTT), 1024, 1024, tb);
  for (int d = 0; d < 2; ++d) {
    conv_job(KP(rw_w2) + (size_t)(l * 2 + d) * 64 * 384, nullptr, 0, 384, 64, 384, (u16*)(wb + WB_RWW2T) + d * 384 * 64, 64,
             384, tb);
    conv_job(KP(rw_a2) + (size_t)(l * 2 + d) * 64 * 384, nullptr, 0, 384, 64, 384, (u16*)(wb + WB_RWA2T) + d * 384 * 64, 64,
             384, tb);
    conv_job(KP(gla_alpha_w2) + (size_t)(l * 2 + d) * 16 * 192, nullptr, 0, 192, 16, 192, (u16*)(wb + WB_GLAT) + d * 192 * 32,
             32, 192, tb);
    for (int h = 0; h < 4; ++h) {
      conv_job(KP(rg_gate_a_w) + (size_t)((l * 2 + d) * 4 + h) * 4096, nullptr, 0, 64, 64, 64,
               (u16*)(wb + WB_RGGT) + ((d * 2 + 0) * 4 + h) * 4096, 64, 64, tb);
      conv_job(KP(rg_gate_x_w) + (size_t)((l * 2 + d) * 4 + h) * 4096, nullptr, 0, 64, 64, 64,
               (u16*)(wb + WB_RGGT) + ((d * 2 + 1) * 4 + h) * 4096, 64, 64, tb);
    }
  }
  conv_job(KP(rw_g2) + (size_t)l * 128 * 384, nullptr, 0, 384, 128, 384, (u16*)(wb + WB_RWG2T), 128, 384, tb);
}

template <bool SPLITY, int NR>
DEV void phase_rows_t(PTag p, int init, int has_y, const float* gpost, const float* mod_gate, float coef,
                      int has_next, const float* gpre, const float* mod_shift, const float* mod_scale, int rbeg,
                      int rend) {
  const int ltid = my_tid();
  const int lbid = my_bid();
  const int lane = ltid & 63;
  const int gw = lbid * 8 + (ltid >> 6), nw = gridDim.x * 8;
  float* hc = (float*)(KWS + OFF_HC);
  const u16* Y = (const u16*)(KWS + OFF_Y);
  u16* XN = (u16*)(KWS + OFF_XN);
  float* outp = KOUT;
  const float* xin = KP(x);
  const float* cin = KP(ctx);
  float4 gpo[4], gpr[4];
#pragma unroll
  for (int i = 0; i < 4; ++i) {
    gpo[i] = has_y ? ((const float4*)gpost)[lane + 64 * i] : make_float4(0.f, 0.f, 0.f, 0.f);
    gpr[i] = has_next ? ((const float4*)gpre)[lane + 64 * i] : make_float4(0.f, 0.f, 0.f, 0.f);
  }
  for (int row0 = rbeg + gw; row0 < rend; row0 += NR * nw) {
    float4 h[NR][4], g[NR][4], sh[NR][4], sc[NR][4], y[NR][4];
    uint2 yr[NR][4];
    bool valid[NR];
    float* hp[NR];
    int rows[NR];
#pragma unroll
    for (int r = 0; r < NR; ++r) {
      int row = row0 + r * nw;
      valid[r] = row < rend;
      if (!valid[r]) row = row0;
      rows[r] = row;
      int m = row < NLAT ? (row >> 12) : 8;
      hp[r] = row < NLAT ? outp + (size_t)row * 1024 : hc + (size_t)(row - NLAT) * 1024;
      const float* src = hp[r];
      if (init) src = row < NLAT ? xin + (size_t)row * 1024 : cin + (size_t)(row - NLAT) * 1024;
#pragma unroll
      for (int i = 0; i < 4; ++i) {
        const f32x4 hv = __builtin_nontemporal_load((const f32x4*)src + lane + 64 * i);
        h[r][i] = make_float4(hv[0], hv[1], hv[2], hv[3]);
      }
      if (has_y) {
        if (SPLITY) {
          const float4* pr = (const float4*)((const float*)(KWS + OFF_AR + AR_PART) + (size_t)(row - NLAT) * 1024);
#pragma unroll
          for (int i = 0; i < 4; ++i) {
            float4 a = pr[lane + 64 * i], b = pr[(size_t)NCTXR * 256 + lane + 64 * i];
            float4 c = pr[(size_t)2 * NCTXR * 256 + lane + 64 * i], d = pr[(size_t)3 * NCTXR * 256 + lane + 64 * i];
            y[r][i].x = (a.x + b.x) + (c.x + d.x); y[r][i].y = (a.y + b.y) + (c.y + d.y);
            y[r][i].z = (a.z + b.z) + (c.z + d.z); y[r][i].w = (a.w + b.w) + (c.w + d.w);
          }
        } else {
#pragma unroll
          for (int i = 0; i < 4; ++i) yr[r][i] = ((const uint2*)(Y + (size_t)row * 1024))[lane + 64 * i];
        }
#pragma unroll
        for (int i = 0; i < 4; ++i) g[r][i] = ((const float4*)(mod_gate + (size_t)m * 9216))[lane + 64 * i];
      }
      if (has_next) {
#pragma unroll
        for (int i = 0; i < 4; ++i) {
          sh[r][i] = ((const float4*)(mod_shift + (size_t)m * 9216))[lane + 64 * i];
          sc[r][i] = ((const float4*)(mod_scale + (size_t)m * 9216))[lane + 64 * i];
        }
      }
    }
#pragma unroll
    for (int r = 0; r < NR; ++r) {
      if (has_y) {
        float ss = 0.f;
#pragma unroll
        for (int i = 0; i < 4; ++i) {
          if (!SPLITY) {
            uint2 u = yr[r][i];
            y[r][i].x = lo2f(u.x); y[r][i].y = hi2f(u.x); y[r][i].z = lo2f(u.y); y[r][i].w = hi2f(u.y);
          }
          ss += y[r][i].x * y[r][i].x + y[r][i].y * y[r][i].y + y[r][i].z * y[r][i].z + y[r][i].w * y[r][i].w;
        }
        ss = wave_sum(ss);
        float rs = rsqrtf(ss * (1.f / 1024.f) + 1e-6f) * coef;
#pragma unroll
        for (int i = 0; i < 4; ++i) {
          h[r][i].x += g[r][i].x * (y[r][i].x * rs * gpo[i].x);
          h[r][i].y += g[r][i].y * (y[r][i].y * rs * gpo[i].y);
          h[r][i].z += g[r][i].z * (y[r][i].z * rs * gpo[i].z);
          h[r][i].w += g[r][i].w * (y[r][i].w * rs * gpo[i].w);
        }
      }
    }
#pragma unroll
    for (int r = 0; r < NR; ++r) {
      if ((init || has_y) && valid[r]) {
#pragma unroll
        for (int i = 0; i < 4; ++i)
          __builtin_nontemporal_store(f32x4{h[r][i].x, h[r][i].y, h[r][i].z, h[r][i].w}, (f32x4*)hp[r] + lane + 64 * i);
      }
      if (has_next) {
        float ss = 0.f;
#pragma unroll
        for (int i = 0; i < 4; ++i)
          ss += h[r][i].x * h[r][i].x + h[r][i].y * h[r][i].y + h[r][i].z * h[r][i].z + h[r][i].w * h[r][i].w;
        ss = wave_sum(ss);
        float rs = rsqrtf(ss * (1.f / 1024.f) + 1e-6f);
        if (valid[r]) {
#pragma unroll
          for (int i = 0; i < 4; ++i) {
            float a = (h[r][i].x * rs * gpr[i].x) * (1.f + sc[r][i].x) + sh[r][i].x;
            float b = (h[r][i].y * rs * gpr[i].y) * (1.f + sc[r][i].y) + sh[r][i].y;
            float c = (h[r][i].z * rs * gpr[i].z) * (1.f + sc[r][i].z) + sh[r][i].z;
            float d = (h[r][i].w * rs * gpr[i].w) * (1.f + sc[r][i].w) + sh[r][i].w;
            uint2 o;
            o.x = pack2(a, b);
            o.y = pack2(c, d);
            ((uint2*)(XN + (size_t)rows[r] * 1024))[lane + 64 * i] = o;
          }
        }
      }
    }
  }
}
DEV void phase_rows(PTag p, int init, int has_y, const float* gpost, const float* mod_gate, float coef,
                    int has_next, const float* gpre, const float* mod_shift, const float* mod_scale, int Mrows,
                    int ysplit = 0) {
  if (ysplit && Mrows > NLAT) {
    phase_rows_t<false, 2>(p, init, has_y, gpost, mod_gate, coef, has_next, gpre, mod_shift, mod_scale, 0, NLAT);
    phase_rows_t<true, 1>(p, init, has_y, gpost, mod_gate, coef, has_next, gpre, mod_shift, mod_scale, NLAT, Mrows);
  } else {
    phase_rows_t<false, 2>(p, init, has_y, gpost, mod_gate, coef, has_next, gpre, mod_shift, mod_scale, 0, Mrows);
  }
}

constexpr int BM = 256, BK = 64, HALF = 128, HT = HALF * BK;
DEV int lds_byte(int r, int c) {
  int st = (r >> 4) * 2 + (c >> 5), rr = r & 15, cc = c & 31, ob = rr * 64 + cc * 2;
  return st * 1024 + (ob ^ (((ob >> 9) & 1) << 5));
}
DEV void stage_rc(int b, int& R, int& C) {
  int st = b / 1024, sb = b % 1024, swz = sb ^ (((sb >> 9) & 1) << 5);
  R = (st >> 1) * 16 + swz / 64;
  C = (st & 1) * 32 + (swz % 64) / 2;
}
enum { EPI_UP = 0, EPI_Y = 1, EPI_Z = 2 };

template <int K, int EPI, bool SPLIT = false>
DEV void gemm_phase(const u16* __restrict__ A, const u16* __restrict__ Bt, int M, int N, u16* __restrict__ O0,
                    u16* __restrict__ O1, int nsplit_rowtiles = 0, float* __restrict__ Pp = nullptr) {
  const int ltid = my_tid();
  const int lbid = my_bid();
  (void)ltid; (void)lbid;
  u16* shm = (u16*)g_smem;
#define SA(b, h) (shm + ((b) * 2 + (h)) * HT)
#define SB(b, h) (shm + (4 + (b) * 2 + (h)) * HT)
#define STAGE(P, GB, kc)                                                                                        \
  do {                                                                                                           \
    __builtin_amdgcn_global_load_lds((const unsigned*)((const char*)(GB) + vb0 + (kc) * (BK * 2)),              \
                                     (unsigned*)((char*)(P) + wbase), 16, 0, 0);                                 \
    __builtin_amdgcn_global_load_lds((const unsigned*)((const char*)(GB) + vb1 + (kc) * (BK * 2)),              \
                                     (unsigned*)((char*)(P) + wbase + 8192), 16, 0, 0);                          \
  } while (0)
#define LDA(dst, b, h)                                                                                 \
  for (int m = 0; m < 4; ++m)                                                                          \
    for (int k = 0; k < 2; ++k)                                                                        \
  dst[m][k] = *reinterpret_cast<const bf16x8*>(aBase + (((b) * 2 + (h)) * 16384 + m * 2048 + k * 1024))
#define LDB(dst, b, h)                                                                                 \
  for (int n = 0; n < 2; ++n)                                                                          \
    for (int k = 0; k < 2; ++k)                                                                        \
  dst[n][k] = *reinterpret_cast<const bf16x8*>(bBase + (((b) * 2 + (h)) * 16384 + n * 2048 + k * 1024))
#define MMA(ai, bj, At_, Bt_)                                                                          \
  do {                                                                                                 \
    __builtin_amdgcn_s_setprio(1);                                                                     \
    for (int m = 0; m < 4; ++m)                                                                        \
      for (int n = 0; n < 2; ++n)                                                                      \
        for (int k = 0; k < 2; ++k)                                                                    \
          acc[ai][bj][m][n] =                                                                          \
              __builtin_amdgcn_mfma_f32_16x16x32_bf16(At_[m][k], Bt_[n][k], acc[ai][bj][m][n], 0, 0, 0); \
    __builtin_amdgcn_s_setprio(0);                                                                     \
  } while (0)
#define WAIT_V(n) asm volatile("s_waitcnt vmcnt(" #n ")" ::: "memory")
#define WAIT_L(n) asm volatile("s_waitcnt lgkmcnt(" #n ")" ::: "memory")
#define BAR __builtin_amdgcn_s_barrier()
#define SCHED __builtin_amdgcn_sched_barrier(0)

  const int tid = ltid;
  const int tid16 = tid * 16;
  unsigned off0, off1;
  {
    int r, c;
    stage_rc(tid16, r, c);
    off0 = (unsigned)(r * K + c) * 2u;
    stage_rc(tid16 + 8192, r, c);
    off1 = (unsigned)(r * K + c) * 2u;
  }
  const int wbase = __builtin_amdgcn_readfirstlane(tid >> 6) * 1024;
  const int wid = tid >> 6, lane = tid & 63, wr = wid >> 2, wc = wid & 3, fr = lane & 15, fq = lane >> 4;
  const int nM = M / BM, nN = N / BM, nwg = nM * nN;
  const int lo_ = lds_byte(fr, fq * 8);
  const char* aBase = (const char*)g_smem + wr * 8192 + lo_;
  const char* bBase = (const char*)g_smem + 65536 + wc * 4096 + lo_;
  constexpr int WGM = 8;
  const int nitems = SPLIT ? nsplit_rowtiles * nN * 4 : nwg;
  const int lb2 = SPLIT ? (lbid + 128) % (int)gridDim.x : lbid;
  for (int tix = lb2; tix < nitems; tix += gridDim.x) {
    int brow, bcol, nt, kbeg, schunk;
    if (!SPLIT) {
      int wgid = tix;
      {
        int q = nwg / 8, r = nwg % 8, xcd = wgid % 8, off = wgid / 8;
        wgid = (xcd < r ? xcd * (q + 1) : r * (q + 1) + (xcd - r) * q) + off;
      }
      int nig = WGM * nN, gid = wgid / nig, fm = gid * WGM, gsz = min(nM - fm, WGM);
      int pm = fm + ((wgid % nig) % gsz), pn = (wgid % nig) / gsz;
      brow = pm * BM;
      bcol = pn * BM;
      nt = K / BK;
      kbeg = 0;
      schunk = -1;
    } else {
      schunk = tix & 3;
      int ct = tix >> 2;
      brow = M + (ct / nN) * BM;
      bcol = (ct % nN) * BM;
      constexpr int q4 = ((K / BK) / 8) * 2;
      kbeg = (schunk < 2) ? schunk * q4 : 2 * q4 + (schunk - 2) * ((K / BK - 2 * q4) / 2);
      nt = (schunk < 2) ? q4 : (K / BK - 2 * q4) / 2;
    }
    f32x4 acc[2][2][4][2];
#pragma unroll
    for (int a = 0; a < 2; ++a)
#pragma unroll
      for (int b = 0; b < 2; ++b)
#pragma unroll
        for (int m = 0; m < 4; ++m)
#pragma unroll
          for (int n = 0; n < 2; ++n) acc[a][b][m][n] = f32x4{0.f, 0.f, 0.f, 0.f};
    bf16x8 At[4][2], B0[2][2], B1[2][2];
    const u16* gA0 = A + (size_t)brow * K + kbeg * BK;
    const u16* gA1 = gA0 + (size_t)HALF * K;
    const u16* gB0 = Bt + (size_t)bcol * K + kbeg * BK;
    const u16* gB1 = gB0 + (size_t)HALF * K;
    unsigned vb0 = off0, vb1 = off1;
    STAGE(SB(0, 0), gB0, 0);
    STAGE(SA(0, 0), gA0, 0);
    STAGE(SB(0, 1), gB1, 0);
    STAGE(SA(0, 1), gA1, 0);
    if (wr == 1) BAR;
    WAIT_V(4);
    BAR;
    STAGE(SB(1, 0), gB0, 1);
    STAGE(SA(1, 0), gA0, 1);
    STAGE(SB(1, 1), gB1, 1);
    WAIT_V(6);
    BAR;
#pragma unroll 1
    for (int t = 0; t < nt - 2; t += 2, vb0 += 2 * BK * 2, vb1 += 2 * BK * 2) {
      LDB(B0, 0, 0); SCHED; LDA(At, 0, 0); STAGE(SA(1, 1), gA1, 1);
      WAIT_L(8); BAR; WAIT_L(0); MMA(0, 0, At, B0); BAR; SCHED;
      LDB(B1, 0, 1); STAGE(SB(0, 0), gB0, 2);
      BAR; WAIT_L(0); MMA(0, 1, At, B1); BAR;
      LDA(At, 0, 1); STAGE(SA(0, 0), gA0, 2);
      BAR; WAIT_L(0); MMA(1, 0, At, B0); BAR; SCHED;
      STAGE(SB(0, 1), gB1, 2);
      WAIT_V(6); BAR; MMA(1, 1, At, B1); BAR;
      LDB(B0, 1, 0); SCHED; LDA(At, 1, 0); STAGE(SA(0, 1), gA1, 2);
      WAIT_L(8); BAR; WAIT_L(0); MMA(0, 0, At, B0); BAR; SCHED;
      LDB(B1, 1, 1); STAGE(SB(1, 0), gB0, 3);
      BAR; WAIT_L(0); MMA(0, 1, At, B1); BAR;
      LDA(At, 1, 1); STAGE(SA(1, 0), gA0, 3);
      BAR; WAIT_L(0); MMA(1, 0, At, B0); BAR; SCHED;
      STAGE(SB(1, 1), gB1, 3);
      WAIT_V(6); BAR; MMA(1, 1, At, B1); BAR;
    }
    {
      LDB(B0, 0, 0); LDA(At, 0, 0); STAGE(SA(1, 1), gA1, 1);
      BAR; WAIT_L(0); MMA(0, 0, At, B0); BAR;
      LDB(B1, 0, 1); BAR; WAIT_L(0); MMA(0, 1, At, B1); BAR;
      LDA(At, 0, 1); WAIT_V(4); BAR; WAIT_L(0); MMA(1, 0, At, B0); MMA(1, 1, At, B1); BAR;
    }
    {
      LDB(B0, 1, 0); LDA(At, 1, 0); WAIT_V(2); BAR; WAIT_L(0); MMA(0, 0, At, B0); BAR;
      LDB(B1, 1, 1); WAIT_V(0); BAR; WAIT_L(0); MMA(0, 1, At, B1); BAR;
      LDA(At, 1, 1); BAR; WAIT_L(0); MMA(1, 0, At, B0); MMA(1, 1, At, B1); BAR;
    }
    if (wr == 0) BAR;
#pragma unroll
    for (int ai = 0; ai < 2; ++ai)
#pragma unroll
      for (int bj = 0; bj < 2; ++bj)
#pragma unroll
        for (int m = 0; m < 4; ++m) {
          int rowb = brow + ai * HALF + wr * 64 + m * 16 + fq * 4;
          if (EPI == EPI_UP) {
            int hcol = ((bcol + bj * HALF + wc * 32) >> 1) + fr;
#pragma unroll
            for (int j = 0; j < 4; ++j) {
              float a = acc[ai][bj][m][0][j], b = acc[ai][bj][m][1][j];
              O0[(size_t)(rowb + j) * DFF + hcol] = f2bf(siluf_(a) * b);
            }
          } else {
#pragma unroll
            for (int n = 0; n < 2; ++n) {
              int col = bcol + bj * HALF + wc * 32 + n * 16 + fr;
#pragma unroll
              for (int j = 0; j < 4; ++j) {
                float v = acc[ai][bj][m][n][j];
                if (EPI == EPI_Y) {
                  if (!SPLIT) O0[(size_t)(rowb + j) * DM + col] = f2bf(v);
                  else Pp[((size_t)schunk * NCTXR + (size_t)(rowb + j - M)) * DM + col] = v;
                } else {
                  if (col < Z1W) O0[(size_t)(rowb + j) * Z1W + col] = f2bf(v);
                  else if (col < PIN) O1[(size_t)(rowb + j) * Z2W + (col - Z1W)] = f2bf(v);
                }
              }
            }
          }
        }
  }
#undef SA
#undef SB
#undef STAGE
#undef LDA
#undef LDB
#undef MMA
}

DEV bf16x8 ld_frag_g(const u16* p) { return *reinterpret_cast<const bf16x8*>(p); }
DEV bf16x8 ld_frag_s(const u16* p) { return *reinterpret_cast<const bf16x8*>(p); }

constexpr int ALD = 392;
constexpr int XLD = 264;
constexpr int GLD = 40;

DEV void phase_prep(PTag p, int l) {
  const int ltid = my_tid();
  const int lbid = my_bid();
  (void)ltid; (void)lbid;
  const int tid = ltid, lane = tid & 63, wid = tid >> 6;
  const int fr = lane & 15, fq = lane >> 4;
  char* ar = KWS + OFF_AR;
  const u16* Z1 = (const u16*)(ar + AR_Z1);
  const u16* Z2 = (const u16*)(ar + AR_Z2);
  u16* RWP = (u16*)(ar + AR_RWP);
  u16* LA = (u16*)(ar + AR_LA);
  float* invn = (float*)(KWS + OFF_INVN);
  u16* Gout = (u16*)(KWS + OFF_Y);
  u16* RGP = (u16*)(KWS + OFF_XN);
  const char* wb = KWS + OFF_WB;
  u16* A_lds = (u16*)g_smem;
  u16* X_lds = (u16*)(g_smem + 50176);
  u16* Gl_lds = (u16*)(g_smem + 50176 + 33792);
  const float* mu = KP(rw_mu) + (size_t)l * 1536;
  const float* k_k = KP(rw_k_k) + (size_t)l * 384;

  const int Gp = gridDim.x;
  const int swz = (Gp % 8 == 0) ? (lbid % 8) * (Gp / 8) + lbid / 8 : lbid;
  for (int base = 0; base < NLAT / 64 + NCTXR / 32; base += Gp) {
    const int tile = base + ((base + Gp <= NLAT / 64) ? swz : lbid);
    if (tile >= NLAT / 64 + NCTXR / 32) continue;
    const int nrows = tile < NLAT / 64 ? 64 : 32;
    const int r0 = tile < NLAT / 64 ? tile * 64 : NLAT + (tile - NLAT / 64) * 32;
    const int nmt = nrows >> 4;
    const bool lat = r0 < NLAT;
    const int tpos0 = lat ? (r0 & 4095) : ((r0 - NLAT) & 255);
    const int seglen = lat ? 4096 : 256;
    for (int it0 = 0; it0 < (nrows * 192) / NTHREADS; it0 += 4) {
      uint4 own[4], n0[4], n1[4], n2[4], n3[4];
#pragma unroll
      for (int b4 = 0; b4 < 4; ++b4) {
        int q = (it0 + b4) * NTHREADS + tid;
        int i = q / 192, cc = q % 192, c0 = cc * 8;
        int row = r0 + i, tpos = tpos0 + i;
        const u16* zr = Z2 + (size_t)row * Z2W + c0;
        uint4 z4 = {0u, 0u, 0u, 0u};
        own[b4] = *(const uint4*)zr;
        n0[b4] = z4; n1[b4] = z4; n2[b4] = z4; n3[b4] = z4;
        if (lat) {
          int gcol = tpos & 63, grow = tpos >> 6;
          if (gcol > 0) n0[b4] = *(const uint4*)(zr - Z2W);
          if (gcol < 63) n1[b4] = *(const uint4*)(zr + Z2W);
          if (grow > 0) n2[b4] = *(const uint4*)(zr - 64 * Z2W);
          if (grow < 63) n3[b4] = *(const uint4*)(zr + 64 * Z2W);
        } else {
          if (tpos > 0) n0[b4] = *(const uint4*)(zr - Z2W);
          if (tpos < 255) n1[b4] = *(const uint4*)(zr + Z2W);
          n2[b4] = n0[b4];
          n3[b4] = n1[b4];
        }
      }
#pragma unroll
      for (int b4 = 0; b4 < 4; ++b4) {
        int q = (it0 + b4) * NTHREADS + tid;
        int i = q / 192, cc = q % 192, c0 = cc * 8;
        int row = r0 + i;
        float4 mu0 = *(const float4*)(mu + c0), mu1 = *(const float4*)(mu + c0 + 4);
        float f[8];
        {
          float o0 = lo2f(own[b4].x), o1 = hi2f(own[b4].x), o2 = lo2f(own[b4].y), o3 = hi2f(own[b4].y);
          float o4 = lo2f(own[b4].z), o5 = hi2f(own[b4].z), o6 = lo2f(own[b4].w), o7 = hi2f(own[b4].w);
          float s0 = lo2f(n0[b4].x), s1 = hi2f(n1[b4].x), s2 = lo2f(n2[b4].y), s3 = hi2f(n3[b4].y);
          float s4 = lo2f(n0[b4].z), s5 = hi2f(n1[b4].z), s6 = lo2f(n2[b4].w), s7 = hi2f(n3[b4].w);
          f[0] = o0 + mu0.x * (s0 - o0);
          f[1] = o1 + mu0.y * (s1 - o1);
          f[2] = o2 + mu0.z * (s2 - o2);
          f[3] = o3 + mu0.w * (s3 - o3);
          f[4] = o4 + mu1.x * (s4 - o4);
          f[5] = o5 + mu1.y * (s5 - o5);
          f[6] = o6 + mu1.z * (s6 - o6);
          f[7] = o7 + mu1.w * (s7 - o7);
        }
        if (c0 < 1152) {
          int arr = c0 / 384, cin = c0 % 384;
          uint4 o;
          o.x = pack2(f[0], f[1]); o.y = pack2(f[2], f[3]); o.z = pack2(f[4], f[5]); o.w = pack2(f[6], f[7]);
          *(uint4*)(RWP + (size_t)arr * NT * 384 + (size_t)row * 384 + cin) = o;
          if (arr == 1) {
            float4 kk0 = *(const float4*)(k_k + cin), kk1 = *(const float4*)(k_k + cin + 4);
            float a0 = f[0] * kk0.x, a1 = f[1] * kk0.y, a2 = f[2] * kk0.z, a3 = f[3] * kk0.w;
            float a4 = f[4] * kk1.x, a5 = f[5] * kk1.y, a6 = f[6] * kk1.z, a7 = f[7] * kk1.w;
            float ss = a0 * a0 + a1 * a1 + a2 * a2 + a3 * a3 + a4 * a4 + a5 * a5 + a6 * a6 + a7 * a7;
            ss = oct_sum(ss);
            if ((lane & 7) == 0) invn[(size_t)row * 8 + (cin >> 6)] = 1.f / fmaxf(sqrtf(ss), 1e-12f);
          }
        } else {
          int cl = c0 - 1152;
          if (cl < 128) {
#pragma unroll
            for (int e = 0; e < 8; ++e) f[e] = tanhf_(f[e]);
          } else if (cl >= 256) {
#pragma unroll
            for (int e = 0; e < 8; ++e) f[e] = sigmoidf_(f[e]);
          }
          uint4 o;
          o.x = pack2(f[0], f[1]); o.y = pack2(f[2], f[3]); o.z = pack2(f[4], f[5]); o.w = pack2(f[6], f[7]);
          *(uint4*)(A_lds + i * ALD + cl) = o;
        }
      }
    }
    {
      const float* cw = KP(rg_conv_w) + (size_t)l * 4 * 256;
      const float* cb = KP(rg_conv_b) + (size_t)l * 256;
      for (int it = 0; it < nrows / 16; ++it) {
        int q = it * NTHREADS + tid;
        int i = q >> 5, c0 = (q & 31) * 8;
        int row = r0 + i, tpos = tpos0 + i;
        float accv[8];
        {
          float4 b0 = *(const float4*)(cb + c0), b1 = *(const float4*)(cb + c0 + 4);
          accv[0] = b0.x; accv[1] = b0.y; accv[2] = b0.z; accv[3] = b0.w;
          accv[4] = b1.x; accv[5] = b1.y; accv[6] = b1.z; accv[7] = b1.w;
        }
#pragma unroll
        for (int j = 0; j < 4; ++j) {
          int tt = tpos + j - 2;
          if (tt >= 0 && tt < seglen) {
            uint4 xv = *(const uint4*)(Z1 + (size_t)(row + j - 2) * Z1W + c0);
            float4 w0 = *(const float4*)(cw + j * 256 + c0), w1 = *(const float4*)(cw + j * 256 + c0 + 4);
            accv[0] += w0.x * lo2f(xv.x); accv[1] += w0.y * hi2f(xv.x);
            accv[2] += w0.z * lo2f(xv.y); accv[3] += w0.w * hi2f(xv.y);
            accv[4] += w1.x * lo2f(xv.z); accv[5] += w1.y * hi2f(xv.z);
            accv[6] += w1.z * lo2f(xv.w); accv[7] += w1.w * hi2f(xv.w);
          }
        }
        uint4 o;
        o.x = pack2(accv[0], accv[1]); o.y = pack2(accv[2], accv[3]);
        o.z = pack2(accv[4], accv[5]); o.w = pack2(accv[6], accv[7]);
        *(uint4*)(X_lds + i * XLD + c0) = o;
      }
      {
        int q = tid;
        int i = q >> 3, d = (q >> 2) & 1, ch = q & 3;
        uint4 o = {0u, 0u, 0u, 0u};
        if (ch < 2 && i < nrows) o = *(const uint4*)(Z1 + (size_t)(r0 + i) * Z1W + 1664 + d * 16 + ch * 8);
        *(uint4*)(Gl_lds + (d * 64 + i) * GLD + ch * 8) = o;
      }
    }
    __syncthreads();
    for (int u = wid; u < 120; u += 8) {
      int g = u / 24, ntile = u % 24, n0 = ntile * 16;
      int n = n0 + fr;
      int nc = n0 + fq * 4;
      f32x4 acc[4];
#pragma unroll
      for (int m = 0; m < 4; ++m) acc[m] = f32x4{0.f, 0.f, 0.f, 0.f};
      if (g < 4) {
        const u16* Bt = (const u16*)(wb + ((g < 2) ? WB_RWW2T : WB_RWA2T)) + (size_t)(g & 1) * 384 * 64;
        bf16x8 b0 = ld_frag_g(Bt + (size_t)n * 64 + fq * 8), b1 = ld_frag_g(Bt + (size_t)n * 64 + 32 + fq * 8);
#pragma unroll
        for (int m = 0; m < 4; ++m) if (m < nmt) {
          const u16* ap = A_lds + (m * 16 + fr) * ALD + g * 64 + fq * 8;
          acc[m] = __builtin_amdgcn_mfma_f32_16x16x32_bf16(b0, ld_frag_s(ap), acc[m], 0, 0, 0);
          acc[m] = __builtin_amdgcn_mfma_f32_16x16x32_bf16(b1, ld_frag_s(ap + 32), acc[m], 0, 0, 0);
        }
      } else {
        const u16* Bt = (const u16*)(wb + WB_RWG2T);
        bf16x8 b[4];
#pragma unroll
        for (int k = 0; k < 4; ++k) b[k] = ld_frag_g(Bt + (size_t)n * 128 + k * 32 + fq * 8);
#pragma unroll
        for (int m = 0; m < 4; ++m) if (m < nmt) {
          const u16* ap = A_lds + (m * 16 + fr) * ALD + 256 + fq * 8;
#pragma unroll
          for (int k = 0; k < 4; ++k)
            acc[m] = __builtin_amdgcn_mfma_f32_16x16x32_bf16(b[k], ld_frag_s(ap + k * 32), acc[m], 0, 0, 0);
        }
      }
      if (g < 2) {
        float4 w0v = *(const float4*)(KP(rw_w0) + (size_t)(l * 2 + g) * 384 + nc);
        u16* dst = RWP + (size_t)(3 + g) * NT * 384;
#pragma unroll
        for (int m = 0; m < 4; ++m) if (m < nmt) {
          int row = r0 + m * 16 + fr;
          uint2 o;
          o.x = pack2(sigmoidf_(w0v.x + acc[m][0]) * 0.60653066f, sigmoidf_(w0v.y + acc[m][1]) * 0.60653066f);
          o.y = pack2(sigmoidf_(w0v.z + acc[m][2]) * 0.60653066f, sigmoidf_(w0v.w + acc[m][3]) * 0.60653066f);
          *(uint2*)(dst + (size_t)row * 384 + nc) = o;
        }
      } else if (g < 4) {
        float4 a0v = *(const float4*)(KP(rw_a0) + (size_t)(l * 2 + (g - 2)) * 384 + nc);
        u16* dst = RWP + (size_t)(5 + (g - 2)) * NT * 384;
#pragma unroll
        for (int m = 0; m < 4; ++m) if (m < nmt) {
          int row = r0 + m * 16 + fr;
          uint2 o;
          o.x = pack2(sigmoidf_(a0v.x + acc[m][0]), sigmoidf_(a0v.y + acc[m][1]));
          o.y = pack2(sigmoidf_(a0v.z + acc[m][2]), sigmoidf_(a0v.w + acc[m][3]));
          *(uint2*)(dst + (size_t)row * 384 + nc) = o;
        }
      } else {
#pragma unroll
        for (int m = 0; m < 4; ++m) if (m < nmt) {
          int row = r0 + m * 16 + fr;
          uint2 o;
          o.x = pack2(acc[m][0], acc[m][1]);
          o.y = pack2(acc[m][2], acc[m][3]);
          *(uint2*)(Gout + (size_t)row * 384 + nc) = o;
        }
      }
    }
    for (int u = wid; u < 32; u += 8) {
      int d = u >> 4, hd = (u >> 2) & 3, ntile = u & 3;
      int nl = ntile * 16 + fr;
      int chc = hd * 64 + ntile * 16 + fq * 4;
      const u16* Ba = (const u16*)(wb + WB_RGGT) + (size_t)((d * 2 + 0) * 4 + hd) * 4096 + nl * 64;
      const u16* Bx = (const u16*)(wb + WB_RGGT) + (size_t)((d * 2 + 1) * 4 + hd) * 4096 + nl * 64;
      bf16x8 ba0 = ld_frag_g(Ba + fq * 8), ba1 = ld_frag_g(Ba + 32 + fq * 8);
      bf16x8 bx0 = ld_frag_g(Bx + fq * 8), bx1 = ld_frag_g(Bx + 32 + fq * 8);
      float4 gab = *(const float4*)(KP(rg_gate_a_b) + (size_t)(l * 2 + d) * 256 + chc);
      float4 gxb = *(const float4*)(KP(rg_gate_x_b) + (size_t)(l * 2 + d) * 256 + chc);
      float4 lam = *(const float4*)(KP(rg_lambda) + (size_t)(l * 2 + d) * 256 + chc);
      float spl[4] = {__logf(1.f + __expf(-lam.x)) * 8.f, __logf(1.f + __expf(-lam.y)) * 8.f,
                      __logf(1.f + __expf(-lam.z)) * 8.f, __logf(1.f + __expf(-lam.w)) * 8.f};
      float gabv[4] = {gab.x, gab.y, gab.z, gab.w}, gxbv[4] = {gxb.x, gxb.y, gxb.z, gxb.w};
      u16* dla = RGP + (size_t)(d * 2 + 0) * NT * 256;
      u16* dbx = RGP + (size_t)(d * 2 + 1) * NT * 256;
#pragma unroll
      for (int m = 0; m < 4; ++m) if (m < nmt) {
        const u16* ap = X_lds + (m * 16 + fr) * XLD + hd * 64 + fq * 8;
        bf16x8 a0 = ld_frag_s(ap), a1 = ld_frag_s(ap + 32);
        f32x4 ca = f32x4{0.f, 0.f, 0.f, 0.f}, cx = ca;
        ca = __builtin_amdgcn_mfma_f32_16x16x32_bf16(ba0, a0, ca, 0, 0, 0);
        ca = __builtin_amdgcn_mfma_f32_16x16x32_bf16(ba1, a1, ca, 0, 0, 0);
        cx = __builtin_amdgcn_mfma_f32_16x16x32_bf16(bx0, a0, cx, 0, 0, 0);
        cx = __builtin_amdgcn_mfma_f32_16x16x32_bf16(bx1, a1, cx, 0, 0, 0);
        int il = m * 16 + fr;
        int row = r0 + il;
        uint2 xcv = *(const uint2*)(X_lds + il * XLD + chc);
        float xc[4] = {lo2f(xcv.x), hi2f(xcv.x), lo2f(xcv.y), hi2f(xcv.y)};
        float la[4], bx[4];
#pragma unroll
        for (int j = 0; j < 4; ++j) {
          float r = sigmoidf_(ca[j] + gabv[j]), ig = sigmoidf_(cx[j] + gxbv[j]);
          float loga = -r * spl[j];
          float mult = __builtin_amdgcn_sqrtf(fmaxf(1.f - __expf(2.f * loga), 0.f));
          la[j] = loga;
          bx[j] = mult * ig * xc[j];
        }
        uint2 o;
        o.x = pack2(la[0], la[1]); o.y = pack2(la[2], la[3]);
        *(uint2*)(dla + (size_t)row * 256 + chc) = o;
        o.x = pack2(bx[0], bx[1]); o.y = pack2(bx[2], bx[3]);
        *(uint2*)(dbx + (size_t)row * 256 + chc) = o;
      }
    }
    for (int u = wid; u < 24; u += 8) {
      int d = u / 12, ntile = u % 12;
      int n = ntile * 16 + fr;
      int nc = ntile * 16 + fq * 4;
      const u16* Bt = (const u16*)(wb + WB_GLAT) + (size_t)d * 192 * 32;
      bf16x8 b0 = ld_frag_g(Bt + (size_t)n * 32 + fq * 8);
      float4 bb = *(const float4*)(KP(gla_alpha_b) + (size_t)(l * 2 + d) * 192 + nc);
      u16* dst = LA + (size_t)d * NT * 192;
#pragma unroll
      for (int m = 0; m < 4; ++m) if (m < nmt) {
        const u16* ap = Gl_lds + (d * 64 + m * 16 + fr) * GLD + fq * 8;
        f32x4 cacc = f32x4{0.f, 0.f, 0.f, 0.f};
        cacc = __builtin_amdgcn_mfma_f32_16x16x32_bf16(b0, ld_frag_s(ap), cacc, 0, 0, 0);
        int row = r0 + m * 16 + fr;
        uint2 o;
        o.x = pack2(log_sigmoidf_(cacc[0] + bb.x) * (1.f / 16.f), log_sigmoidf_(cacc[1] + bb.y) * (1.f / 16.f));
        o.y = pack2(log_sigmoidf_(cacc[2] + bb.z) * (1.f / 16.f), log_sigmoidf_(cacc[3] + bb.w) * (1.f / 16.f));
        *(uint2*)(dst + (size_t)row * 192 + nc) = o;
      }
    }
    __syncthreads();
  }
}

constexpr int TC = 32;
constexpr int NSTEP = 4352;
typedef float v2f __attribute__((ext_vector_type(2)));
DEV v2f pkfma(v2f a, v2f b, v2f c) { return __builtin_elementwise_fma(a, b, c); }
DEV float hex_sum(float x) {
  x = quad_sum(x);
  x += dpp_f<0x141>(x);
  x += dpp_f<0x140>(x);
  return x;
}
#define DPPADD(r, ctrl) "v_add_f32_dpp " r ", " r ", " r " " ctrl " row_mask:0xf bank_mask:0xf bound_ctrl:1\n\t"
DEV void hex_sum2(float& x, float& y) {
  asm volatile("s_nop 1\n\t"
               DPPADD("%0", "quad_perm:[1,0,3,2]") DPPADD("%1", "quad_perm:[1,0,3,2]") "s_nop 0\n\t"
               DPPADD("%0", "quad_perm:[2,3,0,1]") DPPADD("%1", "quad_perm:[2,3,0,1]") "s_nop 0\n\t"
               DPPADD("%0", "row_half_mirror") DPPADD("%1", "row_half_mirror") "s_nop 0\n\t"
               DPPADD("%0", "row_mirror") DPPADD("%1", "row_mirror")
               : "+v"(x), "+v"(y));
}
DEV void hex_sum4(float& a, float& b, float& c, float& d) {
  asm volatile("s_nop 1\n\t"
               DPPADD("%0", "quad_perm:[1,0,3,2]") DPPADD("%1", "quad_perm:[1,0,3,2]")
               DPPADD("%2", "quad_perm:[1,0,3,2]") DPPADD("%3", "quad_perm:[1,0,3,2]")
               DPPADD("%0", "quad_perm:[2,3,0,1]") DPPADD("%1", "quad_perm:[2,3,0,1]")
               DPPADD("%2", "quad_perm:[2,3,0,1]") DPPADD("%3", "quad_perm:[2,3,0,1]")
               DPPADD("%0", "row_half_mirror") DPPADD("%1", "row_half_mirror")
               DPPADD("%2", "row_half_mirror") DPPADD("%3", "row_half_mirror")
               DPPADD("%0", "row_mirror") DPPADD("%1", "row_mirror")
               DPPADD("%2", "row_mirror") DPPADD("%3", "row_mirror")
               : "+v"(a), "+v"(b), "+v"(c), "+v"(d));
}
DEV void oct_sum2(float& x, float& y) {
  asm volatile("s_nop 1\n\t"
               DPPADD("%0", "quad_perm:[1,0,3,2]") DPPADD("%1", "quad_perm:[1,0,3,2]") "s_nop 0\n\t"
               DPPADD("%0", "quad_perm:[2,3,0,1]") DPPADD("%1", "quad_perm:[2,3,0,1]") "s_nop 0\n\t"
               DPPADD("%0", "row_half_mirror") DPPADD("%1", "row_half_mirror")
               : "+v"(x), "+v"(y));
}
DEV void oct_sum3(float& a, float& b, float& c) {
  asm volatile("s_nop 1\n\t"
               DPPADD("%0", "quad_perm:[1,0,3,2]") DPPADD("%1", "quad_perm:[1,0,3,2]") DPPADD("%2", "quad_perm:[1,0,3,2]")
               DPPADD("%0", "quad_perm:[2,3,0,1]") DPPADD("%1", "quad_perm:[2,3,0,1]") DPPADD("%2", "quad_perm:[2,3,0,1]")
               DPPADD("%0", "row_half_mirror") DPPADD("%1", "row_half_mirror") DPPADD("%2", "row_half_mirror")
               : "+v"(a), "+v"(b), "+v"(c));
}

constexpr int RST = 392;
struct RwOps { float4 w, k, a, b, wr; float2 vv; float2 sc; };
struct RwOps8 { float4 w0, w1, k0, k1, a0, a1, b0, b1, r0, r1; float vv; float2 sc; };
DEV void scan_rwkv(PTag p, int l, int task) {
  const int ltid = my_tid();
  const int tid = ltid, lane = tid & 63, w = tid >> 6;
  const int half = task & 1, sc = task >> 1;
  const int b = sc / 12, h = (sc % 12) >> 1, dir = sc & 1;
  char* ar = KWS + OFF_AR;
  const u16* RWP = (const u16*)(ar + AR_RWP);
  const u16* Rg = RWP, *Kg = RWP + (size_t)NT * 384, *Vg = RWP + (size_t)2 * NT * 384;
  const u16* Ug = RWP + (size_t)(3 + dir) * NT * 384, *Ag = RWP + (size_t)(5 + dir) * NT * 384;
  const float* invn = (const float*)(KWS + OFF_INVN);
  u16* Yd = (u16*)(ar + AR_Z2) + (size_t)dir * NT * 384;
  float* buf = (float*)g_smem;
  float* ybuf = buf + 2 * TC * RST;
  const int rl = lane >> 3, kg = lane & 7;
  const int lrow = w * 8 + rl;
  const int lstep = tid >> 4, lq = tid & 15;
  const int ce = h * 64 + lq * 4;
  float4 kkc = *(const float4*)(KP(rw_k_k) + (size_t)l * 384 + ce);
  float4 kac = *(const float4*)(KP(rw_k_a) + (size_t)l * 384 + ce);
  v2f S0 = {0.f, 0.f}, S1 = {0.f, 0.f}, S2 = {0.f, 0.f}, S3 = {0.f, 0.f};

  uint2 gr, gk, gv, gu, ga;
  float gin;
  auto issue = [&](int c) {
    int row = seq_row(b, dir, c * TC + lstep);
    size_t o = (size_t)row * 384 + ce;
    gr = *(const uint2*)(Rg + o);
    gk = *(const uint2*)(Kg + o);
    gv = *(const uint2*)(Vg + o);
    gu = *(const uint2*)(Ug + o);
    ga = *(const uint2*)(Ag + o);
    gin = invn[(size_t)row * 8 + h];
  };
  auto commit = [&](int c, int) {
    float* d = buf + (size_t)((c & 1) * TC + lstep) * RST;
    float r0 = lo2f(gr.x), r1 = hi2f(gr.x), r2 = lo2f(gr.y), r3 = hi2f(gr.y);
    float k0 = lo2f(gk.x), k1 = hi2f(gk.x), k2 = lo2f(gk.y), k3 = hi2f(gk.y);
    float v0 = lo2f(gv.x), v1 = hi2f(gv.x), v2 = lo2f(gv.y), v3 = hi2f(gv.y);
    float u0 = lo2f(gu.x), u1 = hi2f(gu.x), u2 = lo2f(gu.y), u3 = hi2f(gu.y);
    float a0 = lo2f(ga.x), a1 = hi2f(ga.x), a2 = lo2f(ga.y), a3 = hi2f(ga.y);
    float w0 = __expf(-u0), w1 = __expf(-u1), w2 = __expf(-u2), w3 = __expf(-u3);
    float d0 = k0 * (1.f + (a0 - 1.f) * kac.x), d1 = k1 * (1.f + (a1 - 1.f) * kac.y);
    float d2 = k2 * (1.f + (a2 - 1.f) * kac.z), d3 = k3 * (1.f + (a3 - 1.f) * kac.w);
    float q0 = k0 * kkc.x * gin, q1 = k1 * kkc.y * gin, q2 = k2 * kkc.z * gin, q3 = k3 * kkc.w * gin;
    float b0 = q0 * a0, b1 = q1 * a1, b2 = q2 * a2, b3 = q3 * a3;
    *(float4*)(d + lq * 4) = make_float4(w0, w1, w2, w3);
    *(float4*)(d + 64 + lq * 4) = make_float4(d0, d1, d2, d3);
    *(float4*)(d + 128 + lq * 4) = make_float4(-q0, -q1, -q2, -q3);
    *(float4*)(d + 192 + lq * 4) = make_float4(b0, b1, b2, b3);
    *(float4*)(d + 256 + lq * 4) = make_float4(w0 * r0, w1 * r1, w2 * r2, w3 * r3);
    *(float4*)(d + 320 + lq * 4) = make_float4(v0, v1, v2, v3);
    float br = b0 * r0 + b1 * r1 + b2 * r2 + b3 * r3;
    float kr = d0 * r0 + d1 * r1 + d2 * r2 + d3 * r3;
    hex_sum2(br, kr);
    if (lq == 0) *(float2*)(d + 384) = make_float2(br, kr);
  };
  issue(0);
  commit(0, 0);
  __syncthreads();
  constexpr int NCH = NSTEP / TC;
#pragma unroll 1
  for (int c = 0; c < NCH; ++c) {
    const int cn = (c + 1 < NCH) ? c + 1 : c;
    issue(cn);
    const float* cb = buf + (size_t)(c & 1) * TC * RST;
    float* yb = ybuf + (c & 1) * TC * 32;
    if (w < 4) {
      auto ld = [&](int s) {
        RwOps8 o;
        const float* sb = cb + s * RST + kg * 8;
        o.w0 = *(const float4*)(sb);        o.w1 = *(const float4*)(sb + 4);
        o.k0 = *(const float4*)(sb + 64);   o.k1 = *(const float4*)(sb + 68);
        o.a0 = *(const float4*)(sb + 128);  o.a1 = *(const float4*)(sb + 132);
        o.b0 = *(const float4*)(sb + 192);  o.b1 = *(const float4*)(sb + 196);
        o.r0 = *(const float4*)(sb + 256);  o.r1 = *(const float4*)(sb + 260);
        o.vv = cb[s * RST + 320 + half * 32 + lrow];
        o.sc = *(const float2*)(cb + s * RST + 384);
        return o;
      };
      RwOps8 cur = ld(0);
#pragma unroll 8
      for (int s = 0; s < TC; ++s) {
        RwOps8 nxt = ld((s + 1) & (TC - 1));
        v2f t1 = S0 * v2f{cur.a0.x, cur.a0.y}, t2 = S0 * v2f{cur.r0.x, cur.r0.y};
        t1 = pkfma(S1, v2f{cur.a0.z, cur.a0.w}, t1);
        t2 = pkfma(S1, v2f{cur.r0.z, cur.r0.w}, t2);
        t1 = pkfma(S2, v2f{cur.a1.x, cur.a1.y}, t1);
        t2 = pkfma(S2, v2f{cur.r1.x, cur.r1.y}, t2);
        t1 = pkfma(S3, v2f{cur.a1.z, cur.a1.w}, t1);
        t2 = pkfma(S3, v2f{cur.r1.z, cur.r1.w}, t2);
        float sa = t1.x + t1.y, yy = t2.x + t2.y;
        oct_sum2(sa, yy);
        v2f sa2 = {sa, sa}, va2 = {cur.vv, cur.vv};
        S0 = pkfma(S0, v2f{cur.w0.x, cur.w0.y}, pkfma(sa2, v2f{cur.b0.x, cur.b0.y}, va2 * v2f{cur.k0.x, cur.k0.y}));
        S1 = pkfma(S1, v2f{cur.w0.z, cur.w0.w}, pkfma(sa2, v2f{cur.b0.z, cur.b0.w}, va2 * v2f{cur.k0.z, cur.k0.w}));
        S2 = pkfma(S2, v2f{cur.w1.x, cur.w1.y}, pkfma(sa2, v2f{cur.b1.x, cur.b1.y}, va2 * v2f{cur.k1.x, cur.k1.y}));
        S3 = pkfma(S3, v2f{cur.w1.z, cur.w1.w}, pkfma(sa2, v2f{cur.b1.z, cur.b1.w}, va2 * v2f{cur.k1.z, cur.k1.w}));
        yy = fmaf(sa, cur.sc.x, fmaf(cur.vv, cur.sc.y, yy));
        yb[s * 32 + lrow] = yy;
        cur = nxt;
      }
    }
    commit(c + 1, cn);
    __syncthreads();
    if (lq < 8) {
      int row = seq_row(b, dir, c * TC + lstep);
      float4 yv = *(const float4*)(yb + lstep * 32 + lq * 4);
      uint2 o;
      o.x = pack2(yv.x, yv.y);
      o.y = pack2(yv.z, yv.w);
      *(uint2*)(Yd + (size_t)row * 384 + h * 64 + half * 32 + lq * 4) = o;
    }
  }
  __syncthreads();
}

constexpr int GST = 288;
struct GlOps { float4 a03, k03, q03; float2 a45, k45, q45; float v0, v1, v2; };
DEV void scan_gla_rg(PTag p, int l, int task) {
  const int ltid = my_tid();
  const int tid = ltid, lane = tid & 63, w = tid >> 6;
  const int b = task >> 3, hd = (task >> 1) & 3, dir = task & 1;
  char* ar = KWS + OFF_AR;
  const u16* Z1 = (const u16*)(ar + AR_Z1);
  const u16* LAg = (const u16*)(ar + AR_LA) + (size_t)dir * NT * 192;
  u16* Od = (u16*)(ar + AR_Z2) + (size_t)(2 + dir) * NT * 384;
  const u16* RGP = (const u16*)(KWS + OFF_XN);
  const u16* RLA = RGP + (size_t)(dir * 2 + 0) * NT * 256;
  const u16* RBX = RGP + (size_t)(dir * 2 + 1) * NT * 256;
  u16* Hd = (u16*)(KWS + OFF_Y) + (size_t)NT * 384 + (size_t)dir * NT * 256;
  float* buf = (float*)g_smem;
  float* obuf = buf + 2 * TC * GST;
  unsigned* rgbuf = (unsigned*)(obuf + 2 * TC * 128);
  u16* hbuf = (u16*)(rgbuf + 2 * TC * 64);
  const int el = lane >> 3, dg = lane & 7;
  const int c0 = w * 24 + el;
  const int lstep = tid >> 4, lq = tid & 15;
  v2f S[3][3];
#pragma unroll
  for (int c = 0; c < 3; ++c)
#pragma unroll
    for (int j = 0; j < 3; ++j) S[c][j] = v2f{0.f, 0.f};
  float hst = 0.f;
  uint2 gq, gk, gl_, gv0, gv1, rla, rbx;
  auto issue = [&](int c) {
    int row = seq_row(b, dir, c * TC + lstep);
    const u16* zr = Z1 + (size_t)row * Z1W;
    uint2 z = {0u, 0u};
    gq = z; gk = z; gl_ = z; gv1 = z;
    if (lq < 12) {
      gq = *(const uint2*)(zr + 512 + hd * 48 + lq * 4);
      gk = *(const uint2*)(zr + 704 + hd * 48 + lq * 4);
      gl_ = *(const uint2*)(LAg + (size_t)row * 192 + hd * 48 + lq * 4);
    }
    gv0 = *(const uint2*)(zr + 896 + hd * 96 + lq * 4);
    if (lq < 8) gv1 = *(const uint2*)(zr + 896 + hd * 96 + 64 + lq * 4);
    rla = *(const uint2*)(RLA + (size_t)row * 256 + hd * 64 + lq * 4);
    rbx = *(const uint2*)(RBX + (size_t)row * 256 + hd * 64 + lq * 4);
  };
  auto commit = [&](int c, int) {
    float* d = buf + (size_t)((c & 1) * TC + lstep) * GST;
    const float qs = 0.14433756729740643f;
    if (lq < 12) {
      float av[4] = {__expf(lo2f(gl_.x)), __expf(hi2f(gl_.x)), __expf(lo2f(gl_.y)), __expf(hi2f(gl_.y))};
      float kv[4] = {lo2f(gk.x), hi2f(gk.x), lo2f(gk.y), hi2f(gk.y)};
      float qv[4] = {lo2f(gq.x) * qs, hi2f(gq.x) * qs, lo2f(gq.y) * qs, hi2f(gq.y) * qs};
#pragma unroll
      for (int e = 0; e < 4; ++e) {
        int dd = lq * 4 + e;
        int pos = (dd / 6) * 20 + (dd % 6);
        d[pos] = av[e];
        d[6 + pos] = kv[e];
        d[12 + pos] = qv[e];
      }
    }
    {
      float vv0[4] = {lo2f(gv0.x), hi2f(gv0.x), lo2f(gv0.y), hi2f(gv0.y)};
      float vv1[4] = {lo2f(gv1.x), hi2f(gv1.x), lo2f(gv1.y), hi2f(gv1.y)};
#pragma unroll
      for (int e = 0; e < 4; ++e) {
        int c = lq * 4 + e, r = c % 24;
        d[160 + (c / 24) * 32 + (r % 8) * 4 + (r / 8)] = vv0[e];
        if (lq < 8) {
          int c2 = 64 + lq * 4 + e, r2 = c2 % 24;
          d[160 + (c2 / 24) * 32 + (r2 % 8) * 4 + (r2 / 8)] = vv1[e];
        }
      }
    }
    unsigned* rd = rgbuf + (size_t)((c & 1) * TC + lstep) * 64 + lq * 4;
    uint4 ro;
    ro.x = (rla.x & 0xffffu) | (rbx.x << 16);
    ro.y = (rla.x >> 16) | (rbx.x & 0xffff0000u);
    ro.z = (rla.y & 0xffffu) | (rbx.y << 16);
    ro.w = (rla.y >> 16) | (rbx.y & 0xffff0000u);
    *(uint4*)rd = ro;
  };
  issue(0);
  commit(0, 0);
  __syncthreads();
  constexpr int NCH = NSTEP / TC;
#pragma unroll 1
  for (int c = 0; c < NCH; ++c) {
    const int cn = (c + 1 < NCH) ? c + 1 : c;
    issue(cn);
    const float* cb = buf + (size_t)(c & 1) * TC * GST;
    float* ob = obuf + (c & 1) * TC * 128;
    if (w < 4) {
      auto ld = [&](int s) {
        GlOps o;
        const float* sb = cb + s * GST + dg * 20;
        float4 r0 = *(const float4*)(sb), r1 = *(const float4*)(sb + 4), r2 = *(const float4*)(sb + 8);
        float4 r3 = *(const float4*)(sb + 12);
        float2 r4 = *(const float2*)(sb + 16);
        o.a03 = r0;
        o.a45 = make_float2(r1.x, r1.y);
        o.k03 = make_float4(r1.z, r1.w, r2.x, r2.y);
        o.k45 = make_float2(r2.z, r2.w);
        o.q03 = r3;
        o.q45 = r4;
        float4 vq = *(const float4*)(cb + s * GST + 160 + w * 32 + el * 4);
        o.v0 = vq.x; o.v1 = vq.y; o.v2 = vq.z;
        return o;
      };
      GlOps cur = ld(0);
#pragma unroll 8
      for (int s = 0; s < TC; ++s) {
        GlOps nxt = ld((s + 1) & (TC - 1));
        v2f al[3] = {v2f{cur.a03.x, cur.a03.y}, v2f{cur.a03.z, cur.a03.w}, v2f{cur.a45.x, cur.a45.y}};
        v2f kk[3] = {v2f{cur.k03.x, cur.k03.y}, v2f{cur.k03.z, cur.k03.w}, v2f{cur.k45.x, cur.k45.y}};
        v2f qq[3] = {v2f{cur.q03.x, cur.q03.y}, v2f{cur.q03.z, cur.q03.w}, v2f{cur.q45.x, cur.q45.y}};
        v2f vv[3] = {v2f{cur.v0, cur.v0}, v2f{cur.v1, cur.v1}, v2f{cur.v2, cur.v2}};
        float r[3];
#pragma unroll
        for (int ci = 0; ci < 3; ++ci) {
#pragma unroll
          for (int j = 0; j < 3; ++j) S[ci][j] = pkfma(al[j], S[ci][j], kk[j] * vv[ci]);
          v2f o = qq[0] * S[ci][0];
          o = pkfma(qq[1], S[ci][1], o);
          o = pkfma(qq[2], S[ci][2], o);
          r[ci] = o.x + o.y;
        }
        oct_sum3(r[0], r[1], r[2]);
        typedef float v3f __attribute__((ext_vector_type(3)));
        *(v3f*)(ob + s * 128 + w * 32 + el * 4) = v3f{r[0], r[1], r[2]};
        cur = nxt;
      }
    } else if (w == 4) {
      const unsigned* rb = rgbuf + (size_t)(c & 1) * TC * 64 + lane;
      u16* hb = hbuf + (size_t)(c & 1) * TC * 64 + lane;
      unsigned uu[TC];
#pragma unroll
      for (int s = 0; s < TC; ++s) uu[s] = rb[s * 64];
#pragma unroll
      for (int s = 0; s < TC; ++s) {
        float a = __expf(lo2f(uu[s]));
        hst = fmaf(a, hst, hi2f(uu[s]));
        hb[s * 64] = f2bf(hst);
      }
    }
    commit(c + 1, cn);
    __syncthreads();
    {
      int row = seq_row(b, dir, c * TC + lstep);
      u16* orow = Od + (size_t)row * 384 + hd * 96;
      const float* orow_l = ob + lstep * 128;
      float x0[4], x1[4];
#pragma unroll
      for (int e = 0; e < 4; ++e) {
        int c = lq * 4 + e, r = c % 24;
        x0[e] = orow_l[(c / 24) * 32 + (r % 8) * 4 + (r / 8)];
        int c2 = 64 + (lq & 7) * 4 + e, r2 = c2 % 24;
        x1[e] = orow_l[(c2 / 24) * 32 + (r2 % 8) * 4 + (r2 / 8)];
      }
      uint2 o;
      o.x = pack2(x0[0], x0[1]); o.y = pack2(x0[2], x0[3]);
      *(uint2*)(orow + lq * 4) = o;
      if (lq < 8) {
        o.x = pack2(x1[0], x1[1]); o.y = pack2(x1[2], x1[3]);
        *(uint2*)(orow + 64 + lq * 4) = o;
      }
      uint2 hv = *(const uint2*)(hbuf + (size_t)((c & 1) * TC + lstep) * 64 + lq * 4);
      *(uint2*)(Hd + (size_t)row * 256 + hd * 64 + lq * 4) = hv;
    }
  }
  __syncthreads();
}

DEV void phase_scan(PTag p, int l, int mode) {
  const int lbid = my_bid();
  const int Gs = gridDim.x;
  const int swz = (Gs % 8 == 0) ? (lbid % 8) * (Gs / 8) + lbid / 8 : lbid;
  for (int base = 0; base < 256; base += Gs) {
    const int task = base + ((base + Gs <= 256) ? swz : lbid);
    if (task >= 256) continue;
    if (task < 192) { if (mode != 2) scan_rwkv(p, l, task); }
    else { if (mode != 1) scan_gla_rg(p, l, task - 192); }
  }
}

DEV float gelu_tanh(float x) {
  float u = 0.7978845608028654f * (x + 0.044715f * x * x * x);
  return 0.5f * x * (1.f + tanhf_(u));
}
DEV void phase_post(PTag p, int l) {
  const int ltid = my_tid();
  const int lbid = my_bid();
  const int lane = ltid & 63;
  const int gw = lbid * 8 + (ltid >> 6), nw = gridDim.x * 8;
  char* ar = KWS + OFF_AR;
  const u16* Z1 = (const u16*)(ar + AR_Z1);
  const u16* RWP = (const u16*)(ar + AR_RWP);
  const u16* RWY = (const u16*)(ar + AR_Z2);
  const u16* Gg = (const u16*)(KWS + OFF_Y);
  const u16* RGH = Gg + (size_t)NT * 384;
  u16* YM = (u16*)(KWS + OFF_XN);
  const float* gnorm = KP(gla_norm) + (size_t)l * 96;
  const float* r_k = KP(rw_r_k) + (size_t)l * 384;
  const float* k_a = KP(rw_k_a) + (size_t)l * 384;
  const float* ln_w = KP(rw_ln_w) + (size_t)l * 384;
  const float* ln_b = KP(rw_ln_b) + (size_t)l * 384;
  float gn0 = gnorm[lane], gn1 = (lane < 32) ? gnorm[64 + lane] : 0.f;
  float rkc[6], kac[6], lwc[6], lbc[6];
#pragma unroll
  for (int j = 0; j < 6; ++j) {
    rkc[j] = r_k[j * 64 + lane]; kac[j] = k_a[j * 64 + lane];
    lwc[j] = ln_w[j * 64 + lane]; lbc[j] = ln_b[j * 64 + lane];
  }
  const int l32 = lane < 32 ? lane : 0;
  for (int row = gw; row < NT; row += nw) {
    uint2 hf = *(const uint2*)(RGH + (size_t)row * 256 + lane * 4);
    uint2 hb = *(const uint2*)(RGH + (size_t)NT * 256 + (size_t)row * 256 + lane * 4);
    uint2 gb = *(const uint2*)(Z1 + (size_t)row * Z1W + 256 + lane * 4);
    const u16* of = RWY + (size_t)2 * NT * 384 + (size_t)row * 384;
    const u16* ob = RWY + (size_t)3 * NT * 384 + (size_t)row * 384;
    const u16* og = Z1 + (size_t)row * Z1W + 1280;
    u16 gof0[4], gob0[4], gog0[4], gof1[4], gob1[4], gog1[4];
#pragma unroll
    for (int hd = 0; hd < 4; ++hd) {
      gof0[hd] = of[hd * 96 + lane]; gob0[hd] = ob[hd * 96 + lane]; gog0[hd] = og[hd * 96 + lane];
      gof1[hd] = of[hd * 96 + 64 + l32]; gob1[hd] = ob[hd * 96 + 64 + l32]; gog1[hd] = og[hd * 96 + 64 + l32];
    }
    size_t ro = (size_t)row * 384;
    u16 wyf[6], wyb[6], wr[6], wk[6], wv[6], waf[6], wab[6], wg[6];
#pragma unroll
    for (int j = 0; j < 6; ++j) {
      int idx = j * 64 + lane;
      wyf[j] = RWY[ro + idx]; wyb[j] = RWY[(size_t)NT * 384 + ro + idx];
      wr[j] = RWP[ro + idx]; wk[j] = RWP[(size_t)NT * 384 + ro + idx]; wv[j] = RWP[(size_t)2 * NT * 384 + ro + idx];
      waf[j] = RWP[(size_t)5 * NT * 384 + ro + idx]; wab[j] = RWP[(size_t)6 * NT * 384 + ro + idx];
      wg[j] = Gg[ro + idx];
    }
    {
      float y0 = (lo2f(hf.x) + lo2f(hb.x)) * gelu_tanh(lo2f(gb.x));
      float y1 = (hi2f(hf.x) + hi2f(hb.x)) * gelu_tanh(hi2f(gb.x));
      float y2 = (lo2f(hf.y) + lo2f(hb.y)) * gelu_tanh(lo2f(gb.y));
      float y3 = (hi2f(hf.y) + hi2f(hb.y)) * gelu_tanh(hi2f(gb.y));
      uint2 o;
      o.x = pack2(y0, y1); o.y = pack2(y2, y3);
      *(uint2*)(YM + (size_t)row * 1024 + lane * 4) = o;
    }
#pragma unroll
    for (int hd = 0; hd < 4; ++hd) {
      float v0 = bf2f(gof0[hd]) + bf2f(gob0[hd]);
      float v1 = (lane < 32) ? (bf2f(gof1[hd]) + bf2f(gob1[hd])) : 0.f;
      float ss = wave_sum(v0 * v0 + v1 * v1);
      float rs = rsqrtf(ss * (1.f / 96.f) + 1e-6f);
      YM[(size_t)row * 1024 + 256 + hd * 96 + lane] = f2bf(v0 * rs * gn0 * siluf_(bf2f(gog0[hd])));
      if (lane < 32)
        YM[(size_t)row * 1024 + 256 + hd * 96 + 64 + lane] = f2bf(v1 * rs * gn1 * siluf_(bf2f(gog1[hd])));
    }
#pragma unroll
    for (int j = 0; j < 6; ++j) {
      int idx = j * 64 + lane;
      float y = bf2f(wyf[j]) + bf2f(wyb[j]);
      float r = bf2f(wr[j]), k = bf2f(wk[j]), v = bf2f(wv[j]);
      float af = bf2f(waf[j]), ab = bf2f(wab[j]);
      float mean = wave_sum(y) * (1.f / 64.f);
      float dlt = y - mean;
      float var = wave_sum(dlt * dlt) * (1.f / 64.f);
      float bon = wave_sum(r * k * rkc[j] * (2.f + (af + ab - 2.f) * kac[j]));
      float yn = dlt * rsqrtf(var + 64e-5f) * lwc[j] + lbc[j];
      yn += bon * v;
      YM[(size_t)row * 1024 + 640 + idx] = f2bf(yn * bf2f(wg[j]));
    }
  }
}

constexpr int NPHASES = 2 + 12 * 4;

DEV void run_phase(PTag p, int ph, int rep) {
  float* mod = (float*)(KWS + OFF_MOD);
  char* ws = KWS;
  u16* XN = (u16*)(ws + OFF_XN);
  u16* Yb = (u16*)(ws + OFF_Y);
  u16* U = (u16*)(ws + OFF_AR);
  if (ph == 0) {
    phase_adaln(p);
    __syncthreads();
    conv_ffn(p, 0, 0);
    return;
  }
  if (ph == 1) {
    phase_rows(p, 1, 0, nullptr, nullptr, 0.f, 1, KP(norm_pre) + 0, mod + 0 * 1024, mod + 1 * 1024, NT);
    return;
  }
  int q = ph - 2, l = q / 12, k = q % 12;
  const float* modl = mod + (size_t)l * 9 * 9216;
  const bool last = (l == 3);
  const int Mlate = last ? NLAT : NT;
  switch (k) {
    case 0:
      gemm_phase<1024, EPI_UP>(XN, (const u16*)(ws + OFF_WB + WB_W13T), NT, 5632, U, nullptr);
      break;
    case 1:
      gemm_phase<2816, EPI_Y>(U, (const u16*)(ws + OFF_WB + WB_W2T), NLAT, 1024, Yb, nullptr);
      gemm_phase<2816, EPI_Y, true>(U, (const u16*)(ws + OFF_WB + WB_W2T), NLAT, 1024, Yb, nullptr, NCTXR / BM,
                                    (float*)(ws + OFF_AR + AR_PART));
      break;
    case 2:
      phase_rows(p, 0, 1, KP(norm_post) + (size_t)(l * 3 + 0) * 1024, modl + 2 * 1024, 0.5f, 1,
                 KP(norm_pre) + (size_t)(l * 3 + 1) * 1024, modl + 3 * 1024, modl + 4 * 1024, NT, 1);
      conv_mixer(p, l);
      break;
    case 3:
      gemm_phase<1024, EPI_Z>(XN, (const u16*)(ws + OFF_WB + WB_WINT), NT, PINP, (u16*)(ws + OFF_AR + AR_Z1),
                              (u16*)(ws + OFF_AR + AR_Z2));
      break;
    case 4:
      phase_prep(p, l);
      break;
    case 5:
      phase_scan(p, l, rep == 0 ? 0 : SCAN_PROBE_MODE);
      break;
    case 6:
      phase_post(p, l);
      break;
    case 7:
      gemm_phase<1024, EPI_Y>(XN, (const u16*)(ws + OFF_WB + WB_WOUTT), NLAT, 1024, Yb, nullptr);
      if (!last)
        gemm_phase<1024, EPI_Y, true>(XN, (const u16*)(ws + OFF_WB + WB_WOUTT), NLAT, 1024, Yb, nullptr, NCTXR / BM,
                                      (float*)(ws + OFF_AR + AR_PART));
      break;
    case 8:
      phase_rows(p, 0, 1, KP(norm_post) + (size_t)(l * 3 + 1) * 1024, modl + 5 * 1024, 1.0f, 1,
                 KP(norm_pre) + (size_t)(l * 3 + 2) * 1024, modl + 6 * 1024, modl + 7 * 1024, Mlate, 1);
      conv_ffn(p, l, 1);
      break;
    case 9:
      gemm_phase<1024, EPI_UP>(XN, (const u16*)(ws + OFF_WB + WB_W13T), Mlate, 5632, U, nullptr);
      break;
    case 10:
      gemm_phase<2816, EPI_Y>(U, (const u16*)(ws + OFF_WB + WB_W2T), NLAT, 1024, Yb, nullptr);
      if (!last)
        gemm_phase<2816, EPI_Y, true>(U, (const u16*)(ws + OFF_WB + WB_W2T), NLAT, 1024, Yb, nullptr, NCTXR / BM,
                                      (float*)(ws + OFF_AR + AR_PART));
      break;
    case 11:
      if (!last) {
        const float* modn = mod + (size_t)(l + 1) * 9 * 9216;
        phase_rows(p, 0, 1, KP(norm_post) + (size_t)(l * 3 + 2) * 1024, modl + 8 * 1024, 0.5f, 1,
                   KP(norm_pre) + (size_t)((l + 1) * 3 + 0) * 1024, modn + 0 * 1024, modn + 1 * 1024, NT, 1);
        conv_ffn(p, l + 1, 0);
      } else {
        phase_rows(p, 0, 1, KP(norm_post) + (size_t)(l * 3 + 2) * 1024, modl + 8 * 1024, 0.5f, 0, nullptr, nullptr,
                   nullptr, NLAT);
      }
      break;
  }
}

#ifndef REP_SCAN
#define REP_SCAN 1
#endif
#ifndef REP_GEMM
#define REP_GEMM 1
#endif
#ifndef REP_PREP
#define REP_PREP 1
#endif
#ifndef REP_POST
#define REP_POST 1
#endif
DEV int phase_reps(int ph) {
  if (ph < 2) return 1;
  int k = (ph - 2) % 12;
  if (k == 5) return REP_SCAN;
  if (k == 4) return REP_PREP;
  if (k == 6) return REP_POST;
  if (k == 0 || k == 1 || k == 3 || k == 7 || k == 9 || k == 10) return REP_GEMM;
  return 1;
}
#define XB_XCNT(j) (64 * (j))
#define XB_XSUB(j) (1024 + 64 * (j))
#define XB_XGEN(j) (2048 + 64 * (j))
#define XB_TOP 3072
#define XB_TOPGEN 3136
#define XB_WORDS 3200
__shared__ unsigned xb_state[4];
DEV unsigned xb_ld(unsigned* p) { return __hip_atomic_load(p, __ATOMIC_RELAXED, __HIP_MEMORY_SCOPE_AGENT); }
DEV unsigned xb_add(unsigned* p, unsigned v) { return __hip_atomic_fetch_add(p, v, __ATOMIC_RELAXED, __HIP_MEMORY_SCOPE_AGENT); }
DEV void xcd_barrier(unsigned* bar) {
  asm volatile("s_waitcnt vmcnt(0)" ::: "memory");
  __syncthreads();
  if (threadIdx.x == 0) {
    unsigned nloc = xb_state[0], nx = xb_state[1];
    const unsigned x = xb_state[2];
    if (nloc == 0u) {
      const unsigned G = gridDim.x;
      for (;;) {
        unsigned sum = 0u, cnt = 0u, mine = 0u;
#pragma unroll
        for (unsigned j = 0; j < 16; ++j) {
          const unsigned c = xb_ld(&bar[XB_XCNT(j)]);
          sum += c;
          cnt += (c > 0u) ? 1u : 0u;
          mine = (j == x) ? c : mine;
        }
        if (sum == G) { nloc = mine; nx = cnt; break; }
        __builtin_amdgcn_s_sleep(1);
      }
      xb_state[0] = nloc;
      xb_state[1] = nx;
    }
    const unsigned old = xb_add(&bar[XB_XSUB(x)], 1u);
    const unsigned gen = old / nloc;
    if (old + 1u == (gen + 1u) * nloc) {
      __builtin_amdgcn_fence(__ATOMIC_RELEASE, "agent");
      asm volatile("s_waitcnt vmcnt(0)" ::: "memory");
      const unsigned og = xb_add(&bar[XB_TOP], 1u);
      const unsigned tg = og / nx;
      if (og + 1u == (tg + 1u) * nx) xb_add(&bar[XB_TOPGEN], 1u);
      else while (xb_ld(&bar[XB_TOPGEN]) == tg) __builtin_amdgcn_s_sleep(1);
      __builtin_amdgcn_fence(__ATOMIC_ACQUIRE, "agent");
      xb_add(&bar[XB_XGEN(x)], 1u);
      asm volatile("s_waitcnt vmcnt(0)" ::: "memory");
    } else {
      while (xb_ld(&bar[XB_XGEN(x)]) == gen) __builtin_amdgcn_s_sleep(1);
      __builtin_amdgcn_fence(__ATOMIC_ACQUIRE, "agent");
      asm volatile("s_waitcnt vmcnt(0)" ::: "memory");
    }
  }
  __syncthreads();
}

__global__ void __launch_bounds__(NTHREADS, 2) mega_kernel(Params params_, int ph_lo, int ph_hi) {
  PTag p;
  cg::grid_group grid = cg::this_grid();
  unsigned* bar = (unsigned*)(KWS + OFF_BAR);
  if (blockIdx.x == 0)
    for (int i = threadIdx.x; i < XB_WORDS; i += NTHREADS) __hip_atomic_store(&bar[i], 0u, __ATOMIC_RELAXED, __HIP_MEMORY_SCOPE_AGENT);
  if (threadIdx.x == 0) {
    xb_state[0] = 0u;
    xb_state[1] = 0u;
    xb_state[2] = (unsigned)__builtin_amdgcn_s_getreg((3 << 11) | 20) & 0xFu;
  }
  unsigned nsync = 0;
  for (int ph = ph_lo; ph < ph_hi; ++ph) {
    const int reps = phase_reps(ph);
    for (int r = 0; r < reps; ++r) {
      if (ph > ph_lo || r > 0) {
        if (nsync == 0) {
          grid.sync();
          if (threadIdx.x == 0) (void)xb_add(&bar[XB_XCNT(xb_state[2])], 1u);
        } else {
          xcd_barrier(bar);
        }
        ++nsync;
      }
      run_phase(p, ph, r);
    }
  }
}

extern "C" void kernel_launch(void* const* d_in, const int* in_sizes, int n_in, void* d_out, int out_size, void* d_ws,
                              size_t ws_size, hipStream_t stream) {
  static int grid_blocks = 0;
  if (!grid_blocks) {
    int dev = 0, cus = 0, per_cu = 0;
    hipGetDevice(&dev);
    hipDeviceGetAttribute(&cus, hipDeviceAttributeMultiprocessorCount, dev);
    hipFuncSetAttribute((const void*)mega_kernel, hipFuncAttributeMaxDynamicSharedMemorySize, (int)SMEM_BYTES);
    hipOccupancyMaxActiveBlocksPerMultiprocessor(&per_cu, mega_kernel, NTHREADS, SMEM_BYTES);
    if (per_cu < 1) per_cu = 1;
    grid_blocks = cus * per_cu;
    if (ws_size < WS_TOTAL) fprintf(stderr, "workspace too small: %zu < %zu\n", ws_size, (size_t)WS_TOTAL);
  }
  Params p{};
  const float** pp = (const float**)&p;
  for (int i = 0; i < 34; ++i) pp[i] = (const float*)d_in[i];
  p.out = (float*)d_out;
  p.ws = (char*)d_ws;
#ifdef MULTI_LAUNCH
  for (int ph = 0; ph < NPHASES; ++ph) {
    hipLaunchKernelGGL(mega_kernel, dim3(grid_blocks), dim3(NTHREADS), SMEM_BYTES, stream, p, ph, ph + 1);
  }
#else
  int lo = 0, hi = NPHASES;
  void* args[] = {&p, &lo, &hi};
  hipError_t e = hipLaunchCooperativeKernel((const void*)mega_kernel, dim3(grid_blocks), dim3(NTHREADS), args,
                                            SMEM_BYTES, stream);
  if (e != hipSuccess) fprintf(stderr, "cooperative launch failed: %s (grid %d)\n", hipGetErrorString(e), grid_blocks);
#endif
}
```
